# Optimizing an MI355X kernel written in HIP

```python
import jax, jax.numpy as jnp
from jax import lax
import numpy as np

D_MODEL = 1024
BATCH = 16
SEQ = 4096
DEPTH = 1

PLE_DIM = 256
D_MIX = D_MODEL
FOX_HEADS = 8
FOX_HEAD_DIM = 64
FOX_WIDTH = FOX_HEADS * FOX_HEAD_DIM
MLSTM_HEADS = 4
MLSTM_HEAD_DIM = 128
MLSTM_WIDTH = MLSTM_HEADS * MLSTM_HEAD_DIM
CONV_WIDTH = 4
D_FF = 4 * D_MODEL
Q_BLOCK = 128
CHUNK = 128
EPS = 1e-6

IN_SIZES = (FOX_WIDTH, FOX_WIDTH, FOX_WIDTH, FOX_HEADS,
            MLSTM_WIDTH, MLSTM_WIDTH, MLSTM_WIDTH, MLSTM_HEADS, MLSTM_HEADS, MLSTM_WIDTH)
IN_COLS = int(sum(IN_SIZES))
IN_SPLITS = tuple(int(s) for s in np.cumsum(IN_SIZES)[:-1])

kernel_name = "hymba_fox_mlstm_sqrelu_ple"


def rmsnorm(x, g):
    xf = x.astype(jnp.float32)
    y = xf * lax.rsqrt(jnp.mean(xf * xf, axis=-1, keepdims=True) + EPS)
    return (y * g.astype(jnp.float32)).astype(x.dtype)


def head_rmsnorm(h, g):
    B, S, H, d = h.shape
    hf = h.astype(jnp.float32)
    y = hf * lax.rsqrt(jnp.mean(hf * hf, axis=-1, keepdims=True) + EPS)
    return y.reshape(B, S, H * d) * g.astype(jnp.float32)


def causal_conv(u, w):
    K = w.shape[0]
    S = u.shape[1]
    up = jnp.pad(u, ((0, 0), (K - 1, 0), (0, 0)))
    out = up[:, 0:S] * w[0]
    for j in range(1, K):
        out = out + up[:, j:j + S] * w[j]
    return out


def fox_attention(q, k, v, f_pre):
    B, S, H, d = q.shape
    nb = S // Q_BLOCK
    log_f = jax.nn.log_sigmoid(f_pre.astype(jnp.float32))
    c = jnp.cumsum(log_f, axis=1).transpose(0, 2, 1)
    kh = k.transpose(0, 2, 1, 3)
    vh = v.transpose(0, 2, 1, 3)
    qb = q.reshape(B, nb, Q_BLOCK, H, d).transpose(1, 0, 3, 2, 4)
    cb = c.reshape(B, H, nb, Q_BLOCK).transpose(2, 0, 1, 3)
    kpos = jnp.arange(S)
    scale = d ** -0.5

    def block(args):
        qi, ci, i = args
        s = jnp.einsum('bhqd,bhkd->bhqk', qi, kh).astype(jnp.float32) * scale
        s = s + ci[..., :, None] - c[:, :, None, :]
        qpos = i * Q_BLOCK + jnp.arange(Q_BLOCK)
        s = jnp.where(kpos[None, :] <= qpos[:, None], s, -jnp.inf)
        pr = jax.nn.softmax(s, axis=-1).astype(vh.dtype)
        return jnp.einsum('bhqk,bhkd->bhqd', pr, vh)

    o = lax.map(block, (qb, cb, jnp.arange(nb)))
    return o.transpose(1, 0, 3, 2, 4).reshape(B, S, H, d)


def mlstm_chunkwise(q, k, v, i_pre, f_pre):
    B, S, H, d = q.shape
    L = CHUNK
    nc = S // L
    f32 = jnp.float32

    def to_chunks(a):
        a = a.reshape((B, nc, L, H) + a.shape[3:])
        return jnp.moveaxis(a, (1, 3), (0, 2))

    qc = to_chunks(q.astype(f32))
    kc = to_chunks(k.astype(f32) * (d ** -0.5))
    vc = to_chunks(v.astype(f32))
    ic = to_chunks(i_pre.astype(f32))
    fc = to_chunks(jax.nn.log_sigmoid(f_pre.astype(f32)))
    causal = jnp.tril(jnp.ones((L, L), dtype=bool))

    def step(carry, xs):
        C, n, m = carry
        qi, ki, vi, ii, fi = xs
        b = jnp.cumsum(fi, axis=-1)
        Dm = b[..., :, None] - b[..., None, :] + ii[..., None, :]
        Dm = jnp.where(causal, Dm, -jnp.inf)
        inter = b + m[..., None]
        mt = jnp.maximum(inter, jnp.max(Dm, axis=-1))
        w_inter = jnp.exp(inter - mt)
        w_intra = jnp.exp(Dm - mt[..., None])
        sqk = jnp.einsum('bhtd,bhsd->bhts', qi, ki) * w_intra
        num = (w_inter[..., None] * jnp.einsum('bhtd,bhde->bhte', qi, C)
               + jnp.einsum('bhts,bhse->bhte', sqk, vi))
        den = w_inter * jnp.einsum('bhtd,bhd->bht', qi, n) + jnp.sum(sqk, axis=-1)
        h = num / jnp.maximum(jnp.abs(den), jnp.exp(-mt))[..., None]
        bL = b[..., -1]
        g = bL[..., None] - b + ii
        m_new = jnp.maximum(bL + m, jnp.max(g, axis=-1))
        decay = jnp.exp(bL + m - m_new)
        wk = jnp.exp(g - m_new[..., None])[..., None] * ki
        C_new = decay[..., None, None] * C + jnp.einsum('bhsd,bhse->bhde', wk, vi)
        n_new = decay[..., None] * n + jnp.sum(wk, axis=2)
        return (C_new, n_new, m_new), h

    init = (jnp.zeros((B, H, d, d), f32), jnp.zeros((B, H, d), f32), jnp.zeros((B, H), f32))
    _, hs = lax.scan(step, init, (qc, kc, vc, ic, fc))
    hs = jnp.moveaxis(hs, (0, 2), (1, 3)).reshape(B, S, H, d)
    return hs


def setup_inputs(seed: int = 0) -> dict:
    key = jax.random.key(seed)
    ks = jax.random.split(key, 20)
    f32 = jnp.float32
    nrm = lambda k, shape, s: jax.random.normal(k, shape, f32) * s
    gain = lambda k, shape: 1.0 + 0.02 * jax.random.normal(k, shape, f32)
    return {
        "x": jax.random.normal(ks[0], (BATCH, SEQ, D_MODEL), f32),
        "p": jax.random.normal(ks[1], (DEPTH, BATCH, SEQ, PLE_DIM), f32),
        "w_in": nrm(ks[2], (DEPTH, D_MODEL, IN_COLS), D_MODEL ** -0.5),
        "b_fox_f": 3.0 + 0.5 * jax.random.normal(ks[3], (DEPTH, FOX_HEADS), f32),
        "b_mlstm_i": nrm(ks[4], (DEPTH, MLSTM_HEADS), 0.1),
        "b_mlstm_f": jnp.linspace(3.0, 6.0, MLSTM_HEADS, dtype=f32)[None, :]
                     + 0.1 * jax.random.normal(ks[5], (DEPTH, MLSTM_HEADS), f32),
        "w_conv": nrm(ks[6], (DEPTH, CONV_WIDTH, 2 * MLSTM_WIDTH), CONV_WIDTH ** -0.5),
        "g_mix": gain(ks[7], (DEPTH, D_MODEL)),
        "g_fox_out": gain(ks[8], (DEPTH, FOX_WIDTH)),
        "g_mlstm_out": gain(ks[9], (DEPTH, MLSTM_WIDTH)),
        "w_out": nrm(ks[10], (DEPTH, D_MIX, D_MODEL), D_MIX ** -0.5),
        "g_mlp": gain(ks[11], (DEPTH, D_MODEL)),
        "w_up": nrm(ks[12], (DEPTH, D_MODEL, D_FF), D_MODEL ** -0.5),
        "w_down": nrm(ks[13], (DEPTH, D_FF, D_MODEL), D_FF ** -0.5),
        "w_ple": nrm(ks[14], (DEPTH, PLE_DIM, D_MODEL), PLE_DIM ** -0.5),
        "g_ple": gain(ks[15], (DEPTH, D_MODEL)),
        "w_ple_gate": nrm(ks[16], (DEPTH, D_MODEL, D_MODEL), D_MODEL ** -0.5),
        "g_final": gain(ks[17], (D_MODEL,)),
    }


def reference(x, p, w_in, b_fox_f, b_mlstm_i, b_mlstm_f, w_conv, g_mix, g_fox_out,
              g_mlstm_out, w_out, g_mlp, w_up, w_down, w_ple, g_ple, w_ple_gate, g_final):
    B, S, _ = x.shape
    for i in range(DEPTH):
        h = rmsnorm(x, g_mix[i])
        z = h @ w_in[i]
        (fq, fk, fv, ff, mq, mk, mv, mi, mf, mo) = jnp.split(z, IN_SPLITS, axis=-1)

        fox = fox_attention(fq.reshape(B, S, FOX_HEADS, FOX_HEAD_DIM),
                            fk.reshape(B, S, FOX_HEADS, FOX_HEAD_DIM),
                            fv.reshape(B, S, FOX_HEADS, FOX_HEAD_DIM),
                            ff + b_fox_f[i])
        fox_out = head_rmsnorm(fox, g_fox_out[i])

        qk = jax.nn.silu(causal_conv(jnp.concatenate([mq, mk], axis=-1), w_conv[i]))
        mq_c, mk_c = jnp.split(qk, 2, axis=-1)
        ml = mlstm_chunkwise(mq_c.reshape(B, S, MLSTM_HEADS, MLSTM_HEAD_DIM),
                             mk_c.reshape(B, S, MLSTM_HEADS, MLSTM_HEAD_DIM),
                             mv.reshape(B, S, MLSTM_HEADS, MLSTM_HEAD_DIM),
                             mi + b_mlstm_i[i], mf + b_mlstm_f[i])
        ml_out = head_rmsnorm(ml, g_mlstm_out[i]) * jax.nn.sigmoid(mo.astype(jnp.float32))

        mix = jnp.concatenate([fox_out, ml_out], axis=-1).astype(x.dtype)
        x = x + mix @ w_out[i]

        hm = rmsnorm(x, g_mlp[i])
        x = x + jnp.square(jax.nn.relu(hm @ w_up[i])) @ w_down[i]

        gate = jax.nn.sigmoid(rmsnorm(x, g_ple[i]) @ w_ple_gate[i])
        x = x + gate * (p[i] @ w_ple[i])
    return rmsnorm(x, g_final)
```

```cpp
#include <hip/hip_runtime.h>
#include <cstdio>
#include <cstdint>
namespace pg8 {
#define PG8_LAS __attribute__((address_space(3)))
typedef unsigned short bf16_t;
typedef short bf16x8 __attribute__((ext_vector_type(8)));
typedef float f32x4 __attribute__((ext_vector_type(4)));
typedef unsigned u32x4 __attribute__((ext_vector_type(4)));
constexpr int BM = 256, BK = 64, HALF = 128, HTB = HALF * BK * 2  , STAGE_BYTES = 8 * HTB, NXCD = 8, WGM = 8;

__host__ __device__ __forceinline__ int lds_byte(int r, int c) { const int st = (r >> 4) * 2 + (c >> 5), rr = r & 15, cc = c & 31, ob = rr * 64 + cc * 2; return st * 1024 + (ob ^ (((ob >> 9) & 1) << 5)); }
__host__ __device__ __forceinline__ void stage_rc(int b, int& R, int& C) { const int st = b / 1024, sb = b % 1024, swz = sb ^ (((sb >> 9) & 1) << 5); R = (st >> 1) * 16 + swz / 64; C = (st & 1) * 32 + (swz % 64) / 2; }
__host__ __device__ __forceinline__ int perm32(int rho) { const int n = rho >> 4, i = rho & 15; return 8 * (i >> 2) + 4 * n + (i & 3); }

struct Unit { int pm, pn; };
struct Gemm { const bf16_t* A; const bf16_t* Bt; int M, N, K; };

struct StaticOrder {
    int nM, nN, nwg, G, c;
    __host__ __device__ void init(int M, int N, int G_, int c_) { nM = M / BM; nN = N / BM; nwg = nM * nN; G = G_; c = c_; }
    __host__ __device__ bool next(int i, Unit& u) const {
        const long L = (long)i * G + c; if (L >= nwg) return false;
        int wgid = (int)L; { const int q = nwg / NXCD, r = nwg % NXCD, xcd = wgid % NXCD, off = wgid / NXCD; wgid = (xcd < r ? xcd * (q + 1) : r * (q + 1) + (xcd - r) * q) + off; }
        const int nig = WGM * nN, gid = wgid / nig, fm = gid * WGM, gsz = (nM - fm) < WGM ? (nM - fm) : WGM;
        u.pm = fm + ((wgid % nig) % gsz); u.pn = (wgid % nig) / gsz; return true;
    }
    __device__ __forceinline__ void a_ready(const Unit&) const {}
    __device__ __forceinline__ void done(const Unit&) const {}
};

__device__ __forceinline__ unsigned cvt_pk_bf16(float lo, float hi) { unsigned r; asm volatile("v_cvt_pk_bf16_f32 %0, %1, %2" : "=v"(r) : "v"(lo), "v"(hi)); return r; }
typedef float f32x2 __attribute__((ext_vector_type(2)));
typedef unsigned u32x2 __attribute__((ext_vector_type(2)));
__device__ __forceinline__ float bf_lo(unsigned w) { return __uint_as_float(w << 16); }
__device__ __forceinline__ float bf_hi(unsigned w) { return __uint_as_float(w & 0xffff0000u); }
struct EpiZ {
    static constexpr bool PERM = true, AFTER_DRAIN = false;
    bf16_t* Z; size_t zstride; bf16_t* MO; float* G; float scale0;
    __device__ __forceinline__ void operator()(const f32x4 (&acc)[2][2][4][2], const Unit& u, int wr, int wc, int fr, int fq) const {
        asm volatile("" : "+v"(fr), "+v"(fq));
        const int row0 = u.pm * BM + wr * 64 + fr; const int t = u.pn >> 1;
        if (t < 7) {
            bf16_t* base = (t < 6) ? Z + (size_t)t * zstride : MO;
            const float sc = (t == 0) ? scale0 : 1.f;
            const int col0 = (u.pn & 1) * BM + wc * 32 + 8 * fq;
#pragma unroll
            for (int ai = 0; ai < 2; ++ai)
#pragma unroll
                for (int m = 0; m < 4; ++m) { bf16_t* rowp = base + (size_t)(row0 + ai * HALF + m * 16) * 512 + col0;
#pragma unroll
                    for (int bj = 0; bj < 2; ++bj) { const f32x4 v0 = acc[ai][bj][m][0] * sc, v1 = acc[ai][bj][m][1] * sc;
                        u32x4 w; w.x = cvt_pk_bf16(v0[0], v0[1]); w.y = cvt_pk_bf16(v0[2], v0[3]); w.z = cvt_pk_bf16(v1[0], v1[1]); w.w = cvt_pk_bf16(v1[2], v1[3]);
                        *(u32x4*)(rowp + bj * HALF) = w; } }
        } else if (wc == 0 && fq < 2) {
#pragma unroll
            for (int ai = 0; ai < 2; ++ai)
#pragma unroll
                for (int m = 0; m < 4; ++m) { float* gp = G + (size_t)(row0 + ai * HALF + m * 16) * 16 + 8 * fq;
                    *(f32x4*)gp = acc[ai][0][m][0]; *(f32x4*)(gp + 4) = acc[ai][0][m][1]; }
        }
    }
};
struct EpiRes {
    static constexpr bool PERM = false, AFTER_DRAIN = false;
    const float* base; float* out; bf16_t* xb;
    __device__ __forceinline__ void operator()(const f32x4 (&acc)[2][2][4][2], const Unit& u, int wr, int wc, int fr, int fq) const {
        asm volatile("" : "+v"(fr), "+v"(fq));
        const int col0 = u.pn * BM + wc * 32 + 4 * fq;
#pragma unroll
        for (int ai = 0; ai < 2; ++ai)
#pragma unroll
            for (int m = 0; m < 4; ++m) { const size_t off = (size_t)(u.pm * BM + ai * HALF + wr * 64 + m * 16 + fr) * 1024 + col0;
#pragma unroll
                for (int bj = 0; bj < 2; ++bj)
#pragma unroll
                    for (int n = 0; n < 2; ++n) { const f32x4 o = *(const f32x4*)(base + off + bj * HALF + n * 16) + acc[ai][bj][m][n];
                        *(f32x4*)(out + off + bj * HALF + n * 16) = o;
                        u32x2 w; w.x = cvt_pk_bf16(o[0], o[1]); w.y = cvt_pk_bf16(o[2], o[3]); *(u32x2*)(xb + off + bj * HALF + n * 16) = w; }
                asm volatile("" ::: "memory"); }
    }
};
struct EpiUp {
    static constexpr bool PERM = true, AFTER_DRAIN = false;
    bf16_t* H; const float* rstd;
    __device__ __forceinline__ void operator()(const f32x4 (&acc)[2][2][4][2], const Unit& u, int wr, int wc, int fr, int fq) const {
        asm volatile("" : "+v"(fr), "+v"(fq));
        const int row0 = u.pm * BM + wr * 64 + fr, col0 = u.pn * BM + wc * 32 + 8 * fq;
#pragma unroll
        for (int ai = 0; ai < 2; ++ai)
#pragma unroll
            for (int m = 0; m < 4; ++m) { const int r = row0 + ai * HALF + m * 16; const float rs = rstd[r]; bf16_t* rowp = H + (size_t)r * 4096 + col0;
#pragma unroll
                for (int bj = 0; bj < 2; ++bj) { f32x4 v0 = acc[ai][bj][m][0] * rs, v1 = acc[ai][bj][m][1] * rs;
#pragma unroll
                    for (int i = 0; i < 4; ++i) { const float a = fmaxf(v0[i], 0.f), b = fmaxf(v1[i], 0.f); v0[i] = a * a; v1[i] = b * b; }
                    u32x4 w; w.x = cvt_pk_bf16(v0[0], v0[1]); w.y = cvt_pk_bf16(v0[2], v0[3]); w.z = cvt_pk_bf16(v1[0], v1[1]); w.w = cvt_pk_bf16(v1[2], v1[3]);
                    *(u32x4*)(rowp + bj * HALF) = w; } }
    }
};
struct EpiPlain {
    static constexpr bool PERM = true, AFTER_DRAIN = false;
    bf16_t* O; int ldc;
    __device__ __forceinline__ void operator()(const f32x4 (&acc)[2][2][4][2], const Unit& u, int wr, int wc, int fr, int fq) const {
        asm volatile("" : "+v"(fr), "+v"(fq));
        const int row0 = u.pm * BM + wr * 64 + fr, col0 = u.pn * BM + wc * 32 + 8 * fq;
#pragma unroll
        for (int ai = 0; ai < 2; ++ai)
#pragma unroll
            for (int m = 0; m < 4; ++m) { bf16_t* rowp = O + (size_t)(row0 + ai * HALF + m * 16) * ldc + col0;
#pragma unroll
                for (int bj = 0; bj < 2; ++bj) { const f32x4 v0 = acc[ai][bj][m][0], v1 = acc[ai][bj][m][1];
                    u32x4 w; w.x = cvt_pk_bf16(v0[0], v0[1]); w.y = cvt_pk_bf16(v0[2], v0[3]); w.z = cvt_pk_bf16(v1[0], v1[1]); w.w = cvt_pk_bf16(v1[2], v1[3]);
                    *(u32x4*)(rowp + bj * HALF) = w; } }
    }
};
struct EpiGate {
    static constexpr bool PERM = false, AFTER_DRAIN = false;
    float* out; const bf16_t* pl; const float* rstd;
    __device__ __forceinline__ void operator()(const f32x4 (&acc)[2][2][4][2], const Unit& u, int wr, int wc, int fr, int fq) const {
        asm volatile("" : "+v"(fr), "+v"(fq));
        const int col0 = u.pn * BM + wc * 32 + 4 * fq;
#pragma unroll
        for (int ai = 0; ai < 2; ++ai)
#pragma unroll
            for (int m = 0; m < 4; ++m) { const int r = u.pm * BM + ai * HALF + wr * 64 + m * 16 + fr; const float rs = rstd[r]; const size_t off = (size_t)r * 1024 + col0;
#pragma unroll
                for (int bj = 0; bj < 2; ++bj)
#pragma unroll
                    for (int n = 0; n < 2; ++n) { const size_t o2 = off + bj * HALF + n * 16; const f32x4 a = acc[ai][bj][m][n] * rs; const u32x2 pw = *(const u32x2*)(pl + o2);
                        f32x4 x = *(const f32x4*)(out + o2);
                        x[0] += bf_lo(pw.x) / (1.f + __expf(-a[0])); x[1] += bf_hi(pw.x) / (1.f + __expf(-a[1]));
                        x[2] += bf_lo(pw.y) / (1.f + __expf(-a[2])); x[3] += bf_hi(pw.y) / (1.f + __expf(-a[3]));
                        *(f32x4*)(out + o2) = x; }
                asm volatile("" ::: "memory"); }
    }
};
struct PanelOrder {
    int pm, nN;
    __device__ __forceinline__ bool next(int i, Unit& u) const { if (i >= nN) return false; u.pm = pm; u.pn = i; return true; }
    __device__ __forceinline__ void a_ready(const Unit&) const {}
    __device__ __forceinline__ void done(const Unit&) const {}
};
template <class Epi, class Sched, bool ALIGN_EPI = false, bool SP2 = false>
__device__ __forceinline__ void gemm_phase(PG8_LAS unsigned char* lds, const Gemm g, const Sched& S, const Epi& E) {
    int tid_ = threadIdx.x; asm volatile("" : "+v"(tid_));
    const int tid = tid_, wid = __builtin_amdgcn_readfirstlane(tid >> 6), lane = tid & 63, wr = wid >> 2, wc = wid & 3, fr = lane & 15, fq = lane >> 4;
    const int K = g.K, nt = K / BK;
    unsigned voffA[2], voffB[2];
#pragma unroll
    for (int i = 0; i < 2; ++i) { int R, C; stage_rc(tid * 16 + i * 8192, R, C); const int Rb = Epi::PERM ? ((R & ~31) + perm32(R & 31)) : R;
        voffA[i] = (unsigned)(R * K + C) * 2u; voffB[i] = (unsigned)(Rb * K + C) * 2u; }
    const size_t kstep = (size_t)(BK * 2);
    const size_t hstep = (size_t)HALF * K * 2;
    const size_t tstep = 2 * hstep;
    const unsigned ldsw = (unsigned)wid * 1024u;
    const int aoff = lds_byte(wr * 64 + fr, fq * 8), boff = lds_byte(wc * 32 + fr, fq * 8);
#define PG8_SA(b, h) (((b) * 2 + (h)) * HTB)
#define PG8_SB(b, h) ((4 + (b) * 2 + (h)) * HTB)
#define PG8_STAGE(bufoff, gbase, voff) do { _Pragma("unroll") for (int _i = 0; _i < 2; ++_i) \
        __builtin_amdgcn_global_load_lds((const unsigned*)((const char*)(gbase) + (voff)[_i]), (PG8_LAS unsigned*)(lds + (bufoff) + ldsw + _i * 8192), 16, 0, 0); } while (0)
#define PG8_LDA(dst, b, h) do { _Pragma("unroll") for (int m = 0; m < 4; ++m) _Pragma("unroll") for (int k = 0; k < 2; ++k) dst[m][k] = *(const PG8_LAS bf16x8*)(lds + PG8_SA(b, h) + aoff + m * 2048 + k * 1024); } while (0)
#define PG8_LDB(dst, b, h) do { _Pragma("unroll") for (int n = 0; n < 2; ++n) _Pragma("unroll") for (int k = 0; k < 2; ++k) dst[n][k] = *(const PG8_LAS bf16x8*)(lds + PG8_SB(b, h) + boff + n * 2048 + k * 1024); } while (0)
#define PG8_MMA(ai, bj, At, Bt) do { __builtin_amdgcn_s_setprio(1); _Pragma("unroll") for (int m = 0; m < 4; ++m) _Pragma("unroll") for (int n = 0; n < 2; ++n) _Pragma("unroll") for (int k = 0; k < 2; ++k) \
        acc[ai][bj][m][n] = __builtin_amdgcn_mfma_f32_16x16x32_bf16(Bt[n][k], At[m][k], acc[ai][bj][m][n], 0, 0, 0); __builtin_amdgcn_s_setprio(0); } while (0)
#define PG8_WAIT_V(n) asm volatile("s_waitcnt vmcnt(" #n ")" ::: "memory")
#define PG8_WAIT_L(n) asm volatile("s_waitcnt lgkmcnt(" #n ")" ::: "memory")
#define PG8_BAR __builtin_amdgcn_s_barrier()
#define PG8_SCHED __builtin_amdgcn_sched_barrier(0)
    Unit cur, nxt; int ui = 0;
    if (!S.next(0, cur)) return;
    f32x4 acc[2][2][4][2];
#pragma unroll
    for (int a = 0; a < 2; ++a)
#pragma unroll
        for (int b = 0; b < 2; ++b)
#pragma unroll
            for (int m = 0; m < 4; ++m)
#pragma unroll
                for (int n = 0; n < 2; ++n) acc[a][b][m][n] = (f32x4){0.f, 0.f, 0.f, 0.f};
    bf16x8 At[4][2], B0[2][2], B1[2][2];
    const char* cA = (const char*)g.A + (size_t)cur.pm * tstep; const char* cB = (const char*)g.Bt + (size_t)cur.pn * tstep;
    S.a_ready(cur);
    if constexpr (SP2) {
        PG8_STAGE(PG8_SB(0, 0), cB, voffB); PG8_STAGE(PG8_SB(0, 1), cB + hstep, voffB); PG8_STAGE(PG8_SA(0, 0), cA, voffA); PG8_STAGE(PG8_SA(0, 1), cA + hstep, voffA);
        if (wr == 1) PG8_BAR;
        PG8_WAIT_V(2); PG8_BAR;
        PG8_STAGE(PG8_SB(1, 0), cB + kstep, voffB); PG8_STAGE(PG8_SA(1, 0), cA + kstep, voffA); PG8_STAGE(PG8_SB(1, 1), cB + hstep + kstep, voffB);
        PG8_WAIT_V(6); PG8_BAR;
    } else {
        PG8_STAGE(PG8_SB(0, 0), cB, voffB); PG8_STAGE(PG8_SA(0, 0), cA, voffA); PG8_STAGE(PG8_SB(0, 1), cB + hstep, voffB); PG8_STAGE(PG8_SA(0, 1), cA + hstep, voffA);
        if (wr == 1) PG8_BAR;
        PG8_WAIT_V(4); PG8_BAR;
        PG8_STAGE(PG8_SB(1, 0), cB + kstep, voffB); PG8_STAGE(PG8_SA(1, 0), cA + kstep, voffA); PG8_STAGE(PG8_SB(1, 1), cB + hstep + kstep, voffB);
        PG8_WAIT_V(6); PG8_BAR;
    }
    for (;;) {
        const bool has_next = S.next(ui + 1, nxt);
        const char* nA = has_next ? (const char*)g.A + (size_t)nxt.pm * tstep : cA; const char* nB = has_next ? (const char*)g.Bt + (size_t)nxt.pn * tstep : cB;
        for (int t = 0; t < nt; t += 2) {
            const bool last = (t == nt - 2);
            const char* a1 = cA + (size_t)(t + 1) * kstep;
            const char* a2 = last ? nA : cA + (size_t)(t + 2) * kstep; const char* b2 = last ? nB : cB + (size_t)(t + 2) * kstep;
            const char* a3 = a2 + kstep; const char* b3 = b2 + kstep;
            asm volatile("" : "+s"(a1), "+s"(a2), "+s"(b2), "+s"(a3), "+s"(b3));
            if (last && has_next) S.a_ready(nxt);
            if constexpr (SP2) {
            PG8_LDB(B0, 0, 0); PG8_LDB(B1, 0, 1); PG8_SCHED; PG8_LDA(At, 0, 0); PG8_STAGE(PG8_SA(1, 1), a1 + hstep, voffA);
            PG8_WAIT_V(8); PG8_WAIT_L(0); PG8_BAR; PG8_MMA(0, 0, At, B0); PG8_MMA(0, 1, At, B1); PG8_BAR; PG8_SCHED;
            PG8_LDA(At, 0, 1); PG8_STAGE(PG8_SB(0, 0), b2, voffB); PG8_STAGE(PG8_SB(0, 1), b2 + hstep, voffB); PG8_STAGE(PG8_SA(0, 0), a2, voffA);
            PG8_WAIT_V(8); PG8_WAIT_L(0); PG8_BAR; PG8_MMA(1, 0, At, B0); PG8_MMA(1, 1, At, B1); PG8_BAR; PG8_SCHED;
            PG8_LDB(B0, 1, 0); PG8_LDB(B1, 1, 1); PG8_SCHED; PG8_LDA(At, 1, 0); PG8_STAGE(PG8_SA(0, 1), a2 + hstep, voffA);
            PG8_WAIT_V(8); PG8_WAIT_L(0); PG8_BAR; PG8_MMA(0, 0, At, B0); PG8_MMA(0, 1, At, B1); PG8_BAR; PG8_SCHED;
            PG8_LDA(At, 1, 1); PG8_STAGE(PG8_SB(1, 0), b3, voffB); PG8_STAGE(PG8_SB(1, 1), b3 + hstep, voffB); PG8_STAGE(PG8_SA(1, 0), a3, voffA);
            PG8_WAIT_V(8); PG8_WAIT_L(0); PG8_BAR; PG8_MMA(1, 0, At, B0); PG8_MMA(1, 1, At, B1); PG8_BAR; PG8_SCHED;
            } else {
            PG8_LDB(B0, 0, 0); PG8_SCHED; PG8_LDA(At, 0, 0); PG8_STAGE(PG8_SA(1, 1), a1 + hstep, voffA);
            PG8_WAIT_L(8); PG8_BAR; PG8_WAIT_L(0); PG8_MMA(0, 0, At, B0); PG8_BAR; PG8_SCHED;
            PG8_LDB(B1, 0, 1); PG8_STAGE(PG8_SB(0, 0), b2, voffB);
            PG8_BAR; PG8_WAIT_L(0); PG8_MMA(0, 1, At, B1); PG8_BAR;
            PG8_LDA(At, 0, 1); PG8_STAGE(PG8_SA(0, 0), a2, voffA);
            PG8_BAR; PG8_WAIT_L(0); PG8_MMA(1, 0, At, B0); PG8_BAR; PG8_SCHED;
            PG8_STAGE(PG8_SB(0, 1), b2 + hstep, voffB);
            PG8_WAIT_V(6); PG8_BAR; PG8_MMA(1, 1, At, B1); PG8_BAR;
            PG8_LDB(B0, 1, 0); PG8_SCHED; PG8_LDA(At, 1, 0); PG8_STAGE(PG8_SA(0, 1), a2 + hstep, voffA);
            PG8_WAIT_L(8); PG8_BAR; PG8_WAIT_L(0); PG8_MMA(0, 0, At, B0); PG8_BAR; PG8_SCHED;
            PG8_LDB(B1, 1, 1); PG8_STAGE(PG8_SB(1, 0), b3, voffB);
            PG8_BAR; PG8_WAIT_L(0); PG8_MMA(0, 1, At, B1); PG8_BAR;
            PG8_LDA(At, 1, 1); PG8_STAGE(PG8_SA(1, 0), a3, voffA);
            PG8_BAR; PG8_WAIT_L(0); PG8_MMA(1, 0, At, B0); PG8_BAR; PG8_SCHED;
            PG8_STAGE(PG8_SB(1, 1), b3 + hstep, voffB);
            PG8_WAIT_V(6); PG8_BAR; PG8_MMA(1, 1, At, B1); PG8_BAR;
            }
        }
        if constexpr (ALIGN_EPI) { if (wr == 0) PG8_BAR; }
        if constexpr (!Epi::AFTER_DRAIN) { E(acc, cur, wr, wc, fr, fq); S.done(cur); }
        if (!has_next) break;
#pragma unroll
        for (int a = 0; a < 2; ++a)
#pragma unroll
            for (int b = 0; b < 2; ++b)
#pragma unroll
                for (int m = 0; m < 4; ++m)
#pragma unroll
                    for (int n = 0; n < 2; ++n) acc[a][b][m][n] = (f32x4){0.f, 0.f, 0.f, 0.f};
        cur = nxt; cA = nA; cB = nB; ++ui;
        if constexpr (ALIGN_EPI) { if (wr == 1) PG8_BAR; }
    }
    PG8_WAIT_V(0);
    if constexpr (!ALIGN_EPI) { if (wr == 0) PG8_BAR; }
    PG8_BAR;
    if constexpr (Epi::AFTER_DRAIN) { E.fused(acc, cur, wr, wc, fr, fq, lds, wid, lane); S.done(cur); }
#undef PG8_SA
#undef PG8_SB
#undef PG8_STAGE
#undef PG8_LDA
#undef PG8_LDB
#undef PG8_MMA
#undef PG8_WAIT_V
#undef PG8_WAIT_L
#undef PG8_BAR
#undef PG8_SCHED
}
}
#include <hip/hip_bf16.h>
#include <cmath>
namespace attn_body {
using bf16=__hip_bfloat16;
using bf16x8=__attribute__((ext_vector_type(8)))short;
using s16x4=__attribute__((ext_vector_type(4)))short;
using f32x16=__attribute__((ext_vector_type(16)))float;
using u32x4=__attribute__((ext_vector_type(4)))unsigned;
using f32x4v=__attribute__((ext_vector_type(4)))float;
constexpr int BATCH=16,NHEAD=8,SEQ=4096,D=64,DM=NHEAD*D,OPITCH=1024;
constexpr int NW=8,QBLK=32,QB=QBLK*NW,KVBLK=64,NQB=SEQ/QB;
constexpr int ATTN_PITCH=DM, ATTN_UNIT_ROWS=QB;
__device__ __forceinline__ int crow(int r,int hi){return (r&3)+8*(r>>2)+4*hi;}
#define SBAR() __builtin_amdgcn_sched_barrier(0)
__device__ __forceinline__ void cmask(f32x16&p0,f32x16&p1,int jb,int qrel,int hi){
  const float NEG=-INFINITY; int kb=64*jb+4*hi;
  #pragma unroll
  for(int r=0;r<16;++r){int kv=kb+(r&3)+8*(r>>2); if(kv>qrel)p0[r]=NEG; if(kv+32>qrel)p1[r]=NEG;}
}

constexpr int NSLOT=3, SLOTB=8192;
constexpr int LDS_K=0, LDS_V=NSLOT*SLOTB, LDS_WS=2*NSLOT*SLOTB, LDS_OST=LDS_WS+NW*64*4, LDS_BYTES=LDS_OST+NW*4096;
constexpr int LDS_CB=86016;
constexpr float C2=0.125f*1.4426950408889634f;
__device__ __forceinline__ void glds16(const void*gsrc,unsigned lds_dst){unsigned keep;
  asm volatile("s_mov_b32 %0, m0\n\ts_mov_b32 m0, %2\n\ts_nop 0\n\tglobal_load_lds_dwordx4 %1, off\n\ts_mov_b32 m0, %0":"=&s"(keep):"v"(gsrc),"s"(lds_dst):"memory");}
__device__ __forceinline__ float max3f(float a,float b,float c){float r;asm("v_max3_f32 %0, %1, %2, %3":"=v"(r):"v"(a),"v"(b),"v"(c));return r;}
__device__ __forceinline__ float max2f(float a,float b){float r;asm("v_max_f32_e32 %0, %1, %2":"=v"(r):"v"(a),"v"(b));return r;}
__device__ __forceinline__ float fadd_s(float a,float b){float r;asm("v_add_f32_e32 %0, %1, %2":"=v"(r):"v"(a),"v"(b));return r;}
__device__ __forceinline__ float fsub_s(float a,float b){float r;asm("v_sub_f32_e32 %0, %1, %2":"=v"(r):"v"(a),"v"(b));return r;}
typedef float f32x2_t __attribute__((ext_vector_type(2))); typedef __bf16 bf16x2_t __attribute__((ext_vector_type(2)));
__device__ __forceinline__ unsigned cvtpk_s(float lo,float hi){f32x2_t v={lo,hi};bf16x2_t b=__builtin_convertvector(v,bf16x2_t);return __builtin_bit_cast(unsigned,b);}
#define WAIT_BAR(N) asm volatile("s_waitcnt vmcnt(" #N ") lgkmcnt(0)\n\ts_barrier":::"memory")

__device__ __forceinline__ void qkt(f32x16&p0,f32x16&p1,const char*Kslot,const bf16x8*qr,const f32x16&negm,int r32,int hi){
  const char*kb=Kslot+hi*1024+r32*16;
  #pragma unroll
  for(int d0=0;d0<4;++d0){
    const bf16x8 b0=*reinterpret_cast<const bf16x8*>(kb+d0*2048);
    const bf16x8 b1=*reinterpret_cast<const bf16x8*>(kb+d0*2048+512);
    if(d0==0){p0=__builtin_amdgcn_mfma_f32_32x32x16_bf16(b0,qr[0],negm,0,0,0);p1=__builtin_amdgcn_mfma_f32_32x32x16_bf16(b1,qr[0],negm,0,0,0);}
    else{p0=__builtin_amdgcn_mfma_f32_32x32x16_bf16(b0,qr[d0],p0,0,0,0);p1=__builtin_amdgcn_mfma_f32_32x32x16_bf16(b1,qr[d0],p1,0,0,0);}}
}
typedef __attribute__((address_space(3))) const char* lds_cptr;
typedef short v4i16_t __attribute__((ext_vector_type(4)));
__device__ __forceinline__ void kload8(bf16x8*kf,lds_cptr kp){
  kf[0]=*(const __attribute__((address_space(3))) bf16x8*)(kp);      kf[1]=*(const __attribute__((address_space(3))) bf16x8*)(kp+512);
  kf[2]=*(const __attribute__((address_space(3))) bf16x8*)(kp+2048); kf[3]=*(const __attribute__((address_space(3))) bf16x8*)(kp+2560);
  kf[4]=*(const __attribute__((address_space(3))) bf16x8*)(kp+4096); kf[5]=*(const __attribute__((address_space(3))) bf16x8*)(kp+4608);
  kf[6]=*(const __attribute__((address_space(3))) bf16x8*)(kp+6144); kf[7]=*(const __attribute__((address_space(3))) bf16x8*)(kp+6656);
}
__device__ __forceinline__ void kload2(bf16x8*kf,lds_cptr kp,int j){ kf[2*j]=*(const __attribute__((address_space(3))) bf16x8*)(kp+j*2048); kf[2*j+1]=*(const __attribute__((address_space(3))) bf16x8*)(kp+j*2048+512); }
__device__ __forceinline__ s16x4 vtr(lds_cptr p){ return __builtin_bit_cast(s16x4,__builtin_amdgcn_ds_read_tr16_b64_v4i16((__attribute__((address_space(3))) v4i16_t*)p)); }
__device__ __forceinline__ float rowmax(const f32x16&p0,const f32x16&p1){
  float a=max3f(p0[0],p0[1],p1[0]),b=max3f(p0[2],p0[3],p1[1]);a=max3f(a,p1[2],p1[3]);
  #pragma unroll
  for(int r=4;r<16;r+=4){a=max3f(a,p0[r],p0[r+1]);b=max3f(b,p0[r+2],p0[r+3]);a=max3f(a,p1[r],p1[r+1]);b=max3f(b,p1[r+2],p1[r+3]);}
  const float m=max2f(a,b);
  auto rr=__builtin_amdgcn_permlane32_swap(__float_as_uint(m),__float_as_uint(m),false,false);
  return max2f(__uint_as_float(rr[0]),__uint_as_float(rr[1]));
}
__device__ __forceinline__ void pv(f32x16*o,int vb,bf16x8 pa0,bf16x8 pa1,bf16x8 pa2,bf16x8 pa3){
  #pragma unroll
  for(int d0=0;d0<2;++d0){s16x4 lo[4],hi[4];
    #pragma unroll
    for(int ks=0;ks<4;++ks){
      asm volatile("ds_read_b64_tr_b16 %0,%1 offset:%c2":"=&v"(lo[ks]):"v"(vb),"i"(d0*4096+ks*1024):"memory");
      asm volatile("ds_read_b64_tr_b16 %0,%1 offset:%c2":"=&v"(hi[ks]):"v"(vb),"i"(d0*4096+ks*1024+512):"memory");}
    asm volatile("s_waitcnt lgkmcnt(0)":::"memory");SBAR();
    #define PK(k) (bf16x8){lo[k][0],lo[k][1],lo[k][2],lo[k][3],hi[k][0],hi[k][1],hi[k][2],hi[k][3]}
    o[d0]=__builtin_amdgcn_mfma_f32_32x32x16_bf16(pa0,PK(0),o[d0],0,0,0);
    o[d0]=__builtin_amdgcn_mfma_f32_32x32x16_bf16(pa1,PK(1),o[d0],0,0,0);
    o[d0]=__builtin_amdgcn_mfma_f32_32x32x16_bf16(pa2,PK(2),o[d0],0,0,0);
    o[d0]=__builtin_amdgcn_mfma_f32_32x32x16_bf16(pa3,PK(3),o[d0],0,0,0);
    #undef PK
  }
}

#ifndef ATTN_STORE16
#define ATTN_STORE16(p,v) (*(u32x4*)(p)=(v))
#endif
template<int THRL> __device__ __forceinline__ void attn_unit(int b,int h,int qb,const bf16*Q,const bf16*__restrict__ K,const bf16*__restrict__ V,bf16*O,const float*gfox,char*shm){
  int tid_=threadIdx.x; asm volatile("":"+v"(tid_)); const int tid=tid_,lane=tid&63,r32=lane&31,hi=lane>>5; const int wid=__builtin_amdgcn_readfirstlane(tid>>6);
  const long rowbase=(long)b*SEQ; const int q0=qb*QB;
  const bf16*Qw=Q+(rowbase+q0+wid*QBLK)*DM+h*D;
  const bf16*Kh=K+rowbase*DM+h*D,*Vh=V+rowbase*DM+h*D;
  const unsigned lds0=(unsigned)(uintptr_t)shm;
  float*wsf=(float*)(shm+LDS_WS)+wid*64;
  const bf16*ksrc=Kh+(long)lane*DM+wid*8;
  const bf16*vsrc=Vh+(long)(16*(wid&3)+(lane>>2))*DM+(wid>>2)*32+(lane&3)*8;
  const unsigned kdst=lds0+LDS_K+wid*1024, vdst=lds0+LDS_V+wid*1024;
  #define DMA_K(t,slot) glds16(ksrc+(long)(t)*KVBLK*DM,(unsigned)__builtin_amdgcn_readfirstlane(kdst+(slot)))
  #define DMA_V(t,slot) glds16(vsrc+(long)(t)*KVBLK*DM,(unsigned)__builtin_amdgcn_readfirstlane(vdst+(slot)))
  const int vb0=(int)(lds0+LDS_V)+((lane>>4)&1)*32+(lane&3)*8+(4*hi+((lane&15)>>2))*64;
  const char*Kbase=shm+LDS_K; bf16x8 kf[8];
  const lds_cptr shm3=(lds_cptr)shm; const lds_cptr kp0=shm3+LDS_K+hi*1024+r32*16; const lds_cptr vp0=shm3+LDS_V+((lane>>4)&1)*32+(lane&3)*8+(4*hi+((lane&15)>>2))*64;
  const int NT=(q0+QB)/KVBLK;
  DMA_K(0,0);DMA_V(0,0);DMA_K(1,SLOTB);
  bf16x8 qr[4];
  #pragma unroll
  for(int d0=0;d0<4;++d0)qr[d0]=*reinterpret_cast<const bf16x8*>(&Qw[(long)r32*DM+d0*16+hi*8]);
  float mhat=0.f,l_reg=0.f;f32x16 o[2]; float zz_=0.f; asm volatile("":"+v"(zz_));
  #pragma unroll
  for(int r=0;r<16;++r){o[0][r]=zz_;o[1][r]=zz_;}
  f32x16 negm;
  #pragma unroll
  for(int r=0;r<16;++r)negm[r]=zz_;
  asm volatile("":"+v"(negm));
  const int qrel=wid*QBLK+r32;
  const __attribute__((address_space(3))) f32x4v* cbq=(const __attribute__((address_space(3))) f32x4v*)((lds_cptr)shm+LDS_CB)+hi;
  #define FBIAS(P0,P1,t) do{ const __attribute__((address_space(3))) f32x4v* cb_=cbq+(t)*16; \
    _Pragma("unroll") for(int j_=0;j_<4;++j_){ const f32x4v a_=cb_[2*j_], b_=cb_[8+2*j_]; \
      P0[4*j_]-=a_[0]; P0[4*j_+1]-=a_[1]; P0[4*j_+2]-=a_[2]; P0[4*j_+3]-=a_[3]; \
      P1[4*j_]-=b_[0]; P1[4*j_+1]-=b_[1]; P1[4*j_+2]-=b_[2]; P1[4*j_+3]-=b_[3]; } }while(0)
  #define CMASK(P0,P1,t) do{int jb_=(t)-(NT-4); if(jb_>=0)cmask(P0,P1,jb_,qrel,hi);}while(0)
  bool resc=false;
  #define START(P0,P1) do{ const float rm=rowmax(P0,P1); resc=false; \
    { const float dl=rm; mhat=fadd_s(mhat,dl); \
      _Pragma("unroll") for(int r=0;r<16;++r){P0[r]=fsub_s(P0[r],dl);P1[r]=fsub_s(P1[r],dl);} \
      _Pragma("unroll") for(int r=0;r<16;++r)negm[r]=-mhat; asm volatile("":"+v"(negm)); } \
    _Pragma("unroll") for(int r=0;r<16;++r)P0[r]=__builtin_amdgcn_exp2f(P0[r]); }while(0)
  #define RESC() do{ if(resc){ asm volatile("s_waitcnt lgkmcnt(0)":::"memory"); \
      _Pragma("unroll") for(int d_=0;d_<2;++d_) _Pragma("unroll") for(int r=0;r<16;++r)o[d_][r]*=wsf[crow(r,hi)]; } }while(0)
  f32x16 pA0,pA1,pB0,pB1;
  int sl_prev=0,sl_cur=0,sl_next=SLOTB;
  #define ROT() do{sl_prev=sl_cur;sl_cur=sl_next;sl_next=(sl_next==(NSLOT-1)*SLOTB)?0:sl_next+SLOTB;}while(0)
  DMA_K(2,2*SLOTB);
  WAIT_BAR(3);
  qkt(pA0,pA1,Kbase,qr,negm,r32,hi);asm volatile("s_nop 15\n\ts_nop 7":"+v"(pA0),"+v"(pA1));FBIAS(pA0,pA1,0);CMASK(pA0,pA1,0);
  START(pA0,pA1);
  _Pragma("unroll") for(int r=0;r<16;++r)pA1[r]=__builtin_amdgcn_exp2f(pA1[r]);
  WAIT_BAR(0);
  DMA_K(3,0);DMA_V(1,SLOTB);
  ROT();
  kload8(kf,kp0+sl_cur);
  WAIT_BAR(2);
  s16x4 vlo[8],vhi[8]; u32x4 pw0,pw1,pw2,pw3;
  #define PKW(P,B) cvtpk_s(P[B],P[B+1])
  #define PAF(k) __builtin_bit_cast(bf16x8,pw##k)
  #define VFR(i) (bf16x8){vlo[i][0],vlo[i][1],vlo[i][2],vlo[i][3],vhi[i][0],vhi[i][1],vhi[i][2],vhi[i][3]}
  #define PIN(x) asm volatile("":"+v"(x))
  #define MX3(a,b,c) __builtin_fmaxf(__builtin_fmaxf((a),(b)),(c))
  #define GAPA(MF,A0,A1,A2,A3,W0,W1,PW) do{ MF; sacc+=A0; sacc+=A1; sacc+=A2; sacc+=A3; PIN(sacc); W0; W1; PIN(PW); SBAR(); }while(0)
  #define EX(v) __builtin_amdgcn_exp2f(v)
  #define GAPB(MF,X,B) do{ MF; X[B]=EX(X[B]); X[B+1]=EX(X[B+1]); X[B+2]=EX(X[B+2]); X[B+3]=EX(X[B+3]); PIN(X); SBAR(); }while(0)
  #define VRD(i) do{ vlo[i]=vtr(vp_+(((i)>>2)*4096+((i)&3)*1024)); vhi[i]=vtr(vp_+(((i)>>2)*4096+((i)&3)*1024+512)); }while(0)
  #define KRD(G,j) do{ if(G){ kload2(kf,kp0+sl_next,j); SBAR(); } }while(0)
  #define STEP(C0,C1,P0,P1,t,GK,GV,GL) do{ SBAR(); \
    const lds_cptr vp_=vp0+sl_prev; \
    VRD(0); SBAR(); float sacc=(P0[0]+P0[1]); \
    GAPA(C0=__builtin_amdgcn_mfma_f32_32x32x16_bf16(kf[0],qr[0],negm,0,0,0), P0[2],P0[3],P0[4],P0[5],     pw0[0]=PKW(P0,0), pw0[1]=PKW(P0,2), pw0); \
    VRD(4); SBAR(); GAPA(C1=__builtin_amdgcn_mfma_f32_32x32x16_bf16(kf[1],qr[0],negm,0,0,0), P0[6],P0[7],P0[8],P0[9],     pw0[2]=PKW(P0,4), pw0[3]=PKW(P0,6), pw0); \
    VRD(1); SBAR(); GAPA(C0=__builtin_amdgcn_mfma_f32_32x32x16_bf16(kf[2],qr[1],C0,0,0,0),   P0[10],P0[11],P0[12],P0[13], pw1[0]=PKW(P0,8), pw1[1]=PKW(P0,10), pw1); \
    VRD(5); SBAR(); GAPA(C1=__builtin_amdgcn_mfma_f32_32x32x16_bf16(kf[3],qr[1],C1,0,0,0),   P0[14],P0[15],P1[0],P1[1],   pw1[2]=PKW(P0,12),pw1[3]=PKW(P0,14), pw1); \
    VRD(2); SBAR(); GAPA(C0=__builtin_amdgcn_mfma_f32_32x32x16_bf16(kf[4],qr[2],C0,0,0,0),   P1[2],P1[3],P1[4],P1[5],     pw2[0]=PKW(P1,0), pw2[1]=PKW(P1,2), pw2); \
    VRD(6); SBAR(); GAPA(C1=__builtin_amdgcn_mfma_f32_32x32x16_bf16(kf[5],qr[2],C1,0,0,0),   P1[6],P1[7],P1[8],P1[9],     pw2[2]=PKW(P1,4), pw2[3]=PKW(P1,6), pw2); \
    VRD(3); SBAR(); GAPA(C0=__builtin_amdgcn_mfma_f32_32x32x16_bf16(kf[6],qr[3],C0,0,0,0),   P1[10],P1[11],P1[12],P1[13], pw3[0]=PKW(P1,8), pw3[1]=PKW(P1,10), pw3); \
    VRD(7); SBAR(); GAPA(C1=__builtin_amdgcn_mfma_f32_32x32x16_bf16(kf[7],qr[3],C1,0,0,0),   P1[14],P1[15],0.f,0.f,       pw3[2]=PKW(P1,12),pw3[3]=PKW(P1,14), pw3); \
    l_reg+=sacc; \
    if(GK){DMA_K((t)+3,sl_cur);} if(GV){DMA_V((t)+1,sl_next);} \
    FBIAS(C0,C1,t); CMASK(C0,C1,t); \
    { float a=MX3(C0[0],C0[1],C1[0]),b=MX3(C0[2],C0[3],C1[1]); a=MX3(a,C1[2],C1[3]); \
      _Pragma("unroll") for(int r=4;r<16;r+=4){a=MX3(a,C0[r],C0[r+1]);b=MX3(b,C0[r+2],C0[r+3]);a=MX3(a,C1[r],C1[r+1]);b=MX3(b,C1[r+2],C1[r+3]);} \
      float rm=__builtin_fmaxf(a,b); { auto rr=__builtin_amdgcn_permlane32_swap(__float_as_uint(rm),__float_as_uint(rm),false,false); rm=__builtin_fmaxf(__uint_as_float(rr[0]),__uint_as_float(rr[1])); } \
      resc=false; \
      if(__builtin_expect(__any(rm>(float)THRL),0)){ const float dl=__builtin_fmaxf(rm,0.f); mhat+=dl; \
        _Pragma("unroll") for(int r=0;r<16;++r){C0[r]-=dl;C1[r]-=dl;} \
        _Pragma("unroll") for(int r=0;r<16;++r)negm[r]=-mhat; asm volatile("":"+v"(negm)); \
        const float f=__builtin_amdgcn_exp2f(-dl); l_reg*=f; if(hi==0)wsf[r32]=f; resc=true; } } \
    SBAR(); \
    GAPB(o[0]=__builtin_amdgcn_mfma_f32_32x32x16_bf16(PAF(0),VFR(0),o[0],0,0,0), C0,0); \
    GAPB(o[1]=__builtin_amdgcn_mfma_f32_32x32x16_bf16(PAF(0),VFR(4),o[1],0,0,0), C0,4); \
    KRD(GL,0); GAPB(o[0]=__builtin_amdgcn_mfma_f32_32x32x16_bf16(PAF(1),VFR(1),o[0],0,0,0), C0,8); \
    KRD(GL,1); GAPB(o[1]=__builtin_amdgcn_mfma_f32_32x32x16_bf16(PAF(1),VFR(5),o[1],0,0,0), C0,12); \
    KRD(GL,2); GAPB(o[0]=__builtin_amdgcn_mfma_f32_32x32x16_bf16(PAF(2),VFR(2),o[0],0,0,0), C1,0); \
    KRD(GL,3); GAPB(o[1]=__builtin_amdgcn_mfma_f32_32x32x16_bf16(PAF(2),VFR(6),o[1],0,0,0), C1,4); \
    GAPB(o[0]=__builtin_amdgcn_mfma_f32_32x32x16_bf16(PAF(3),VFR(3),o[0],0,0,0), C1,8); \
    GAPB(o[1]=__builtin_amdgcn_mfma_f32_32x32x16_bf16(PAF(3),VFR(7),o[1],0,0,0), C1,12); \
    }while(0)
  int t=1;
  #undef CMASK
  #define CMASK(P0,P1,t) do{}while(0)
  for(;t+5<NT;t+=2){
    STEP(pB0,pB1,pA0,pA1,t,true,true,true);     WAIT_BAR(2); RESC(); ROT();
    STEP(pA0,pA1,pB0,pB1,t+1,true,true,true);   WAIT_BAR(2); RESC(); ROT();
  }
  #undef CMASK
  #define CMASK(P0,P1,t) do{int jb_=(t)-(NT-4); if(jb_>=0)cmask(P0,P1,jb_,qrel,hi);}while(0)
  #define ENDW(tt) do{ if((tt)+3<NT){WAIT_BAR(2);} else if((tt)+2<NT){WAIT_BAR(1);} else {WAIT_BAR(0);} }while(0)
  for(;t+1<NT;t+=2){
    STEP(pB0,pB1,pA0,pA1,t,(t+3<NT),(t+1<NT),(t+1<NT));       ENDW(t);   RESC(); ROT();
    STEP(pA0,pA1,pB0,pB1,t+1,(t+4<NT),(t+2<NT),(t+2<NT));     ENDW(t+1); RESC(); ROT();
  }
  STEP(pB0,pB1,pA0,pA1,NT-1,false,false,false); RESC();
  { float sacc=pB0[0]+pB0[1]; _Pragma("unroll") for(int r=2;r<16;++r)sacc+=pB0[r]; _Pragma("unroll") for(int r=0;r<16;++r)sacc+=pB1[r]; l_reg+=sacc;
    pw0=(u32x4){PKW(pB0,0),PKW(pB0,2),PKW(pB0,4),PKW(pB0,6)};pw1=(u32x4){PKW(pB0,8),PKW(pB0,10),PKW(pB0,12),PKW(pB0,14)};pw2=(u32x4){PKW(pB1,0),PKW(pB1,2),PKW(pB1,4),PKW(pB1,6)};pw3=(u32x4){PKW(pB1,8),PKW(pB1,10),PKW(pB1,12),PKW(pB1,14)};
    SBAR(); pv(o,vb0+sl_cur,PAF(0),PAF(1),PAF(2),PAF(3)); }
  #undef PKW
  #undef PAF
  #undef VFR
  #undef PIN
  #undef MX3
  #undef GAPA
  #undef GAPB
  #undef EX
  #undef VRD
  #undef KRD
  #undef STEP
  #undef ENDW
  {auto rr=__builtin_amdgcn_permlane32_swap(__float_as_uint(l_reg),__float_as_uint(l_reg),false,false);l_reg=__uint_as_float(rr[0])+__uint_as_float(rr[1]);}
  if(hi==0)wsf[32+r32]=l_reg;asm volatile("s_waitcnt lgkmcnt(0)":::"memory");
  float rli[16];
  #pragma unroll
  for(int r=0;r<16;++r)rli[r]=__builtin_amdgcn_rcpf(wsf[32+crow(r,hi)]);
  bf16*Ow=O+(rowbase+q0+wid*QBLK)*OPITCH+h*D;
  { bf16*stg=(bf16*)(shm+LDS_OST)+wid*2048;
    #pragma unroll
    for(int r=0;r<16;++r){const int orow=crow(r,hi);
      #pragma unroll
      for(int d0=0;d0<2;++d0)stg[orow*64+d0*32+r32]=__float2bfloat16(o[d0][r]*rli[r]);}
    asm volatile("s_waitcnt lgkmcnt(0)":::"memory");
    #pragma unroll
    for(int i=0;i<4;++i){const int row=i*8+(lane>>3),ch=lane&7; const u32x4 v=*(const u32x4*)(stg+row*64+ch*8);
      float f[8]; f[0]=__uint_as_float(v.x<<16);f[1]=__uint_as_float(v.x&0xffff0000u);f[2]=__uint_as_float(v.y<<16);f[3]=__uint_as_float(v.y&0xffff0000u);
      f[4]=__uint_as_float(v.z<<16);f[5]=__uint_as_float(v.z&0xffff0000u);f[6]=__uint_as_float(v.w<<16);f[7]=__uint_as_float(v.w&0xffff0000u);
      float ss=0.f;
      #pragma unroll
      for(int j=0;j<8;++j)ss+=f[j]*f[j];
      ss+=__shfl_xor(ss,1);ss+=__shfl_xor(ss,2);ss+=__shfl_xor(ss,4);
      const float rs=1.0f/sqrtf(ss*(1.0f/64.0f)+1e-6f);
      const f32x4v g0=*(const f32x4v*)(gfox+h*D+ch*8),g1=*(const f32x4v*)(gfox+h*D+ch*8+4);
      u32x4 w; w.x=cvtpk_s(f[0]*rs*g0[0],f[1]*rs*g0[1]); w.y=cvtpk_s(f[2]*rs*g0[2],f[3]*rs*g0[3]); w.z=cvtpk_s(f[4]*rs*g1[0],f[5]*rs*g1[1]); w.w=cvtpk_s(f[6]*rs*g1[2],f[7]*rs*g1[3]);
      ATTN_STORE16(Ow+(long)row*OPITCH+ch*8,w);} }
  asm volatile("s_waitcnt lgkmcnt(0)\n\ts_barrier":::"memory");
  #undef DMA_K
  #undef DMA_V
  #undef CMASK
  #undef FBIAS
  #undef START
  #undef RESC
  #undef ROT
}
constexpr int ATTN_LDS_BYTES=LDS_BYTES;
#undef SBAR
#undef WAIT_BAR
}
#include <hip/hip_cooperative_groups.h>
namespace cg = cooperative_groups;
constexpr int NWAVES = 8, NTHR = 512;
constexpr int BATCH = 16, SEQ = 4096, DM = 1024, FF = 4096, M = BATCH * SEQ, PLE = 256, NZ = 3840, WIN_LD = 3600;
constexpr float EPS = 1e-6f;
constexpr size_t MiB = 1u << 20;
constexpr size_t WS_WIN = 2 * MiB, WS_WOUT = 10 * MiB, WS_WUP = 12 * MiB, WS_WDN = 20 * MiB, WS_WPG = 28 * MiB, WS_WPLE = 30 * MiB;
constexpr size_t WS_XN = 32 * MiB;
constexpr size_t WS_Z = 160 * MiB;
constexpr size_t WS_QC = 544 * MiB, WS_KC = 608 * MiB;
constexpr size_t WS_H = 160 * MiB;
constexpr size_t WS_MO = 672 * MiB, WS_MIX = 736 * MiB, WS_G = 864 * MiB, WS_PB = 868 * MiB, WS_RSTD = 900 * MiB, WS_END = 902 * MiB;
constexpr int RING_BYTES = 131072, LDS_TOTAL = 147456;
#define LAS __attribute__((address_space(3)))
typedef unsigned short bf16;
typedef unsigned v4u __attribute__((ext_vector_type(4)));
typedef unsigned v2u __attribute__((ext_vector_type(2)));
typedef float f32x4 __attribute__((ext_vector_type(4)));
typedef float f32x2 __attribute__((ext_vector_type(2)));
__device__ __forceinline__ unsigned f2bf(float f) { unsigned u = __builtin_bit_cast(unsigned, f); return (u + 0x7fffu + ((u >> 16) & 1u)) >> 16; }
__device__ __forceinline__ unsigned pk2(float lo, float hi) { return f2bf(lo) | (f2bf(hi) << 16); }
__device__ __forceinline__ float bflo(unsigned w) { return __uint_as_float(w << 16); }
__device__ __forceinline__ float bfhi(unsigned w) { return __uint_as_float(w & 0xffff0000u); }
__device__ __forceinline__ float wave_sum(float v) {
#pragma unroll
    for (int o = 1; o < 64; o <<= 1) v += __shfl_xor(v, o);
    return v;
}
__device__ __forceinline__ void block_seam() {
    asm volatile("s_waitcnt vmcnt(0) lgkmcnt(0)" ::: "memory");
    __syncthreads();
    __builtin_amdgcn_fence(__ATOMIC_ACQUIRE, "agent");
    asm volatile("s_waitcnt vmcnt(0)" ::: "memory");
}
__device__ __forceinline__ void p0_transpose_item(const float* W, int ldw, int ncols, int K, bf16* WT, int row_off, const float* gain, LAS float* scr, int item, int lane) {
    const int nblk = ncols / 32, kb = item / nblk, nb = item % nblk, k0 = 64 * kb, n0 = 32 * nb;
#pragma unroll 8
    for (int i = 0; i < 32; ++i) { const int kk = 2 * i + (lane >> 5); float v = W[(size_t)(k0 + kk) * ldw + n0 + (lane & 31)]; if (gain) v *= gain[k0 + kk]; scr[kk * 33 + (lane & 31)] = v; }
    asm volatile("s_waitcnt lgkmcnt(0)" ::: "memory");
    const int c = lane & 7;
#pragma unroll
    for (int j = 0; j < 4; ++j) { const int n = (lane >> 3) + 8 * j; const LAS float* s = scr + (8 * c) * 33 + n;
        v4u o; o.x = pk2(s[0 * 33], s[1 * 33]); o.y = pk2(s[2 * 33], s[3 * 33]); o.z = pk2(s[4 * 33], s[5 * 33]); o.w = pk2(s[6 * 33], s[7 * 33]);
        *(v4u*)(WT + (size_t)(row_off + n0 + n) * K + k0 + 8 * c) = o; }
    asm volatile("s_waitcnt lgkmcnt(0)" ::: "memory");
}
__device__ __forceinline__ int gate_src_col(int j) { return j < 8 ? 1536 + j : (j < 12 ? 3080 + (j - 8) : 3084 + (j - 12)); }

template <class T> __device__ __forceinline__ T* opq(T* p) { asm volatile("" : "+s"(p)); return p; }
struct Args { const float* in[18]; float* out; unsigned char* ws; };

__device__ __forceinline__ void p0_prologue(const Args& A, unsigned char* ws, LAS unsigned char* lds, int tid, int lane, int wave, int bx, int G) {
    LAS float* scr = (LAS float*)(lds + wave * 16384);
    const int gw = bx * NWAVES + wave, NGW = G * NWAVES;
    const float* w_in = A.in[2];
    bf16* WinT = (bf16*)(ws + WS_WIN); bf16* WoutT = (bf16*)(ws + WS_WOUT); bf16* WupT = (bf16*)(ws + WS_WUP); bf16* WdnT = (bf16*)(ws + WS_WDN); bf16* WpgT = (bf16*)(ws + WS_WPG); bf16* WpleT = (bf16*)(ws + WS_WPLE);
    constexpr int I_SEG = 16 * 16, I_IN = 7 * I_SEG, I_OUT = 16 * 32, I_UP = 16 * 128, I_DN = 64 * 32, I_PG = 16 * 32, I_PLE = 4 * 32;
    constexpr int NITEMS = I_IN + I_OUT + I_UP + I_DN + I_PG + I_PLE;
    for (int it = gw; it < NITEMS; it += NGW) {
        int r = it;
        if (r < I_IN) { const int s = r / I_SEG; const int srcc = (s == 0) ? 0 : (s == 1) ? 512 : (s == 2) ? 1024 : (s == 3) ? 1544 : (s == 4) ? 2056 : (s == 5) ? 2568 : 3088;
            p0_transpose_item(w_in + srcc, WIN_LD, 512, DM, WinT, 512 * s, nullptr, scr, r % I_SEG, lane); continue; } r -= I_IN;
        if (r < I_OUT) { p0_transpose_item(A.in[10], DM, DM, DM, WoutT, 0, nullptr, scr, r, lane); continue; } r -= I_OUT;
        if (r < I_UP) { p0_transpose_item(A.in[12], FF, FF, DM, WupT, 0, A.in[11], scr, r, lane); continue; } r -= I_UP;
        if (r < I_DN) { p0_transpose_item(A.in[13], DM, DM, FF, WdnT, 0, nullptr, scr, r, lane); continue; } r -= I_DN;
        if (r < I_PG) { p0_transpose_item(A.in[16], DM, DM, DM, WpgT, 0, A.in[15], scr, r, lane); continue; } r -= I_PG;
        p0_transpose_item(A.in[14], DM, DM, PLE, WpleT, 0, nullptr, scr, r, lane);
    }
    const int gt = bx * NTHR + tid, NGT = G * NTHR;
    for (int i = gt; i < 16 * DM; i += NGT) { const int j = i >> 10, k = i & 1023; WinT[(size_t)(3584 + j) * DM + k] = (bf16)f2bf(w_in[(size_t)k * WIN_LD + gate_src_col(j)]); }
    for (int i = gt; i < 240 * DM / 8; i += NGT) ((v4u*)(WinT + (size_t)3600 * DM))[i] = (v4u){0u, 0u, 0u, 0u};
    { const f32x4* p4 = (const f32x4*)A.in[1]; v4u* pb = (v4u*)(ws + WS_PB);
      for (int i = gt; i < M * PLE / 8; i += NGT) { const f32x4 a = p4[2 * i], b = p4[2 * i + 1]; pb[i] = (v4u){pk2(a[0], a[1]), pk2(a[2], a[3]), pk2(b[0], b[1]), pk2(b[2], b[3])}; } }
    { const float* x = A.in[0]; const f32x4* g4 = (const f32x4*)A.in[7]; bf16* XN = (bf16*)(ws + WS_XN);
      f32x4 gv[4];
#pragma unroll
      for (int j = 0; j < 4; ++j) gv[j] = g4[lane + 64 * j];
      for (int m = gw; m < M; m += NGW) {
          const f32x4* xr = (const f32x4*)(x + (size_t)m * DM) + lane; f32x4 v[4]; float s = 0.f;
#pragma unroll
          for (int j = 0; j < 4; ++j) { v[j] = xr[64 * j]; s += (v[j][0] * v[j][0] + v[j][1] * v[j][1]) + (v[j][2] * v[j][2] + v[j][3] * v[j][3]); }
          const float rstd = 1.0f / sqrtf(wave_sum(s) * (1.f / DM) + EPS);
          v2u* o8 = (v2u*)(XN + (size_t)m * DM) + lane;
#pragma unroll
          for (int j = 0; j < 4; ++j) { const f32x4 y = v[j] * rstd * gv[j]; o8[64 * j] = (v2u){pk2(y[0], y[1]), pk2(y[2], y[3])}; }
      } }
}

__device__ __forceinline__ void conv_silu_phase(const float* w_conv, const bf16* MQ, const bf16* MK, bf16* QC, bf16* KC, int gt, int NGT) {
    for (int it = gt; it < 2 * (M / 32) * 64; it += NGT) {
        const int cgi = it & 63, rb = (it >> 6) & (M / 32 - 1), ten = it >> 17;
        const bf16* src = (ten ? MK : MQ) + cgi * 8; bf16* dst = (ten ? KC : QC) + cgi * 8;
        const float osc = ten ? 0.08838834764831845f : 1.0f;
        float w[4][8];
#pragma unroll
        for (int j = 0; j < 4; ++j) { const f32x4 a = *(const f32x4*)(w_conv + j * 1024 + ten * 512 + cgi * 8), b = *(const f32x4*)(w_conv + j * 1024 + ten * 512 + cgi * 8 + 4);
            w[j][0] = a[0]; w[j][1] = a[1]; w[j][2] = a[2]; w[j][3] = a[3]; w[j][4] = b[0]; w[j][5] = b[1]; w[j][6] = b[2]; w[j][7] = b[3]; }
        const int t0 = rb * 32; const bool first = (t0 % SEQ) == 0;
        float h0[8], h1[8], h2[8];
#pragma unroll
        for (int i = 0; i < 8; ++i) { h0[i] = 0.f; h1[i] = 0.f; h2[i] = 0.f; }
        if (!first) {
            const v4u a = *(const v4u*)(src + (size_t)(t0 - 3) * 512), b = *(const v4u*)(src + (size_t)(t0 - 2) * 512), c = *(const v4u*)(src + (size_t)(t0 - 1) * 512);
#pragma unroll
            for (int i = 0; i < 4; ++i) { h0[2 * i] = bflo(a[i]); h0[2 * i + 1] = bfhi(a[i]); h1[2 * i] = bflo(b[i]); h1[2 * i + 1] = bfhi(b[i]); h2[2 * i] = bflo(c[i]); h2[2 * i + 1] = bfhi(c[i]); }
        }
#pragma unroll 8
        for (int r = 0; r < 32; ++r) {
            const v4u cu = *(const v4u*)(src + (size_t)(t0 + r) * 512); float c[8], o[8];
#pragma unroll
            for (int i = 0; i < 4; ++i) { c[2 * i] = bflo(cu[i]); c[2 * i + 1] = bfhi(cu[i]); }
#pragma unroll
            for (int i = 0; i < 8; ++i) { const float y = w[0][i] * h0[i] + w[1][i] * h1[i] + w[2][i] * h2[i] + w[3][i] * c[i];
                o[i] = osc * y / (1.f + __expf(-y)); h0[i] = h1[i]; h1[i] = h2[i]; h2[i] = c[i]; }
            *(v4u*)(dst + (size_t)(t0 + r) * 512) = (v4u){pk2(o[0], o[1]), pk2(o[2], o[3]), pk2(o[4], o[5]), pk2(o[6], o[7])};
        }
    }
}

__device__ __forceinline__ void fox_cumsum(LAS float* CB, LAS float* red, const float* Gt, float bias, int b, int h, int tid, int lane, int wave) {
    float v[8]; const float* base = Gt + ((size_t)b * SEQ + tid * 8) * 16 + h;
#pragma unroll
    for (int i = 0; i < 8; ++i) { const float z = base[i * 16] + bias; v[i] = (fminf(z, 0.f) - log1pf(expf(-fabsf(z)))) * 1.4426950408889634f; }
#pragma unroll
    for (int i = 1; i < 8; ++i) v[i] += v[i - 1];
    const float tot = v[7]; float sc = tot;
#pragma unroll
    for (int o = 1; o < 64; o <<= 1) { const float n = __shfl_up(sc, o); if (lane >= o) sc += n; }
    if (lane == 63) red[wave] = sc;
    __syncthreads();
    float off = sc - tot;
    for (int w = 0; w < wave; ++w) off += red[w];
#pragma unroll
    for (int i = 0; i < 8; ++i) CB[tid * 8 + i] = v[i] + off;
    __syncthreads();
}

__device__ __forceinline__ void mlstm_naive_item(int item, const bf16* QC, const bf16* KC, const bf16* MV, const float* Gt, const float* b_i, const float* b_f, float* HRAW, int lane, int wave) {
    const int es = item & 3, hd = (item >> 2) & 3, b = item >> 4;
    const int ecol = hd * 128 + es * 32 + wave * 4, dcol = hd * 128 + 2 * lane;
    const float bi = b_i[hd], bff = b_f[hd];
    float C0[4] = {0.f, 0.f, 0.f, 0.f}, C1[4] = {0.f, 0.f, 0.f, 0.f}, n0 = 0.f, n1 = 0.f;
    const size_t row0 = (size_t)b * SEQ;
    for (int t0 = 0; t0 < SEQ; t0 += 8) {
        unsigned qv[8], kv[8]; v2u vv[8]; float gi[8], gf[8];
#pragma unroll
        for (int u = 0; u < 8; ++u) { const size_t row = row0 + t0 + u;
            qv[u] = *(const unsigned*)(QC + row * 512 + dcol); kv[u] = *(const unsigned*)(KC + row * 512 + dcol); vv[u] = *(const v2u*)(MV + row * 512 + ecol);
            gi[u] = Gt[row * 16 + 8 + hd]; gf[u] = Gt[row * 16 + 12 + hd]; }
#pragma unroll
        for (int u = 0; u < 8; ++u) {
            const float f = 1.f / (1.f + expf(-(gf[u] + bff))), ig = expf(gi[u] + bi);
            const float q0 = bflo(qv[u]), q1 = bfhi(qv[u]), k0 = ig * bflo(kv[u]), k1 = ig * bfhi(kv[u]);
            const float ve[4] = {bflo(vv[u].x), bfhi(vv[u].x), bflo(vv[u].y), bfhi(vv[u].y)};
            n0 = f * n0 + k0; n1 = f * n1 + k1;
            float pn[4], pd = q0 * n0 + q1 * n1;
#pragma unroll
            for (int e = 0; e < 4; ++e) { C0[e] = f * C0[e] + k0 * ve[e]; C1[e] = f * C1[e] + k1 * ve[e]; pn[e] = q0 * C0[e] + q1 * C1[e]; }
            pd = wave_sum(pd);
#pragma unroll
            for (int e = 0; e < 4; ++e) pn[e] = wave_sum(pn[e]);
            const float inv = 1.f / fmaxf(fabsf(pd), 1.f);
            if (lane == 0) *(f32x4*)(HRAW + (row0 + t0 + u) * 512 + ecol) = (f32x4){pn[0] * inv, pn[1] * inv, pn[2] * inv, pn[3] * inv};
        }
    }
}

__device__ __forceinline__ void mlstm_finalize_panel(int pm, const float* HRAW, const bf16* MO, const float* g, bf16* MIX, int lane, int wave) {
    for (int i = wave; i < 256 * 4; i += NWAVES) { const int row = pm * 256 + (i >> 2), hd = i & 3; const size_t o = (size_t)row * 512 + hd * 128 + 2 * lane;
        const f32x2 h = *(const f32x2*)(HRAW + o); const float ss = wave_sum(h[0] * h[0] + h[1] * h[1]); const float rs = 1.0f / sqrtf(ss * (1.f / 128.f) + EPS);
        const unsigned mo = *(const unsigned*)(MO + o); const f32x2 gg = *(const f32x2*)(g + hd * 128 + 2 * lane);
        const float a = h[0] * rs * gg[0] / (1.f + __expf(-bflo(mo))), b = h[1] * rs * gg[1] / (1.f + __expf(-bfhi(mo)));
        *(unsigned*)(MIX + (size_t)row * 1024 + 512 + hd * 128 + 2 * lane) = pk2(a, b); }
}
__device__ __forceinline__ void panel_rstd(int pm, const float* X, float* RSTD, int lane, int wave) {
    for (int i = wave; i < 256; i += NWAVES) { const int row = pm * 256 + i; const f32x4* xr = (const f32x4*)(X + (size_t)row * DM) + lane; float s = 0.f;
#pragma unroll
        for (int j = 0; j < 4; ++j) { const f32x4 v = xr[64 * j]; s += (v[0] * v[0] + v[1] * v[1]) + (v[2] * v[2] + v[3] * v[3]); }
        s = wave_sum(s); if (lane == 0) RSTD[row] = 1.0f / sqrtf(s * (1.f / DM) + EPS); }
}
__device__ __forceinline__ void panel_final_norm(int pm, float* X, const float* g, int lane, int wave) {
    const f32x4* g4 = (const f32x4*)g;
    for (int i = wave; i < 256; i += NWAVES) { const int row = pm * 256 + i; f32x4* xr = (f32x4*)(X + (size_t)row * DM) + lane; f32x4 v[4]; float s = 0.f;
#pragma unroll
        for (int j = 0; j < 4; ++j) { v[j] = xr[64 * j]; s += (v[j][0] * v[j][0] + v[j][1] * v[j][1]) + (v[j][2] * v[j][2] + v[j][3] * v[j][3]); }
        const float rs = 1.0f / sqrtf(wave_sum(s) * (1.f / DM) + EPS);
#pragma unroll
        for (int j = 0; j < 4; ++j) xr[64 * j] = v[j] * rs * g4[lane + 64 * j]; }
}

__global__ void __launch_bounds__(NTHR, 2) hymba_fwd(Args args) {
    extern __shared__ __attribute__((aligned(16))) unsigned char lds[];
    cg::grid_group grid = cg::this_grid();
    LAS unsigned char* L = (LAS unsigned char*)lds;
#define FRESH_TID() int tid_ = threadIdx.x; asm volatile("" : "+v"(tid_)); const int tid = tid_, lane = tid & 63, wave = __builtin_amdgcn_readfirstlane(tid >> 6); (void)lane; (void)wave
    const int G = gridDim.x, bx = blockIdx.x;
    unsigned char* ws = args.ws;
    bf16* XN = (bf16*)(ws + WS_XN); float* HRAW = (float*)(ws + WS_XN); bf16* XB = (bf16*)(ws + WS_XN);
    bf16* Z = (bf16*)(ws + WS_Z); bf16* QC = (bf16*)(ws + WS_QC); bf16* KC = (bf16*)(ws + WS_KC); bf16* MO = (bf16*)(ws + WS_MO);
    bf16* MIX = (bf16*)(ws + WS_MIX); float* Gt = (float*)(ws + WS_G); bf16* PB = (bf16*)(ws + WS_PB); float* RSTD = (float*)(ws + WS_RSTD);
    bf16* Hb = (bf16*)(ws + WS_H);
    constexpr size_t ZS = (size_t)M * 512;

    { FRESH_TID(); p0_prologue(args, ws, L, tid, lane, wave, bx, G); }
    grid.sync();

    {
        pg8::Gemm g{opq(XN), opq((const bf16*)(ws + WS_WIN)), M, NZ, DM}; pg8::StaticOrder S; S.init(M, NZ, G, bx);
        pg8::EpiZ E{Z, ZS, MO, Gt, attn_body::C2};
        pg8::gemm_phase<pg8::EpiZ, pg8::StaticOrder, true, true>(L, g, S, E);
    }
    grid.sync();

    { FRESH_TID(); conv_silu_phase(args.in[6], Z + 3 * ZS, Z + 4 * ZS, QC, KC, bx * NTHR + tid, G * NTHR); }
    {
        FRESH_TID();
        const int vcu0 = (G % 8 == 0) ? (bx % 8) * (G / 8) + bx / 8 : bx;
        if (vcu0 < 256) { const int v = vcu0;
            const int bh = v >> 1, half = v & 1, b = bh >> 3, h = bh & 7;
            __syncthreads();
            fox_cumsum((LAS float*)(L + attn_body::LDS_CB), (LAS float*)(L + attn_body::LDS_CB + 16384), Gt, args.in[3][h], b, h, tid, lane, wave);
            for (int i = 0; i < 8; ++i) { const int s = 2 * (i >> 1) + half; const int qb = (i & 1) ? 15 - s : s;
                attn_body::attn_unit<8>(b, h, qb, (const attn_body::bf16*)Z, (const attn_body::bf16*)(Z + ZS), (const attn_body::bf16*)(Z + 2 * ZS), (attn_body::bf16*)MIX, args.in[8], (char*)lds); }
        }
    }
    grid.sync();

    { FRESH_TID(); for (int item = bx; item < 256; item += G) mlstm_naive_item(item, QC, KC, Z + 5 * ZS, Gt, args.in[4], args.in[5], HRAW, lane, wave); }
    grid.sync();

    if (bx < M / 256) { const int pm = bx;
        { FRESH_TID(); mlstm_finalize_panel(pm, HRAW, MO, args.in[9], MIX, lane, wave); }
        block_seam();
        { pg8::Gemm g{opq(MIX), opq((const bf16*)(ws + WS_WOUT)), M, DM, DM}; pg8::PanelOrder S{pm, 4}; pg8::EpiRes E{opq(args.in[0]), opq(args.out), opq(XB)};
          pg8::gemm_phase<pg8::EpiRes, pg8::PanelOrder, true, true>(L, g, S, E); }
        block_seam();
        { FRESH_TID(); panel_rstd(pm, args.out, RSTD, lane, wave); }
        block_seam();
        { pg8::Gemm g{opq(XB), opq((const bf16*)(ws + WS_WUP)), M, FF, DM}; pg8::PanelOrder S{pm, 16}; pg8::EpiUp E{opq(Hb), opq(RSTD)};
          pg8::gemm_phase<pg8::EpiUp, pg8::PanelOrder, true, true>(L, g, S, E); }
        block_seam();
        { pg8::Gemm g{opq(Hb), opq((const bf16*)(ws + WS_WDN)), M, DM, FF}; pg8::PanelOrder S{pm, 4}; float* o_ = opq(args.out); pg8::EpiRes E{o_, o_, opq(XB)};
          pg8::gemm_phase<pg8::EpiRes, pg8::PanelOrder, true, true>(L, g, S, E); }
        block_seam();
        { FRESH_TID(); panel_rstd(pm, args.out, RSTD, lane, wave); }
        bf16* PLp = Hb + (size_t)pm * 256 * FF - (size_t)pm * 256 * DM;
        { pg8::Gemm g{opq(PB), opq((const bf16*)(ws + WS_WPLE)), M, DM, PLE}; pg8::PanelOrder S{pm, 4}; pg8::EpiPlain E{opq(PLp), DM};
          pg8::gemm_phase<pg8::EpiPlain, pg8::PanelOrder, true, true>(L, g, S, E); }
        block_seam();
        { pg8::Gemm g{opq(XB), opq((const bf16*)(ws + WS_WPG)), M, DM, DM}; pg8::PanelOrder S{pm, 4}; pg8::EpiGate E{opq(args.out), opq((const bf16*)PLp), opq(RSTD)};
          pg8::gemm_phase<pg8::EpiGate, pg8::PanelOrder, true, true>(L, g, S, E); }
        block_seam();
        { FRESH_TID(); panel_final_norm(pm, args.out, args.in[17], lane, wave); }
        block_seam();
    }
}

extern "C" void kernel_launch(void* const* d_in, const int* in_sizes, int n_in, void* d_out, int out_size, void* d_ws, size_t ws_size, hipStream_t stream) {
    static int grid = 0;
    if (grid == 0) {
        if (n_in != 18 || in_sizes[0] != M * DM || out_size != M * DM || ws_size < WS_END) { fprintf(stderr, "kernel_launch: unexpected shapes (n_in %d, in0 %d, out %d, ws %zu)\n", n_in, n_in > 0 ? in_sizes[0] : -1, out_size, ws_size); grid = -1; return; }
        int dev = 0, cus = 0, per_cu = 0;
        if (hipGetDevice(&dev) != hipSuccess || hipDeviceGetAttribute(&cus, hipDeviceAttributeMultiprocessorCount, dev) != hipSuccess) { grid = -1; return; }
        if (hipFuncSetAttribute((const void*)hymba_fwd, hipFuncAttributeMaxDynamicSharedMemorySize, LDS_TOTAL) != hipSuccess) { fprintf(stderr, "kernel_launch: hipFuncSetAttribute failed\n"); grid = -1; return; }
        if (hipOccupancyMaxActiveBlocksPerMultiprocessor(&per_cu, (const void*)hymba_fwd, NTHR, LDS_TOTAL) != hipSuccess || per_cu < 1) { fprintf(stderr, "kernel_launch: occupancy query says %d\n", per_cu); per_cu = 1; }
        (void)hipGetLastError();
        grid = cus * per_cu;
        if (grid > 256) grid = 256;
    }
    if (grid < 0) return;
    Args a{};
    for (int i = 0; i < 18; ++i) a.in[i] = (const float*)d_in[i];
    a.out = (float*)d_out; a.ws = (unsigned char*)d_ws;
    void* params[] = {&a};
    hipError_t e = hipLaunchCooperativeKernel((const void*)hymba_fwd, dim3(grid), dim3(NTHR), params, LDS_TOTAL, stream);
    if (e != hipSuccess) fprintf(stderr, "kernel_launch: cooperative launch failed: %s (grid %d)\n", hipGetErrorString(e), grid);
}
```

```cpp
#include <hip/hip_runtime.h>
#include <cstdio>
#include <cstdint>
namespace pg8 {
#define PG8_LAS __attribute__((address_space(3)))
typedef unsigned short bf16_t;
typedef short bf16x8 __attribute__((ext_vector_type(8)));
typedef float f32x4 __attribute__((ext_vector_type(4)));
typedef unsigned u32x4 __attribute__((ext_vector_type(4)));
constexpr int BM = 256, BK = 64, HALF = 128, HTB = HALF * BK * 2  , STAGE_BYTES = 8 * HTB, NXCD = 8, WGM = 8;

__host__ __device__ __forceinline__ int lds_byte(int r, int c) { const int st = (r >> 4) * 2 + (c >> 5), rr = r & 15, cc = c & 31, ob = rr * 64 + cc * 2; return st * 1024 + (ob ^ (((ob >> 9) & 1) << 5)); }
__host__ __device__ __forceinline__ void stage_rc(int b, int& R, int& C) { const int st = b / 1024, sb = b % 1024, swz = sb ^ (((sb >> 9) & 1) << 5); R = (st >> 1) * 16 + swz / 64; C = (st & 1) * 32 + (swz % 64) / 2; }
__host__ __device__ __forceinline__ int perm32(int rho) { const int n = rho >> 4, i = rho & 15; return 8 * (i >> 2) + 4 * n + (i & 3); }

struct Unit { int pm, pn; };
struct Gemm { const bf16_t* A; const bf16_t* Bt; int M, N, K; };

struct StaticOrder {
    int nM, nN, nwg, G, c;
    __host__ __device__ void init(int M, int N, int G_, int c_) { nM = M / BM; nN = N / BM; nwg = nM * nN; G = G_; c = c_; }
    __host__ __device__ bool next(int i, Unit& u) const {
        const long L = (long)i * G + c; if (L >= nwg) return false;
        int wgid = (int)L; { const int q = nwg / NXCD, r = nwg % NXCD, xcd = wgid % NXCD, off = wgid / NXCD; wgid = (xcd < r ? xcd * (q + 1) : r * (q + 1) + (xcd - r) * q) + off; }
        const int nig = WGM * nN, gid = wgid / nig, fm = gid * WGM, gsz = (nM - fm) < WGM ? (nM - fm) : WGM;
        u.pm = fm + ((wgid % nig) % gsz); u.pn = (wgid % nig) / gsz; return true;
    }
    __device__ __forceinline__ void a_ready(const Unit&) const {}
    __device__ __forceinline__ void done(const Unit&) const {}
};

__device__ __forceinline__ unsigned cvt_pk_bf16(float lo, float hi) { unsigned r; asm volatile("v_cvt_pk_bf16_f32 %0, %1, %2" : "=v"(r) : "v"(lo), "v"(hi)); return r; }
typedef float f32x2 __attribute__((ext_vector_type(2)));
typedef unsigned u32x2 __attribute__((ext_vector_type(2)));
__device__ __forceinline__ float bf_lo(unsigned w) { return __uint_as_float(w << 16); }
__device__ __forceinline__ float bf_hi(unsigned w) { return __uint_as_float(w & 0xffff0000u); }
struct EpiZ {
    static constexpr bool PERM = true, AFTER_DRAIN = false;
    bf16_t* Z; size_t zstride; bf16_t* MO; float* G; float scale0;
    __device__ __forceinline__ void operator()(const f32x4 (&acc)[2][2][4][2], const Unit& u, int wr, int wc, int fr, int fq) const {
        asm volatile("" : "+v"(fr), "+v"(fq));
        const int row0 = u.pm * BM + wr * 64 + fr; const int t = u.pn >> 1;
        if (t < 7) {
            bf16_t* base = (t < 6) ? Z + (size_t)t * zstride : MO;
            const float sc = (t == 0) ? scale0 : 1.f;
            const int col0 = (u.pn & 1) * BM + wc * 32 + 8 * fq;
#pragma unroll
            for (int ai = 0; ai < 2; ++ai)
#pragma unroll
                for (int m = 0; m < 4; ++m) { bf16_t* rowp = base + (size_t)(row0 + ai * HALF + m * 16) * 512 + col0;
#pragma unroll
                    for (int bj = 0; bj < 2; ++bj) { const f32x4 v0 = acc[ai][bj][m][0] * sc, v1 = acc[ai][bj][m][1] * sc;
                        u32x4 w; w.x = cvt_pk_bf16(v0[0], v0[1]); w.y = cvt_pk_bf16(v0[2], v0[3]); w.z = cvt_pk_bf16(v1[0], v1[1]); w.w = cvt_pk_bf16(v1[2], v1[3]);
                        *(u32x4*)(rowp + bj * HALF) = w; } }
        } else if (wc == 0 && fq < 2) {
#pragma unroll
            for (int ai = 0; ai < 2; ++ai)
#pragma unroll
                for (int m = 0; m < 4; ++m) { float* gp = G + (size_t)(row0 + ai * HALF + m * 16) * 16 + 8 * fq;
                    *(f32x4*)gp = acc[ai][0][m][0]; *(f32x4*)(gp + 4) = acc[ai][0][m][1]; }
        }
    }
};
struct EpiRes {
    static constexpr bool PERM = false, AFTER_DRAIN = false;
    const float* base; float* out; bf16_t* xb;
    __device__ __forceinline__ void operator()(const f32x4 (&acc)[2][2][4][2], const Unit& u, int wr, int wc, int fr, int fq) const {
        asm volatile("" : "+v"(fr), "+v"(fq));
        const int col0 = u.pn * BM + wc * 32 + 4 * fq;
#pragma unroll
        for (int ai = 0; ai < 2; ++ai)
#pragma unroll
            for (int m = 0; m < 4; ++m) { const size_t off = (size_t)(u.pm * BM + ai * HALF + wr * 64 + m * 16 + fr) * 1024 + col0;
#pragma unroll
                for (int bj = 0; bj < 2; ++bj)
#pragma unroll
                    for (int n = 0; n < 2; ++n) { const f32x4 o = *(const f32x4*)(base + off + bj * HALF + n * 16) + acc[ai][bj][m][n];
                        *(f32x4*)(out + off + bj * HALF + n * 16) = o;
                        u32x2 w; w.x = cvt_pk_bf16(o[0], o[1]); w.y = cvt_pk_bf16(o[2], o[3]); *(u32x2*)(xb + off + bj * HALF + n * 16) = w; }
                asm volatile("" ::: "memory"); }
    }
};
struct EpiUp {
    static constexpr bool PERM = true, AFTER_DRAIN = false;
    bf16_t* H; const float* rstd;
    __device__ __forceinline__ void operator()(const f32x4 (&acc)[2][2][4][2], const Unit& u, int wr, int wc, int fr, int fq) const {
        asm volatile("" : "+v"(fr), "+v"(fq));
        const int row0 = u.pm * BM + wr * 64 + fr, col0 = u.pn * BM + wc * 32 + 8 * fq;
#pragma unroll
        for (int ai = 0; ai < 2; ++ai)
#pragma unroll
            for (int m = 0; m < 4; ++m) { const int r = row0 + ai * HALF + m * 16; const float rs = rstd[r]; bf16_t* rowp = H + (size_t)r * 4096 + col0;
#pragma unroll
                for (int bj = 0; bj < 2; ++bj) { f32x4 v0 = acc[ai][bj][m][0] * rs, v1 = acc[ai][bj][m][1] * rs;
#pragma unroll
                    for (int i = 0; i < 4; ++i) { const float a = fmaxf(v0[i], 0.f), b = fmaxf(v1[i], 0.f); v0[i] = a * a; v1[i] = b * b; }
                    u32x4 w; w.x = cvt_pk_bf16(v0[0], v0[1]); w.y = cvt_pk_bf16(v0[2], v0[3]); w.z = cvt_pk_bf16(v1[0], v1[1]); w.w = cvt_pk_bf16(v1[2], v1[3]);
                    *(u32x4*)(rowp + bj * HALF) = w; } }
    }
};
struct EpiPlain {
    static constexpr bool PERM = true, AFTER_DRAIN = false;
    bf16_t* O; int ldc;
    __device__ __forceinline__ void operator()(const f32x4 (&acc)[2][2][4][2], const Unit& u, int wr, int wc, int fr, int fq) const {
        asm volatile("" : "+v"(fr), "+v"(fq));
        const int row0 = u.pm * BM + wr * 64 + fr, col0 = u.pn * BM + wc * 32 + 8 * fq;
#pragma unroll
        for (int ai = 0; ai < 2; ++ai)
#pragma unroll
            for (int m = 0; m < 4; ++m) { bf16_t* rowp = O + (size_t)(row0 + ai * HALF + m * 16) * ldc + col0;
#pragma unroll
                for (int bj = 0; bj < 2; ++bj) { const f32x4 v0 = acc[ai][bj][m][0], v1 = acc[ai][bj][m][1];
                    u32x4 w; w.x = cvt_pk_bf16(v0[0], v0[1]); w.y = cvt_pk_bf16(v0[2], v0[3]); w.z = cvt_pk_bf16(v1[0], v1[1]); w.w = cvt_pk_bf16(v1[2], v1[3]);
                    *(u32x4*)(rowp + bj * HALF) = w; } }
    }
};
struct EpiGate {
    static constexpr bool PERM = false, AFTER_DRAIN = false;
    float* out; const bf16_t* pl; const float* rstd;
    __device__ __forceinline__ void operator()(const f32x4 (&acc)[2][2][4][2], const Unit& u, int wr, int wc, int fr, int fq) const {
        asm volatile("" : "+v"(fr), "+v"(fq));
        const int col0 = u.pn * BM + wc * 32 + 4 * fq;
#pragma unroll
        for (int ai = 0; ai < 2; ++ai)
#pragma unroll
            for (int m = 0; m < 4; ++m) { const int r = u.pm * BM + ai * HALF + wr * 64 + m * 16 + fr; const float rs = rstd[r]; const size_t off = (size_t)r * 1024 + col0;
#pragma unroll
                for (int bj = 0; bj < 2; ++bj)
#pragma unroll
                    for (int n = 0; n < 2; ++n) { const size_t o2 = off + bj * HALF + n * 16; const f32x4 a = acc[ai][bj][m][n] * rs; const u32x2 pw = *(const u32x2*)(pl + o2);
                        f32x4 x = *(const f32x4*)(out + o2);
                        x[0] += bf_lo(pw.x) / (1.f + __expf(-a[0])); x[1] += bf_hi(pw.x) / (1.f + __expf(-a[1]));
                        x[2] += bf_lo(pw.y) / (1.f + __expf(-a[2])); x[3] += bf_hi(pw.y) / (1.f + __expf(-a[3]));
                        *(f32x4*)(out + o2) = x; }
                asm volatile("" ::: "memory"); }
    }
};
struct PanelOrder {
    int pm, nN;
    __device__ __forceinline__ bool next(int i, Unit& u) const { if (i >= nN) return false; u.pm = pm; u.pn = i; return true; }
    __device__ __forceinline__ void a_ready(const Unit&) const {}
    __device__ __forceinline__ void done(const Unit&) const {}
};
template <class Epi, class Sched, bool ALIGN_EPI = false, bool SP2 = false>
__device__ __forceinline__ void gemm_phase(PG8_LAS unsigned char* lds, const Gemm g, const Sched& S, const Epi& E, int tid_) {
    asm volatile("" : "+v"(tid_));
    const int tid = tid_, wid = __builtin_amdgcn_readfirstlane(tid >> 6), lane = tid & 63, wr = wid >> 2, wc = wid & 3, fr = lane & 15, fq = lane >> 4;
    const int K = g.K, nt = K / BK;
    unsigned voffA[2], voffB[2];
#pragma unroll
    for (int i = 0; i < 2; ++i) { int R, C; stage_rc(tid * 16 + i * 8192, R, C); const int Rb = Epi::PERM ? ((R & ~31) + perm32(R & 31)) : R;
        voffA[i] = (unsigned)(R * K + C) * 2u; voffB[i] = (unsigned)(Rb * K + C) * 2u; }
    const size_t kstep = (size_t)(BK * 2);
    const size_t hstep = (size_t)HALF * K * 2;
    const size_t tstep = 2 * hstep;
    const unsigned ldsw = (unsigned)wid * 1024u;
    const int aoff = lds_byte(wr * 64 + fr, fq * 8), boff = lds_byte(wc * 32 + fr, fq * 8);
#define PG8_SA(b, h) (((b) * 2 + (h)) * HTB)
#define PG8_SB(b, h) ((4 + (b) * 2 + (h)) * HTB)
#define PG8_STAGE(bufoff, gbase, voff) do { _Pragma("unroll") for (int _i = 0; _i < 2; ++_i) \
        __builtin_amdgcn_global_load_lds((const unsigned*)((const char*)(gbase) + (voff)[_i]), (PG8_LAS unsigned*)(lds + (bufoff) + ldsw + _i * 8192), 16, 0, 0); } while (0)
#define PG8_LDA(dst, b, h) do { _Pragma("unroll") for (int m = 0; m < 4; ++m) _Pragma("unroll") for (int k = 0; k < 2; ++k) dst[m][k] = *(const PG8_LAS bf16x8*)(lds + PG8_SA(b, h) + aoff + m * 2048 + k * 1024); } while (0)
#define PG8_LDB(dst, b, h) do { _Pragma("unroll") for (int n = 0; n < 2; ++n) _Pragma("unroll") for (int k = 0; k < 2; ++k) dst[n][k] = *(const PG8_LAS bf16x8*)(lds + PG8_SB(b, h) + boff + n * 2048 + k * 1024); } while (0)
#define PG8_MMA(ai, bj, At, Bt) do { __builtin_amdgcn_s_setprio(1); _Pragma("unroll") for (int m = 0; m < 4; ++m) _Pragma("unroll") for (int n = 0; n < 2; ++n) _Pragma("unroll") for (int k = 0; k < 2; ++k) \
        acc[ai][bj][m][n] = __builtin_amdgcn_mfma_f32_16x16x32_bf16(Bt[n][k], At[m][k], acc[ai][bj][m][n], 0, 0, 0); __builtin_amdgcn_s_setprio(0); } while (0)
#define PG8_WAIT_V(n) asm volatile("s_waitcnt vmcnt(" #n ")" ::: "memory")
#define PG8_WAIT_L(n) asm volatile("s_waitcnt lgkmcnt(" #n ")" ::: "memory")
#define PG8_BAR __builtin_amdgcn_s_barrier()
#define PG8_SCHED __builtin_amdgcn_sched_barrier(0)
    Unit cur, nxt; int ui = 0;
    if (!S.next(0, cur)) return;
    f32x4 acc[2][2][4][2];
#pragma unroll
    for (int a = 0; a < 2; ++a)
#pragma unroll
        for (int b = 0; b < 2; ++b)
#pragma unroll
            for (int m = 0; m < 4; ++m)
#pragma unroll
                for (int n = 0; n < 2; ++n) acc[a][b][m][n] = (f32x4){0.f, 0.f, 0.f, 0.f};
    bf16x8 At[4][2], B0[2][2], B1[2][2];
    const char* cA = (const char*)g.A + (size_t)cur.pm * tstep; const char* cB = (const char*)g.Bt + (size_t)cur.pn * tstep;
    S.a_ready(cur);
    if constexpr (SP2) {
        PG8_STAGE(PG8_SB(0, 0), cB, voffB); PG8_STAGE(PG8_SB(0, 1), cB + hstep, voffB); PG8_STAGE(PG8_SA(0, 0), cA, voffA); PG8_STAGE(PG8_SA(0, 1), cA + hstep, voffA);
        if (wr == 1) PG8_BAR;
        PG8_WAIT_V(2); PG8_BAR;
        PG8_STAGE(PG8_SB(1, 0), cB + kstep, voffB); PG8_STAGE(PG8_SA(1, 0), cA + kstep, voffA); PG8_STAGE(PG8_SB(1, 1), cB + hstep + kstep, voffB);
        PG8_WAIT_V(6); PG8_BAR;
    } else {
        PG8_STAGE(PG8_SB(0, 0), cB, voffB); PG8_STAGE(PG8_SA(0, 0), cA, voffA); PG8_STAGE(PG8_SB(0, 1), cB + hstep, voffB); PG8_STAGE(PG8_SA(0, 1), cA + hstep, voffA);
        if (wr == 1) PG8_BAR;
        PG8_WAIT_V(4); PG8_BAR;
        PG8_STAGE(PG8_SB(1, 0), cB + kstep, voffB); PG8_STAGE(PG8_SA(1, 0), cA + kstep, voffA); PG8_STAGE(PG8_SB(1, 1), cB + hstep + kstep, voffB);
        PG8_WAIT_V(6); PG8_BAR;
    }
    for (;;) {
        const bool has_next = S.next(ui + 1, nxt);
        const char* nA = has_next ? (const char*)g.A + (size_t)nxt.pm * tstep : cA; const char* nB = has_next ? (const char*)g.Bt + (size_t)nxt.pn * tstep : cB;
        for (int t = 0; t < nt; t += 2) {
            const bool last = (t == nt - 2);
            const char* a1 = cA + (size_t)(t + 1) * kstep;
            const char* a2 = last ? nA : cA + (size_t)(t + 2) * kstep; const char* b2 = last ? nB : cB + (size_t)(t + 2) * kstep;
            const char* a3 = a2 + kstep; const char* b3 = b2 + kstep;
            asm volatile("" : "+s"(a1), "+s"(a2), "+s"(b2), "+s"(a3), "+s"(b3));
            if (last && has_next) S.a_ready(nxt);
            if constexpr (SP2) {
            PG8_LDB(B0, 0, 0); PG8_LDB(B1, 0, 1); PG8_SCHED; PG8_LDA(At, 0, 0); PG8_STAGE(PG8_SA(1, 1), a1 + hstep, voffA);
            PG8_WAIT_V(8); PG8_WAIT_L(0); PG8_BAR; PG8_MMA(0, 0, At, B0); PG8_MMA(0, 1, At, B1); PG8_BAR; PG8_SCHED;
            PG8_LDA(At, 0, 1); PG8_STAGE(PG8_SB(0, 0), b2, voffB); PG8_STAGE(PG8_SB(0, 1), b2 + hstep, voffB); PG8_STAGE(PG8_SA(0, 0), a2, voffA);
            PG8_WAIT_V(8); PG8_WAIT_L(0); PG8_BAR; PG8_MMA(1, 0, At, B0); PG8_MMA(1, 1, At, B1); PG8_BAR; PG8_SCHED;
            PG8_LDB(B0, 1, 0); PG8_LDB(B1, 1, 1); PG8_SCHED; PG8_LDA(At, 1, 0); PG8_STAGE(PG8_SA(0, 1), a2 + hstep, voffA);
            PG8_WAIT_V(8); PG8_WAIT_L(0); PG8_BAR; PG8_MMA(0, 0, At, B0); PG8_MMA(0, 1, At, B1); PG8_BAR; PG8_SCHED;
            PG8_LDA(At, 1, 1); PG8_STAGE(PG8_SB(1, 0), b3, voffB); PG8_STAGE(PG8_SB(1, 1), b3 + hstep, voffB); PG8_STAGE(PG8_SA(1, 0), a3, voffA);
            PG8_WAIT_V(8); PG8_WAIT_L(0); PG8_BAR; PG8_MMA(1, 0, At, B0); PG8_MMA(1, 1, At, B1); PG8_BAR; PG8_SCHED;
            } else {
            PG8_LDB(B0, 0, 0); PG8_SCHED; PG8_LDA(At, 0, 0); PG8_STAGE(PG8_SA(1, 1), a1 + hstep, voffA);
            PG8_WAIT_L(8); PG8_BAR; PG8_WAIT_L(0); PG8_MMA(0, 0, At, B0); PG8_BAR; PG8_SCHED;
            PG8_LDB(B1, 0, 1); PG8_STAGE(PG8_SB(0, 0), b2, voffB);
            PG8_BAR; PG8_WAIT_L(0); PG8_MMA(0, 1, At, B1); PG8_BAR;
            PG8_LDA(At, 0, 1); PG8_STAGE(PG8_SA(0, 0), a2, voffA);
            PG8_BAR; PG8_WAIT_L(0); PG8_MMA(1, 0, At, B0); PG8_BAR; PG8_SCHED;
            PG8_STAGE(PG8_SB(0, 1), b2 + hstep, voffB);
            PG8_WAIT_V(6); PG8_BAR; PG8_MMA(1, 1, At, B1); PG8_BAR;
            PG8_LDB(B0, 1, 0); PG8_SCHED; PG8_LDA(At, 1, 0); PG8_STAGE(PG8_SA(0, 1), a2 + hstep, voffA);
            PG8_WAIT_L(8); PG8_BAR; PG8_WAIT_L(0); PG8_MMA(0, 0, At, B0); PG8_BAR; PG8_SCHED;
            PG8_LDB(B1, 1, 1); PG8_STAGE(PG8_SB(1, 0), b3, voffB);
            PG8_BAR; PG8_WAIT_L(0); PG8_MMA(0, 1, At, B1); PG8_BAR;
            PG8_LDA(At, 1, 1); PG8_STAGE(PG8_SA(1, 0), a3, voffA);
            PG8_BAR; PG8_WAIT_L(0); PG8_MMA(1, 0, At, B0); PG8_BAR; PG8_SCHED;
            PG8_STAGE(PG8_SB(1, 1), b3 + hstep, voffB);
            PG8_WAIT_V(6); PG8_BAR; PG8_MMA(1, 1, At, B1); PG8_BAR;
            }
        }
        if constexpr (ALIGN_EPI) { if (wr == 0) PG8_BAR; }
        if constexpr (!Epi::AFTER_DRAIN) { E(acc, cur, wr, wc, fr, fq); S.done(cur); }
        if (!has_next) break;
#pragma unroll
        for (int a = 0; a < 2; ++a)
#pragma unroll
            for (int b = 0; b < 2; ++b)
#pragma unroll
                for (int m = 0; m < 4; ++m)
#pragma unroll
                    for (int n = 0; n < 2; ++n) acc[a][b][m][n] = (f32x4){0.f, 0.f, 0.f, 0.f};
        cur = nxt; cA = nA; cB = nB; ++ui;
        if constexpr (ALIGN_EPI) { if (wr == 1) PG8_BAR; }
    }
    PG8_WAIT_V(0);
    if constexpr (!ALIGN_EPI) { if (wr == 0) PG8_BAR; }
    PG8_BAR;
    if constexpr (Epi::AFTER_DRAIN) { E.fused(acc, cur, wr, wc, fr, fq, lds, wid, lane); S.done(cur); }
#undef PG8_SA
#undef PG8_SB
#undef PG8_STAGE
#undef PG8_LDA
#undef PG8_LDB
#undef PG8_MMA
#undef PG8_WAIT_V
#undef PG8_WAIT_L
#undef PG8_BAR
#undef PG8_SCHED
}
}
#include <hip/hip_bf16.h>
#include <cmath>
namespace attn_body {
using bf16=__hip_bfloat16;
using bf16x8=__attribute__((ext_vector_type(8)))short;
using s16x4=__attribute__((ext_vector_type(4)))short;
using f32x16=__attribute__((ext_vector_type(16)))float;
using u32x4=__attribute__((ext_vector_type(4)))unsigned;
using f32x4v=__attribute__((ext_vector_type(4)))float;
constexpr int BATCH=16,NHEAD=8,SEQ=4096,D=64,DM=NHEAD*D,OPITCH=1024;
constexpr int NW=8,QBLK=32,QB=QBLK*NW,KVBLK=64,NQB=SEQ/QB;
constexpr int ATTN_PITCH=DM, ATTN_UNIT_ROWS=QB;
__device__ __forceinline__ int crow(int r,int hi){return (r&3)+8*(r>>2)+4*hi;}
#define SBAR() __builtin_amdgcn_sched_barrier(0)
__device__ __forceinline__ void cmask(f32x16&p0,f32x16&p1,int jb,int qrel,int hi){
  const float NEG=-INFINITY; int kb=64*jb+4*hi;
  #pragma unroll
  for(int r=0;r<16;++r){int kv=kb+(r&3)+8*(r>>2); if(kv>qrel)p0[r]=NEG; if(kv+32>qrel)p1[r]=NEG;}
}

constexpr int NSLOT=3, SLOTB=8192;
constexpr int LDS_K=0, LDS_V=NSLOT*SLOTB, LDS_WS=2*NSLOT*SLOTB, LDS_OST=LDS_WS+NW*64*4, LDS_BYTES=LDS_OST+NW*4096;
constexpr int LDS_CB=86016;
constexpr float C2=0.125f*1.4426950408889634f;
__device__ __forceinline__ void glds16(const void*gsrc,unsigned lds_dst){unsigned keep;
  asm volatile("s_mov_b32 %0, m0\n\ts_mov_b32 m0, %2\n\ts_nop 0\n\tglobal_load_lds_dwordx4 %1, off\n\ts_mov_b32 m0, %0":"=&s"(keep):"v"(gsrc),"s"(lds_dst):"memory");}
__device__ __forceinline__ float max3f(float a,float b,float c){float r;asm("v_max3_f32 %0, %1, %2, %3":"=v"(r):"v"(a),"v"(b),"v"(c));return r;}
__device__ __forceinline__ float max2f(float a,float b){float r;asm("v_max_f32_e32 %0, %1, %2":"=v"(r):"v"(a),"v"(b));return r;}
__device__ __forceinline__ float fadd_s(float a,float b){float r;asm("v_add_f32_e32 %0, %1, %2":"=v"(r):"v"(a),"v"(b));return r;}
__device__ __forceinline__ float fsub_s(float a,float b){float r;asm("v_sub_f32_e32 %0, %1, %2":"=v"(r):"v"(a),"v"(b));return r;}
typedef float f32x2_t __attribute__((ext_vector_type(2))); typedef __bf16 bf16x2_t __attribute__((ext_vector_type(2)));
__device__ __forceinline__ unsigned cvtpk_s(float lo,float hi){f32x2_t v={lo,hi};bf16x2_t b=__builtin_convertvector(v,bf16x2_t);return __builtin_bit_cast(unsigned,b);}
#define WAIT_BAR(N) asm volatile("s_waitcnt vmcnt(" #N ") lgkmcnt(0)\n\ts_barrier":::"memory")

__device__ __forceinline__ void qkt(f32x16&p0,f32x16&p1,const char*Kslot,const bf16x8*qr,const f32x16&negm,int r32,int hi){
  const char*kb=Kslot+hi*1024+r32*16;
  #pragma unroll
  for(int d0=0;d0<4;++d0){
    const bf16x8 b0=*reinterpret_cast<const bf16x8*>(kb+d0*2048);
    const bf16x8 b1=*reinterpret_cast<const bf16x8*>(kb+d0*2048+512);
    if(d0==0){p0=__builtin_amdgcn_mfma_f32_32x32x16_bf16(b0,qr[0],negm,0,0,0);p1=__builtin_amdgcn_mfma_f32_32x32x16_bf16(b1,qr[0],negm,0,0,0);}
    else{p0=__builtin_amdgcn_mfma_f32_32x32x16_bf16(b0,qr[d0],p0,0,0,0);p1=__builtin_amdgcn_mfma_f32_32x32x16_bf16(b1,qr[d0],p1,0,0,0);}}
}
typedef __attribute__((address_space(3))) const char* lds_cptr;
typedef short v4i16_t __attribute__((ext_vector_type(4)));
__device__ __forceinline__ void kload8(bf16x8*kf,lds_cptr kp){
  kf[0]=*(const __attribute__((address_space(3))) bf16x8*)(kp);      kf[1]=*(const __attribute__((address_space(3))) bf16x8*)(kp+512);
  kf[2]=*(const __attribute__((address_space(3))) bf16x8*)(kp+2048); kf[3]=*(const __attribute__((address_space(3))) bf16x8*)(kp+2560);
  kf[4]=*(const __attribute__((address_space(3))) bf16x8*)(kp+4096); kf[5]=*(const __attribute__((address_space(3))) bf16x8*)(kp+4608);
  kf[6]=*(const __attribute__((address_space(3))) bf16x8*)(kp+6144); kf[7]=*(const __attribute__((address_space(3))) bf16x8*)(kp+6656);
}
__device__ __forceinline__ void kload2(bf16x8*kf,lds_cptr kp,int j){ kf[2*j]=*(const __attribute__((address_space(3))) bf16x8*)(kp+j*2048); kf[2*j+1]=*(const __attribute__((address_space(3))) bf16x8*)(kp+j*2048+512); }
__device__ __forceinline__ s16x4 vtr(lds_cptr p){ return __builtin_bit_cast(s16x4,__builtin_amdgcn_ds_read_tr16_b64_v4i16((__attribute__((address_space(3))) v4i16_t*)p)); }
__device__ __forceinline__ float rowmax(const f32x16&p0,const f32x16&p1){
  float a=max3f(p0[0],p0[1],p1[0]),b=max3f(p0[2],p0[3],p1[1]);a=max3f(a,p1[2],p1[3]);
  #pragma unroll
  for(int r=4;r<16;r+=4){a=max3f(a,p0[r],p0[r+1]);b=max3f(b,p0[r+2],p0[r+3]);a=max3f(a,p1[r],p1[r+1]);b=max3f(b,p1[r+2],p1[r+3]);}
  const float m=max2f(a,b);
  auto rr=__builtin_amdgcn_permlane32_swap(__float_as_uint(m),__float_as_uint(m),false,false);
  return max2f(__uint_as_float(rr[0]),__uint_as_float(rr[1]));
}
__device__ __forceinline__ void pv(f32x16*o,int vb,bf16x8 pa0,bf16x8 pa1,bf16x8 pa2,bf16x8 pa3){
  #pragma unroll
  for(int d0=0;d0<2;++d0){s16x4 lo[4],hi[4];
    #pragma unroll
    for(int ks=0;ks<4;++ks){
      asm volatile("ds_read_b64_tr_b16 %0,%1 offset:%c2":"=&v"(lo[ks]):"v"(vb),"i"(d0*4096+ks*1024):"memory");
      asm volatile("ds_read_b64_tr_b16 %0,%1 offset:%c2":"=&v"(hi[ks]):"v"(vb),"i"(d0*4096+ks*1024+512):"memory");}
    asm volatile("s_waitcnt lgkmcnt(0)":::"memory");SBAR();
    #define PK(k) (bf16x8){lo[k][0],lo[k][1],lo[k][2],lo[k][3],hi[k][0],hi[k][1],hi[k][2],hi[k][3]}
    o[d0]=__builtin_amdgcn_mfma_f32_32x32x16_bf16(pa0,PK(0),o[d0],0,0,0);
    o[d0]=__builtin_amdgcn_mfma_f32_32x32x16_bf16(pa1,PK(1),o[d0],0,0,0);
    o[d0]=__builtin_amdgcn_mfma_f32_32x32x16_bf16(pa2,PK(2),o[d0],0,0,0);
    o[d0]=__builtin_amdgcn_mfma_f32_32x32x16_bf16(pa3,PK(3),o[d0],0,0,0);
    #undef PK
  }
}

#ifndef ATTN_STORE16
#define ATTN_STORE16(p,v) (*(u32x4*)(p)=(v))
#endif
template<int THRL> __device__ __forceinline__ void attn_unit(int b,int h,int qb,const bf16*Q,const bf16*__restrict__ K,const bf16*__restrict__ V,bf16*O,const float*gfox,char*shm,int tid_){
  asm volatile("":"+v"(tid_)); const int tid=tid_,lane=tid&63,r32=lane&31,hi=lane>>5; const int wid=__builtin_amdgcn_readfirstlane(tid>>6);
  const long rowbase=(long)b*SEQ; const int q0=qb*QB;
  const bf16*Qw=Q+(rowbase+q0+wid*QBLK)*DM+h*D;
  const bf16*Kh=K+rowbase*DM+h*D,*Vh=V+rowbase*DM+h*D;
  const unsigned lds0=(unsigned)(uintptr_t)shm;
  float*wsf=(float*)(shm+LDS_WS)+wid*64;
  const bf16*ksrc=Kh+(long)lane*DM+wid*8;
  const bf16*vsrc=Vh+(long)(16*(wid&3)+(lane>>2))*DM+(wid>>2)*32+(lane&3)*8;
  const unsigned kdst=lds0+LDS_K+wid*1024, vdst=lds0+LDS_V+wid*1024;
  #define DMA_K(t,slot) glds16(ksrc+(long)(t)*KVBLK*DM,(unsigned)__builtin_amdgcn_readfirstlane(kdst+(slot)))
  #define DMA_V(t,slot) glds16(vsrc+(long)(t)*KVBLK*DM,(unsigned)__builtin_amdgcn_readfirstlane(vdst+(slot)))
  const int vb0=(int)(lds0+LDS_V)+((lane>>4)&1)*32+(lane&3)*8+(4*hi+((lane&15)>>2))*64;
  const char*Kbase=shm+LDS_K; bf16x8 kf[8];
  const lds_cptr shm3=(lds_cptr)shm; const lds_cptr kp0=shm3+LDS_K+hi*1024+r32*16; const lds_cptr vp0=shm3+LDS_V+((lane>>4)&1)*32+(lane&3)*8+(4*hi+((lane&15)>>2))*64;
  const int NT=(q0+QB)/KVBLK;
  DMA_K(0,0);DMA_V(0,0);DMA_K(1,SLOTB);
  bf16x8 qr[4];
  #pragma unroll
  for(int d0=0;d0<4;++d0)qr[d0]=*reinterpret_cast<const bf16x8*>(&Qw[(long)r32*DM+d0*16+hi*8]);
  float mhat=0.f,l_reg=0.f;f32x16 o[2]; float zz_=0.f; asm volatile("":"+v"(zz_));
  #pragma unroll
  for(int r=0;r<16;++r){o[0][r]=zz_;o[1][r]=zz_;}
  f32x16 negm;
  #pragma unroll
  for(int r=0;r<16;++r)negm[r]=zz_;
  asm volatile("":"+v"(negm));
  const int qrel=wid*QBLK+r32;
  const __attribute__((address_space(3))) f32x4v* cbq=(const __attribute__((address_space(3))) f32x4v*)((lds_cptr)shm+LDS_CB)+hi;
  #define FBIAS(P0,P1,t) do{ const __attribute__((address_space(3))) f32x4v* cb_=cbq+(t)*16; \
    _Pragma("unroll") for(int j_=0;j_<4;++j_){ const f32x4v a_=cb_[2*j_], b_=cb_[8+2*j_]; \
      P0[4*j_]-=a_[0]; P0[4*j_+1]-=a_[1]; P0[4*j_+2]-=a_[2]; P0[4*j_+3]-=a_[3]; \
      P1[4*j_]-=b_[0]; P1[4*j_+1]-=b_[1]; P1[4*j_+2]-=b_[2]; P1[4*j_+3]-=b_[3]; } }while(0)
  #define CMASK(P0,P1,t) do{int jb_=(t)-(NT-4); if(jb_>=0)cmask(P0,P1,jb_,qrel,hi);}while(0)
  bool resc=false;
  #define START(P0,P1) do{ const float rm=rowmax(P0,P1); resc=false; \
    { const float dl=rm; mhat=fadd_s(mhat,dl); \
      _Pragma("unroll") for(int r=0;r<16;++r){P0[r]=fsub_s(P0[r],dl);P1[r]=fsub_s(P1[r],dl);} \
      _Pragma("unroll") for(int r=0;r<16;++r)negm[r]=-mhat; asm volatile("":"+v"(negm)); } \
    _Pragma("unroll") for(int r=0;r<16;++r)P0[r]=__builtin_amdgcn_exp2f(P0[r]); }while(0)
  #define RESC() do{ if(resc){ asm volatile("s_waitcnt lgkmcnt(0)":::"memory"); \
      _Pragma("unroll") for(int d_=0;d_<2;++d_) _Pragma("unroll") for(int r=0;r<16;++r)o[d_][r]*=wsf[crow(r,hi)]; } }while(0)
  f32x16 pA0,pA1,pB0,pB1;
  int sl_prev=0,sl_cur=0,sl_next=SLOTB;
  #define ROT() do{sl_prev=sl_cur;sl_cur=sl_next;sl_next=(sl_next==(NSLOT-1)*SLOTB)?0:sl_next+SLOTB;}while(0)
  DMA_K(2,2*SLOTB);
  WAIT_BAR(3);
  qkt(pA0,pA1,Kbase,qr,negm,r32,hi);asm volatile("s_nop 15\n\ts_nop 7":"+v"(pA0),"+v"(pA1));FBIAS(pA0,pA1,0);CMASK(pA0,pA1,0);
  START(pA0,pA1);
  _Pragma("unroll") for(int r=0;r<16;++r)pA1[r]=__builtin_amdgcn_exp2f(pA1[r]);
  WAIT_BAR(0);
  DMA_K(3,0);DMA_V(1,SLOTB);
  ROT();
  kload8(kf,kp0+sl_cur);
  WAIT_BAR(2);
  s16x4 vlo[8],vhi[8]; u32x4 pw0,pw1,pw2,pw3;
  #define PKW(P,B) cvtpk_s(P[B],P[B+1])
  #define PAF(k) __builtin_bit_cast(bf16x8,pw##k)
  #define VFR(i) (bf16x8){vlo[i][0],vlo[i][1],vlo[i][2],vlo[i][3],vhi[i][0],vhi[i][1],vhi[i][2],vhi[i][3]}
  #define PIN(x) asm volatile("":"+v"(x))
  #define MX3(a,b,c) __builtin_fmaxf(__builtin_fmaxf((a),(b)),(c))
  #define GAPA(MF,A0,A1,A2,A3,W0,W1,PW) do{ MF; sacc+=A0; sacc+=A1; sacc+=A2; sacc+=A3; PIN(sacc); W0; W1; PIN(PW); SBAR(); }while(0)
  #define EX(v) __builtin_amdgcn_exp2f(v)
  #define GAPB(MF,X,B) do{ MF; X[B]=EX(X[B]); X[B+1]=EX(X[B+1]); X[B+2]=EX(X[B+2]); X[B+3]=EX(X[B+3]); PIN(X); SBAR(); }while(0)
  #define VRD(i) do{ vlo[i]=vtr(vp_+(((i)>>2)*4096+((i)&3)*1024)); vhi[i]=vtr(vp_+(((i)>>2)*4096+((i)&3)*1024+512)); }while(0)
  #define KRD(G,j) do{ if(G){ kload2(kf,kp0+sl_next,j); SBAR(); } }while(0)
  #define STEP(C0,C1,P0,P1,t,GK,GV,GL) do{ SBAR(); \
    const lds_cptr vp_=vp0+sl_prev; \
    VRD(0); SBAR(); float sacc=(P0[0]+P0[1]); \
    GAPA(C0=__builtin_amdgcn_mfma_f32_32x32x16_bf16(kf[0],qr[0],negm,0,0,0), P0[2],P0[3],P0[4],P0[5],     pw0[0]=PKW(P0,0), pw0[1]=PKW(P0,2), pw0); \
    VRD(4); SBAR(); GAPA(C1=__builtin_amdgcn_mfma_f32_32x32x16_bf16(kf[1],qr[0],negm,0,0,0), P0[6],P0[7],P0[8],P0[9],     pw0[2]=PKW(P0,4), pw0[3]=PKW(P0,6), pw0); \
    VRD(1); SBAR(); GAPA(C0=__builtin_amdgcn_mfma_f32_32x32x16_bf16(kf[2],qr[1],C0,0,0,0),   P0[10],P0[11],P0[12],P0[13], pw1[0]=PKW(P0,8), pw1[1]=PKW(P0,10), pw1); \
    VRD(5); SBAR(); GAPA(C1=__builtin_amdgcn_mfma_f32_32x32x16_bf16(kf[3],qr[1],C1,0,0,0),   P0[14],P0[15],P1[0],P1[1],   pw1[2]=PKW(P0,12),pw1[3]=PKW(P0,14), pw1); \
    VRD(2); SBAR(); GAPA(C0=__builtin_amdgcn_mfma_f32_32x32x16_bf16(kf[4],qr[2],C0,0,0,0),   P1[2],P1[3],P1[4],P1[5],     pw2[0]=PKW(P1,0), pw2[1]=PKW(P1,2), pw2); \
    VRD(6); SBAR(); GAPA(C1=__builtin_amdgcn_mfma_f32_32x32x16_bf16(kf[5],qr[2],C1,0,0,0),   P1[6],P1[7],P1[8],P1[9],     pw2[2]=PKW(P1,4), pw2[3]=PKW(P1,6), pw2); \
    VRD(3); SBAR(); GAPA(C0=__builtin_amdgcn_mfma_f32_32x32x16_bf16(kf[6],qr[3],C0,0,0,0),   P1[10],P1[11],P1[12],P1[13], pw3[0]=PKW(P1,8), pw3[1]=PKW(P1,10), pw3); \
    VRD(7); SBAR(); GAPA(C1=__builtin_amdgcn_mfma_f32_32x32x16_bf16(kf[7],qr[3],C1,0,0,0),   P1[14],P1[15],0.f,0.f,       pw3[2]=PKW(P1,12),pw3[3]=PKW(P1,14), pw3); \
    l_reg+=sacc; \
    if(GK){DMA_K((t)+3,sl_cur);} if(GV){DMA_V((t)+1,sl_next);} \
    FBIAS(C0,C1,t); CMASK(C0,C1,t); \
    { float a=MX3(C0[0],C0[1],C1[0]),b=MX3(C0[2],C0[3],C1[1]); a=MX3(a,C1[2],C1[3]); \
      _Pragma("unroll") for(int r=4;r<16;r+=4){a=MX3(a,C0[r],C0[r+1]);b=MX3(b,C0[r+2],C0[r+3]);a=MX3(a,C1[r],C1[r+1]);b=MX3(b,C1[r+2],C1[r+3]);} \
      float rm=__builtin_fmaxf(a,b); { auto rr=__builtin_amdgcn_permlane32_swap(__float_as_uint(rm),__float_as_uint(rm),false,false); rm=__builtin_fmaxf(__uint_as_float(rr[0]),__uint_as_float(rr[1])); } \
      resc=false; \
      if(__builtin_expect(__any(rm>(float)THRL),0)){ const float dl=__builtin_fmaxf(rm,0.f); mhat+=dl; \
        _Pragma("unroll") for(int r=0;r<16;++r){C0[r]-=dl;C1[r]-=dl;} \
        _Pragma("unroll") for(int r=0;r<16;++r)negm[r]=-mhat; asm volatile("":"+v"(negm)); \
        const float f=__builtin_amdgcn_exp2f(-dl); l_reg*=f; if(hi==0)wsf[r32]=f; resc=true; } } \
    SBAR(); \
    GAPB(o[0]=__builtin_amdgcn_mfma_f32_32x32x16_bf16(PAF(0),VFR(0),o[0],0,0,0), C0,0); \
    GAPB(o[1]=__builtin_amdgcn_mfma_f32_32x32x16_bf16(PAF(0),VFR(4),o[1],0,0,0), C0,4); \
    KRD(GL,0); GAPB(o[0]=__builtin_amdgcn_mfma_f32_32x32x16_bf16(PAF(1),VFR(1),o[0],0,0,0), C0,8); \
    KRD(GL,1); GAPB(o[1]=__builtin_amdgcn_mfma_f32_32x32x16_bf16(PAF(1),VFR(5),o[1],0,0,0), C0,12); \
    KRD(GL,2); GAPB(o[0]=__builtin_amdgcn_mfma_f32_32x32x16_bf16(PAF(2),VFR(2),o[0],0,0,0), C1,0); \
    KRD(GL,3); GAPB(o[1]=__builtin_amdgcn_mfma_f32_32x32x16_bf16(PAF(2),VFR(6),o[1],0,0,0), C1,4); \
    GAPB(o[0]=__builtin_amdgcn_mfma_f32_32x32x16_bf16(PAF(3),VFR(3),o[0],0,0,0), C1,8); \
    GAPB(o[1]=__builtin_amdgcn_mfma_f32_32x32x16_bf16(PAF(3),VFR(7),o[1],0,0,0), C1,12); \
    }while(0)
  int t=1;
  #undef CMASK
  #define CMASK(P0,P1,t) do{}while(0)
  for(;t+5<NT;t+=2){
    STEP(pB0,pB1,pA0,pA1,t,true,true,true);     WAIT_BAR(2); RESC(); ROT();
    STEP(pA0,pA1,pB0,pB1,t+1,true,true,true);   WAIT_BAR(2); RESC(); ROT();
  }
  #undef CMASK
  #define CMASK(P0,P1,t) do{int jb_=(t)-(NT-4); if(jb_>=0)cmask(P0,P1,jb_,qrel,hi);}while(0)
  #define ENDW(tt) do{ if((tt)+3<NT){WAIT_BAR(2);} else if((tt)+2<NT){WAIT_BAR(1);} else {WAIT_BAR(0);} }while(0)
  for(;t+1<NT;t+=2){
    STEP(pB0,pB1,pA0,pA1,t,(t+3<NT),(t+1<NT),(t+1<NT));       ENDW(t);   RESC(); ROT();
    STEP(pA0,pA1,pB0,pB1,t+1,(t+4<NT),(t+2<NT),(t+2<NT));     ENDW(t+1); RESC(); ROT();
  }
  STEP(pB0,pB1,pA0,pA1,NT-1,false,false,false); RESC();
  { float sacc=pB0[0]+pB0[1]; _Pragma("unroll") for(int r=2;r<16;++r)sacc+=pB0[r]; _Pragma("unroll") for(int r=0;r<16;++r)sacc+=pB1[r]; l_reg+=sacc;
    pw0=(u32x4){PKW(pB0,0),PKW(pB0,2),PKW(pB0,4),PKW(pB0,6)};pw1=(u32x4){PKW(pB0,8),PKW(pB0,10),PKW(pB0,12),PKW(pB0,14)};pw2=(u32x4){PKW(pB1,0),PKW(pB1,2),PKW(pB1,4),PKW(pB1,6)};pw3=(u32x4){PKW(pB1,8),PKW(pB1,10),PKW(pB1,12),PKW(pB1,14)};
    SBAR(); pv(o,vb0+sl_cur,PAF(0),PAF(1),PAF(2),PAF(3)); }
  #undef PKW
  #undef PAF
  #undef VFR
  #undef PIN
  #undef MX3
  #undef GAPA
  #undef GAPB
  #undef EX
  #undef VRD
  #undef KRD
  #undef STEP
  #undef ENDW
  {auto rr=__builtin_amdgcn_permlane32_swap(__float_as_uint(l_reg),__float_as_uint(l_reg),false,false);l_reg=__uint_as_float(rr[0])+__uint_as_float(rr[1]);}
  if(hi==0)wsf[32+r32]=l_reg;asm volatile("s_waitcnt lgkmcnt(0)":::"memory");
  float rli[16];
  #pragma unroll
  for(int r=0;r<16;++r)rli[r]=__builtin_amdgcn_rcpf(wsf[32+crow(r,hi)]);
  bf16*Ow=O+(rowbase+q0+wid*QBLK)*OPITCH+h*D;
  { bf16*stg=(bf16*)(shm+LDS_OST)+wid*2048;
    #pragma unroll
    for(int r=0;r<16;++r){const int orow=crow(r,hi);
      #pragma unroll
      for(int d0=0;d0<2;++d0)stg[orow*64+d0*32+r32]=__float2bfloat16(o[d0][r]*rli[r]);}
    asm volatile("s_waitcnt lgkmcnt(0)":::"memory");
    #pragma unroll
    for(int i=0;i<4;++i){const int row=i*8+(lane>>3),ch=lane&7; const u32x4 v=*(const u32x4*)(stg+row*64+ch*8);
      float f[8]; f[0]=__uint_as_float(v.x<<16);f[1]=__uint_as_float(v.x&0xffff0000u);f[2]=__uint_as_float(v.y<<16);f[3]=__uint_as_float(v.y&0xffff0000u);
      f[4]=__uint_as_float(v.z<<16);f[5]=__uint_as_float(v.z&0xffff0000u);f[6]=__uint_as_float(v.w<<16);f[7]=__uint_as_float(v.w&0xffff0000u);
      float ss=0.f;
      #pragma unroll
      for(int j=0;j<8;++j)ss+=f[j]*f[j];
      ss+=__int_as_float(__builtin_amdgcn_ds_bpermute((lane^1)<<2,__float_as_int(ss)));ss+=__int_as_float(__builtin_amdgcn_ds_bpermute((lane^2)<<2,__float_as_int(ss)));ss+=__int_as_float(__builtin_amdgcn_ds_bpermute((lane^4)<<2,__float_as_int(ss)));
      const float rs=1.0f/sqrtf(ss*(1.0f/64.0f)+1e-6f);
      const f32x4v g0=*(const f32x4v*)(gfox+h*D+ch*8),g1=*(const f32x4v*)(gfox+h*D+ch*8+4);
      u32x4 w; w.x=cvtpk_s(f[0]*rs*g0[0],f[1]*rs*g0[1]); w.y=cvtpk_s(f[2]*rs*g0[2],f[3]*rs*g0[3]); w.z=cvtpk_s(f[4]*rs*g1[0],f[5]*rs*g1[1]); w.w=cvtpk_s(f[6]*rs*g1[2],f[7]*rs*g1[3]);
      ATTN_STORE16(Ow+(long)row*OPITCH+ch*8,w);} }
  asm volatile("s_waitcnt lgkmcnt(0)\n\ts_barrier":::"memory");
  #undef DMA_K
  #undef DMA_V
  #undef CMASK
  #undef FBIAS
  #undef START
  #undef RESC
  #undef ROT
}
constexpr int ATTN_LDS_BYTES=LDS_BYTES;
#undef SBAR
#undef WAIT_BAR
}
#include <hip/hip_cooperative_groups.h>
namespace cg = cooperative_groups;
constexpr int NWAVES = 8, NTHR = 512;
constexpr int BATCH = 16, SEQ = 4096, DM = 1024, FF = 4096, M = BATCH * SEQ, PLE = 256, NZ = 3840, WIN_LD = 3600;
constexpr float EPS = 1e-6f;
constexpr size_t MiB = 1u << 20;
constexpr size_t WS_WIN = 2 * MiB, WS_WOUT = 10 * MiB, WS_WUP = 12 * MiB, WS_WDN = 20 * MiB, WS_WPG = 28 * MiB, WS_WPLE = 30 * MiB;
constexpr size_t WS_XN = 32 * MiB;
constexpr size_t WS_Z = 160 * MiB;
constexpr size_t WS_QC = 544 * MiB, WS_KC = 608 * MiB;
constexpr size_t WS_H = 160 * MiB;
constexpr size_t WS_MO = 672 * MiB, WS_MIX = 736 * MiB, WS_G = 864 * MiB, WS_PB = 868 * MiB, WS_RSTD = 900 * MiB, WS_END = 902 * MiB;
constexpr int RING_BYTES = 131072, LDS_TOTAL = 147456;
#define LAS __attribute__((address_space(3)))
typedef unsigned short bf16;
typedef unsigned v4u __attribute__((ext_vector_type(4)));
typedef unsigned v2u __attribute__((ext_vector_type(2)));
typedef float f32x4 __attribute__((ext_vector_type(4)));
typedef float f32x2 __attribute__((ext_vector_type(2)));
__device__ __forceinline__ unsigned f2bf(float f) { unsigned u = __builtin_bit_cast(unsigned, f); return (u + 0x7fffu + ((u >> 16) & 1u)) >> 16; }
__device__ __forceinline__ unsigned pk2(float lo, float hi) { return f2bf(lo) | (f2bf(hi) << 16); }
__device__ __forceinline__ float bflo(unsigned w) { return __uint_as_float(w << 16); }
__device__ __forceinline__ float bfhi(unsigned w) { return __uint_as_float(w & 0xffff0000u); }
__device__ __forceinline__ float shx(float v, int o, int lane) { return __int_as_float(__builtin_amdgcn_ds_bpermute((lane ^ o) << 2, __float_as_int(v))); }
__device__ __forceinline__ float shu(float v, int o, int lane) { return __int_as_float(__builtin_amdgcn_ds_bpermute((lane - o) << 2, __float_as_int(v))); }
__device__ __forceinline__ float shl(float v, int src) { return __int_as_float(__builtin_amdgcn_ds_bpermute(src << 2, __float_as_int(v))); }
__device__ __forceinline__ float wave_sum(float v, int lane) {
#pragma unroll
    for (int o = 1; o < 64; o <<= 1) v += shx(v, o, lane);
    return v;
}
__device__ __forceinline__ void block_seam() {
    asm volatile("s_waitcnt vmcnt(0) lgkmcnt(0)" ::: "memory");
    __syncthreads();
    __builtin_amdgcn_fence(__ATOMIC_ACQUIRE, "agent");
    asm volatile("s_waitcnt vmcnt(0)" ::: "memory");
}
__device__ __forceinline__ void p0_transpose_item(const float* W, int ldw, int ncols, int K, bf16* WT, int row_off, const float* gain, LAS float* scr, int item, int lane) {
    const int nblk = ncols / 32, kb = item / nblk, nb = item % nblk, k0 = 64 * kb, n0 = 32 * nb;
#pragma unroll 8
    for (int i = 0; i < 32; ++i) { const int kk = 2 * i + (lane >> 5); float v = W[(size_t)(k0 + kk) * ldw + n0 + (lane & 31)]; if (gain) v *= gain[k0 + kk]; scr[kk * 33 + (lane & 31)] = v; }
    asm volatile("s_waitcnt lgkmcnt(0)" ::: "memory");
    const int c = lane & 7;
#pragma unroll
    for (int j = 0; j < 4; ++j) { const int n = (lane >> 3) + 8 * j; const LAS float* s = scr + (8 * c) * 33 + n;
        v4u o; o.x = pk2(s[0 * 33], s[1 * 33]); o.y = pk2(s[2 * 33], s[3 * 33]); o.z = pk2(s[4 * 33], s[5 * 33]); o.w = pk2(s[6 * 33], s[7 * 33]);
        *(v4u*)(WT + (size_t)(row_off + n0 + n) * K + k0 + 8 * c) = o; }
    asm volatile("s_waitcnt lgkmcnt(0)" ::: "memory");
}
__device__ __forceinline__ int gate_src_col(int j) { return j < 8 ? 1536 + j : (j < 12 ? 3080 + (j - 8) : 3084 + (j - 12)); }

template <class T> __device__ __forceinline__ T* opq(T* p) { asm volatile("" : "+s"(p)); return p; }
struct Args { const float* in[18]; float* out; unsigned char* ws; };

__device__ __forceinline__ void p0_prologue(const Args& A, unsigned char* ws, LAS unsigned char* lds, int tid, int lane, int wave, int bx, int G) {
    LAS float* scr = (LAS float*)(lds + wave * 16384);
    const int gw = bx * NWAVES + wave, NGW = G * NWAVES;
    const float* w_in = A.in[2];
    bf16* WinT = (bf16*)(ws + WS_WIN); bf16* WoutT = (bf16*)(ws + WS_WOUT); bf16* WupT = (bf16*)(ws + WS_WUP); bf16* WdnT = (bf16*)(ws + WS_WDN); bf16* WpgT = (bf16*)(ws + WS_WPG); bf16* WpleT = (bf16*)(ws + WS_WPLE);
    constexpr int I_SEG = 16 * 16, I_IN = 7 * I_SEG, I_OUT = 16 * 32, I_UP = 16 * 128, I_DN = 64 * 32, I_PG = 16 * 32, I_PLE = 4 * 32;
    constexpr int NITEMS = I_IN + I_OUT + I_UP + I_DN + I_PG + I_PLE;
    for (int it = gw; it < NITEMS; it += NGW) {
        int r = it;
        if (r < I_IN) { const int s = r / I_SEG; const int srcc = (s == 0) ? 0 : (s == 1) ? 512 : (s == 2) ? 1024 : (s == 3) ? 1544 : (s == 4) ? 2056 : (s == 5) ? 2568 : 3088;
            p0_transpose_item(w_in + srcc, WIN_LD, 512, DM, WinT, 512 * s, nullptr, scr, r % I_SEG, lane); continue; } r -= I_IN;
        if (r < I_OUT) { p0_transpose_item(A.in[10], DM, DM, DM, WoutT, 0, nullptr, scr, r, lane); continue; } r -= I_OUT;
        if (r < I_UP) { p0_transpose_item(A.in[12], FF, FF, DM, WupT, 0, A.in[11], scr, r, lane); continue; } r -= I_UP;
        if (r < I_DN) { p0_transpose_item(A.in[13], DM, DM, FF, WdnT, 0, nullptr, scr, r, lane); continue; } r -= I_DN;
        if (r < I_PG) { p0_transpose_item(A.in[16], DM, DM, DM, WpgT, 0, A.in[15], scr, r, lane); continue; } r -= I_PG;
        p0_transpose_item(A.in[14], DM, DM, PLE, WpleT, 0, nullptr, scr, r, lane);
    }
    const int gt = bx * NTHR + tid, NGT = G * NTHR;
    for (int i = gt; i < 16 * DM; i += NGT) { const int j = i >> 10, k = i & 1023; WinT[(size_t)(3584 + j) * DM + k] = (bf16)f2bf(w_in[(size_t)k * WIN_LD + gate_src_col(j)]); }
    for (int i = gt; i < 240 * DM / 8; i += NGT) ((v4u*)(WinT + (size_t)3600 * DM))[i] = (v4u){0u, 0u, 0u, 0u};
    { const f32x4* p4 = (const f32x4*)A.in[1]; v4u* pb = (v4u*)(ws + WS_PB);
      for (int i = gt; i < M * PLE / 8; i += NGT) { const f32x4 a = p4[2 * i], b = p4[2 * i + 1]; pb[i] = (v4u){pk2(a[0], a[1]), pk2(a[2], a[3]), pk2(b[0], b[1]), pk2(b[2], b[3])}; } }
    { const float* x = A.in[0]; const f32x4* g4 = (const f32x4*)A.in[7]; bf16* XN = (bf16*)(ws + WS_XN);
      f32x4 gv[4];
#pragma unroll
      for (int j = 0; j < 4; ++j) gv[j] = g4[lane + 64 * j];
      for (int m = gw; m < M; m += NGW) {
          const f32x4* xr = (const f32x4*)(x + (size_t)m * DM) + lane; f32x4 v[4]; float s = 0.f;
#pragma unroll
          for (int j = 0; j < 4; ++j) { v[j] = xr[64 * j]; s += (v[j][0] * v[j][0] + v[j][1] * v[j][1]) + (v[j][2] * v[j][2] + v[j][3] * v[j][3]); }
          const float rstd = 1.0f / sqrtf(wave_sum(s, lane) * (1.f / DM) + EPS);
          v2u* o8 = (v2u*)(XN + (size_t)m * DM) + lane;
#pragma unroll
          for (int j = 0; j < 4; ++j) { const f32x4 y = v[j] * rstd * gv[j]; o8[64 * j] = (v2u){pk2(y[0], y[1]), pk2(y[2], y[3])}; }
      } }
}

__device__ __forceinline__ void conv_silu_phase(const float* w_conv, const bf16* MQ, const bf16* MK, bf16* QC, bf16* KC, int gt, int NGT) {
    for (int it = gt; it < 2 * (M / 32) * 64; it += NGT) {
        const int cgi = it & 63, rb = (it >> 6) & (M / 32 - 1), ten = it >> 17;
        const bf16* src = (ten ? MK : MQ) + cgi * 8; bf16* dst = (ten ? KC : QC) + cgi * 8;
        const float osc = ten ? 0.08838834764831845f : 1.0f;
        float w[4][8];
#pragma unroll
        for (int j = 0; j < 4; ++j) { const f32x4 a = *(const f32x4*)(w_conv + j * 1024 + ten * 512 + cgi * 8), b = *(const f32x4*)(w_conv + j * 1024 + ten * 512 + cgi * 8 + 4);
            w[j][0] = a[0]; w[j][1] = a[1]; w[j][2] = a[2]; w[j][3] = a[3]; w[j][4] = b[0]; w[j][5] = b[1]; w[j][6] = b[2]; w[j][7] = b[3]; }
        const int t0 = rb * 32; const bool first = (t0 % SEQ) == 0;
        float h0[8], h1[8], h2[8];
#pragma unroll
        for (int i = 0; i < 8; ++i) { h0[i] = 0.f; h1[i] = 0.f; h2[i] = 0.f; }
        if (!first) {
            const v4u a = *(const v4u*)(src + (size_t)(t0 - 3) * 512), b = *(const v4u*)(src + (size_t)(t0 - 2) * 512), c = *(const v4u*)(src + (size_t)(t0 - 1) * 512);
#pragma unroll
            for (int i = 0; i < 4; ++i) { h0[2 * i] = bflo(a[i]); h0[2 * i + 1] = bfhi(a[i]); h1[2 * i] = bflo(b[i]); h1[2 * i + 1] = bfhi(b[i]); h2[2 * i] = bflo(c[i]); h2[2 * i + 1] = bfhi(c[i]); }
        }
#pragma unroll 8
        for (int r = 0; r < 32; ++r) {
            const v4u cu = *(const v4u*)(src + (size_t)(t0 + r) * 512); float c[8], o[8];
#pragma unroll
            for (int i = 0; i < 4; ++i) { c[2 * i] = bflo(cu[i]); c[2 * i + 1] = bfhi(cu[i]); }
#pragma unroll
            for (int i = 0; i < 8; ++i) { const float y = w[0][i] * h0[i] + w[1][i] * h1[i] + w[2][i] * h2[i] + w[3][i] * c[i];
                o[i] = osc * y / (1.f + __expf(-y)); h0[i] = h1[i]; h1[i] = h2[i]; h2[i] = c[i]; }
            *(v4u*)(dst + (size_t)(t0 + r) * 512) = (v4u){pk2(o[0], o[1]), pk2(o[2], o[3]), pk2(o[4], o[5]), pk2(o[6], o[7])};
        }
    }
}

__device__ __forceinline__ void fox_cumsum(LAS float* CB, LAS float* red, const float* Gt, float bias, int b, int h, int tid, int lane, int wave) {
    float v[8]; const float* base = Gt + ((size_t)b * SEQ + tid * 8) * 16 + h;
#pragma unroll
    for (int i = 0; i < 8; ++i) { const float z = base[i * 16] + bias; v[i] = (fminf(z, 0.f) - log1pf(expf(-fabsf(z)))) * 1.4426950408889634f; }
#pragma unroll
    for (int i = 1; i < 8; ++i) v[i] += v[i - 1];
    const float tot = v[7]; float sc = tot;
#pragma unroll
    for (int o = 1; o < 64; o <<= 1) { const float n = shu(sc, o, lane); if (lane >= o) sc += n; }
    if (lane == 63) red[wave] = sc;
    __syncthreads();
    float off = sc - tot;
    for (int w = 0; w < wave; ++w) off += red[w];
#pragma unroll
    for (int i = 0; i < 8; ++i) CB[tid * 8 + i] = v[i] + off;
    __syncthreads();
}

namespace ml {
typedef short bf16x8 __attribute__((ext_vector_type(8)));
typedef short v4i16_t __attribute__((ext_vector_type(4)));
constexpr int PK = 288, PV = 272, PC = 288;
constexpr int L_K = 0, L_VT = 36864, L_VW = L_VT + 48 * PV, L_CT = L_VW + 48 * PV, L_U = L_CT + 48 * PC, L_MT = L_U + 512, L_BT = L_MT + 512, L_END = L_BT + 512;
__device__ __forceinline__ float logsig(float z) { return fminf(z, 0.f) - log1pf(__expf(-fabsf(z))); }
__device__ __forceinline__ bf16x8 cat8(v2u lo, v2u hi) { const v4u w = (v4u){lo.x, lo.y, hi.x, hi.y}; return __builtin_bit_cast(bf16x8, w); }
__device__ __forceinline__ v2u vtr(LAS unsigned char* p) { return __builtin_bit_cast(v2u, __builtin_amdgcn_ds_read_tr16_b64_v4i16((LAS v4i16_t*)p)); }
#define ML_MFMA(a, b, c) __builtin_amdgcn_mfma_f32_16x16x32_bf16((a), (b), (c), 0, 0, 0)
__device__ __forceinline__ void mlstm_item(int item, const bf16* QC, const bf16* KC, const bf16* MV, const float* Gt, const float* b_i, const float* b_f, float* HRAW, LAS unsigned char* L, int tid, int lane, int wave) {
    const int es = item & 3, hd = (item >> 2) & 3, b = item >> 4;
    const int hcol = hd * 128, ecol = hcol + es * 32;
    const float bi = b_i[hd], bff = b_f[hd];
    const int j16 = lane & 15, kq = lane >> 4, t = 16 * wave + j16;
    LAS float* U = (LAS float*)(L + L_U); LAS float* MT = (LAS float*)(L + L_MT); LAS float* BT = (LAS float*)(L + L_BT);
    __syncthreads();
    for (int i = tid; i < 48 * PC / 4; i += NTHR) ((LAS unsigned*)(L + L_CT))[i] = 0u;
    for (int i = tid; i < 16 * PV / 4; i += NTHR) ((LAS unsigned*)(L + L_VT + 32 * PV))[i] = (i < PV / 4) ? 0x3F803F80u : 0u;
    for (int i = tid; i < 15 * PV / 4; i += NTHR) ((LAS unsigned*)(L + L_VW + 33 * PV))[i] = 0u;
    f32x4 Cacc[3];
#pragma unroll
    for (int eb = 0; eb < 3; ++eb) Cacc[eb] = (f32x4){0.f, 0.f, 0.f, 0.f};
    float m_prev = 0.f;
    for (int c = 0; c < SEQ / 128; ++c) {
        const size_t row0 = (size_t)b * SEQ + (size_t)c * 128;
        const float* g0 = Gt + (row0 + 2 * lane) * 16;
        const float i0 = g0[8 + hd] + bi, i1 = g0[16 + 8 + hd] + bi;
        const float f0 = logsig(g0[12 + hd] + bff), f1 = logsig(g0[16 + 12 + hd] + bff);
        float b0 = f0, b1 = f0 + f1;
        { float sc = b1;
#pragma unroll
          for (int o = 1; o < 64; o <<= 1) { const float n = shu(sc, o, lane); if (lane >= o) sc += n; }
          const float off = sc - b1; b0 += off; b1 += off; }
        const float u0 = i0 - b0, u1 = i1 - b1;
        float c0 = u0, c1 = fmaxf(u0, u1);
        { float pm = c1;
#pragma unroll
          for (int o = 1; o < 64; o <<= 1) { const float n = shu(pm, o, lane); if (lane >= o) pm = fmaxf(pm, n); }
          float prev = shu(pm, 1, lane); if (lane == 0) prev = -INFINITY;
          c0 = fmaxf(c0, prev); c1 = fmaxf(c1, prev); }
        const float M0 = fmaxf(m_prev, c0), M1 = fmaxf(m_prev, c1);
        const float Mlast = shl(M1, 63), bL = shl(b1, 63);
        if (wave == 0) { U[2 * lane] = u0; U[2 * lane + 1] = u1; MT[2 * lane] = M0; MT[2 * lane + 1] = M1; BT[2 * lane] = b0; BT[2 * lane + 1] = b1; }
        const int s_v = tid >> 2;
        float wk; { const float ua = shl(u0, (s_v >> 1) & 63), ub = shl(u1, (s_v >> 1) & 63); wk = __expf(((s_v & 1) ? ub : ua) - Mlast); }
#pragma unroll
        for (int j = 0; j < 4; ++j) { const int id = tid + NTHR * j, r = id >> 4, c16 = id & 15;
            const v4u kv = *(const v4u*)(KC + (row0 + r) * 512 + hcol + c16 * 8); *(LAS v4u*)(L + L_K + r * PK + c16 * 16) = kv; }
        { const int e8 = (tid & 3) * 8; const v4u vv = *(const v4u*)(MV + (row0 + s_v) * 512 + ecol + e8);
#pragma unroll
          for (int i = 0; i < 4; ++i) { const unsigned w = vv[i]; const int e = e8 + 2 * i;
              *(LAS unsigned short*)(L + L_VT + e * PV + s_v * 2) = (unsigned short)(w & 0xffffu); *(LAS unsigned short*)(L + L_VT + (e + 1) * PV + s_v * 2) = (unsigned short)(w >> 16);
              *(LAS unsigned short*)(L + L_VW + e * PV + s_v * 2) = (unsigned short)f2bf(bflo(w) * wk); *(LAS unsigned short*)(L + L_VW + (e + 1) * PV + s_v * 2) = (unsigned short)f2bf(bfhi(w) * wk); }
          if ((tid & 3) == 0) *(LAS unsigned short*)(L + L_VW + 32 * PV + s_v * 2) = (unsigned short)f2bf(wk); }
        bf16x8 qf[4];
#pragma unroll
        for (int ks = 0; ks < 4; ++ks) qf[ks] = *(const bf16x8*)(QC + (row0 + t) * 512 + hcol + 32 * ks + 8 * kq);
        __syncthreads();
        const float Mt = MT[t], bt = BT[t];
        const float winter = __expf(m_prev - Mt), thr = __expf(-(bt + Mt));
        f32x4 acc[3];
#pragma unroll
        for (int eb = 0; eb < 3; ++eb) { f32x4 a4 = (f32x4){0.f, 0.f, 0.f, 0.f};
#pragma unroll
            for (int ks = 0; ks < 4; ++ks) { const bf16x8 a = *(const LAS bf16x8*)(L + L_CT + (16 * eb + j16) * PC + (32 * ks + 8 * kq) * 2); a4 = ML_MFMA(a, qf[ks], a4); }
            acc[eb] = a4 * winter; }
#pragma unroll
        for (int g = 0; g < 4; ++g) {
            f32x4 s0 = (f32x4){0.f, 0.f, 0.f, 0.f}, s1 = s0;
#pragma unroll
            for (int ks = 0; ks < 4; ++ks) { const bf16x8 a0 = *(const LAS bf16x8*)(L + L_K + (32 * g + j16) * PK + (32 * ks + 8 * kq) * 2), a1 = *(const LAS bf16x8*)(L + L_K + (32 * g + 16 + j16) * PK + (32 * ks + 8 * kq) * 2);
                s0 = ML_MFMA(a0, qf[ks], s0); s1 = ML_MFMA(a1, qf[ks], s1); }
            const f32x4 ua = *(const LAS f32x4*)(U + 32 * g + 4 * kq), ub = *(const LAS f32x4*)(U + 32 * g + 16 + 4 * kq);
            float p[8];
#pragma unroll
            for (int i = 0; i < 4; ++i) { const int sa = 32 * g + 4 * kq + i;
                p[i] = (sa <= t) ? s0[i] * __expf(ua[i] - Mt) : 0.f; p[4 + i] = (sa + 16 <= t) ? s1[i] * __expf(ub[i] - Mt) : 0.f; }
            const v4u pw = (v4u){pk2(p[0], p[1]), pk2(p[2], p[3]), pk2(p[4], p[5]), pk2(p[6], p[7])};
            const bf16x8 pf = __builtin_bit_cast(bf16x8, pw);
#pragma unroll
            for (int eb = 0; eb < 3; ++eb) { LAS unsigned char* vp = L + L_VT + (16 * eb + j16) * PV + (32 * g + 4 * kq) * 2;
                const bf16x8 a = cat8(*(const LAS v2u*)vp, *(const LAS v2u*)(vp + 32)); acc[eb] = ML_MFMA(a, pf, acc[eb]); }
        }
        { const float den = shl(acc[2][0], j16); const float inv = 1.f / fmaxf(fabsf(den), thr);
          float* hp = HRAW + (row0 + t) * 512 + ecol + 4 * kq;
          *(f32x4*)hp = acc[0] * inv; *(f32x4*)(hp + 16) = acc[1] * inv; }
        { const float decay = __expf(m_prev - Mlast);
#pragma unroll
          for (int eb = 0; eb < 3; ++eb) Cacc[eb] = Cacc[eb] * decay;
          const int q4 = j16 >> 2, p4 = j16 & 3;
#pragma unroll
          for (int g = 0; g < 4; ++g) {
              LAS unsigned char* kp = L + L_K + (32 * g + 4 * kq + q4) * PK + (16 * wave + 4 * p4) * 2;
              const bf16x8 bfr = cat8(vtr(kp), vtr(kp + 16 * PK));
#pragma unroll
              for (int eb = 0; eb < 3; ++eb) { LAS unsigned char* vp = L + L_VW + (16 * eb + j16) * PV + (32 * g + 4 * kq) * 2;
                  const bf16x8 a = cat8(*(const LAS v2u*)vp, *(const LAS v2u*)(vp + 32)); Cacc[eb] = ML_MFMA(a, bfr, Cacc[eb]); }
          } }
        __syncthreads();
#pragma unroll
        for (int eb = 0; eb < 3; ++eb)
#pragma unroll
            for (int i = 0; i < 4; ++i) *(LAS unsigned short*)(L + L_CT + (16 * eb + 4 * kq + i) * PC + (16 * wave + j16) * 2) = (unsigned short)f2bf(Cacc[eb][i]);
        m_prev = bL + Mlast;
    }
}
#undef ML_MFMA
}
__device__ __forceinline__ void mlstm_finalize_panel(int pm, const float* HRAW, const bf16* MO, const float* g, bf16* MIX, int lane, int wave) {
    for (int i = wave; i < 256 * 4; i += NWAVES) { const int row = pm * 256 + (i >> 2), hd = i & 3; const size_t o = (size_t)row * 512 + hd * 128 + 2 * lane;
        const f32x2 h = *(const f32x2*)(HRAW + o); const float ss = wave_sum(h[0] * h[0] + h[1] * h[1], lane); const float rs = 1.0f / sqrtf(ss * (1.f / 128.f) + EPS);
        const unsigned mo = *(const unsigned*)(MO + o); const f32x2 gg = *(const f32x2*)(g + hd * 128 + 2 * lane);
        const float a = h[0] * rs * gg[0] / (1.f + __expf(-bflo(mo))), b = h[1] * rs * gg[1] / (1.f + __expf(-bfhi(mo)));
        *(unsigned*)(MIX + (size_t)row * 1024 + 512 + hd * 128 + 2 * lane) = pk2(a, b); }
}
__device__ __forceinline__ void panel_rstd(int pm, const float* X, float* RSTD, int lane, int wave) {
    for (int i = wave; i < 256; i += NWAVES) { const int row = pm * 256 + i; const f32x4* xr = (const f32x4*)(X + (size_t)row * DM) + lane; float s = 0.f;
#pragma unroll
        for (int j = 0; j < 4; ++j) { const f32x4 v = xr[64 * j]; s += (v[0] * v[0] + v[1] * v[1]) + (v[2] * v[2] + v[3] * v[3]); }
        s = wave_sum(s, lane); if (lane == 0) RSTD[row] = 1.0f / sqrtf(s * (1.f / DM) + EPS); }
}
__device__ __forceinline__ void panel_final_norm(int pm, float* X, const float* g, int lane, int wave) {
    const f32x4* g4 = (const f32x4*)g;
    for (int i = wave; i < 256; i += NWAVES) { const int row = pm * 256 + i; f32x4* xr = (f32x4*)(X + (size_t)row * DM) + lane; f32x4 v[4]; float s = 0.f;
#pragma unroll
        for (int j = 0; j < 4; ++j) { v[j] = xr[64 * j]; s += (v[j][0] * v[j][0] + v[j][1] * v[j][1]) + (v[j][2] * v[j][2] + v[j][3] * v[j][3]); }
        const float rs = 1.0f / sqrtf(wave_sum(s, lane) * (1.f / DM) + EPS);
#pragma unroll
        for (int j = 0; j < 4; ++j) xr[64 * j] = v[j] * rs * g4[lane + 64 * j]; }
}

typedef const __attribute__((address_space(4))) Args* ArgsP;
__global__ void __launch_bounds__(NTHR, 2) hymba_fwd(Args args_unused) {
    extern __shared__ __attribute__((aligned(16))) unsigned char lds[];
    cg::grid_group grid = cg::this_grid();
    LAS unsigned char* L = (LAS unsigned char*)lds;
    const int wave0 = __builtin_amdgcn_readfirstlane((int)threadIdx.x >> 6);
    const int G = gridDim.x, bx = blockIdx.x;
#define ARGP() ArgsP ap = (ArgsP)__builtin_amdgcn_kernarg_segment_ptr(); asm volatile("" : "+s"(ap)); unsigned char* ws = ap->ws; (void)ws
#define FRESH_TID() int tid_ = wave0 * 64 + (int)__builtin_amdgcn_mbcnt_hi(~0u, __builtin_amdgcn_mbcnt_lo(~0u, 0u)); asm volatile("" : "+v"(tid_)); const int tid = tid_, lane = tid & 63, wave = __builtin_amdgcn_readfirstlane(tid >> 6); (void)lane; (void)wave
    constexpr size_t ZS = (size_t)M * 512;

    { ARGP(); FRESH_TID(); Args a;
#pragma unroll
      for (int i = 0; i < 18; ++i) a.in[i] = ap->in[i];
      a.out = ap->out; a.ws = ws;
      p0_prologue(a, ws, L, tid, lane, wave, bx, G); }
    grid.sync();

    {
        ARGP(); FRESH_TID();
        pg8::Gemm g{(const bf16*)(ws + WS_XN), (const bf16*)(ws + WS_WIN), M, NZ, DM}; pg8::StaticOrder S; S.init(M, NZ, G, bx);
        pg8::EpiZ E{(bf16*)(ws + WS_Z), ZS, (bf16*)(ws + WS_MO), (float*)(ws + WS_G), attn_body::C2};
        pg8::gemm_phase<pg8::EpiZ, pg8::StaticOrder, true, true>(L, g, S, E, tid);
    }
    grid.sync();

    { ARGP(); FRESH_TID(); bf16* Z = (bf16*)(ws + WS_Z); conv_silu_phase(ap->in[6], Z + 3 * ZS, Z + 4 * ZS, (bf16*)(ws + WS_QC), (bf16*)(ws + WS_KC), bx * NTHR + tid, G * NTHR); }
    {
        const int vcu0 = (G % 8 == 0) ? (bx % 8) * (G / 8) + bx / 8 : bx;
        if (vcu0 < 256) { const int v = vcu0;
            const int bh = v >> 1, half = v & 1, b = bh >> 3, h = bh & 7;
            __syncthreads();
            { ARGP(); FRESH_TID(); fox_cumsum((LAS float*)(L + attn_body::LDS_CB), (LAS float*)(L + attn_body::LDS_CB + 16384), (const float*)(ws + WS_G), ap->in[3][h], b, h, tid, lane, wave); }
            for (int i = 0; i < 8; ++i) { const int s = 2 * (i >> 1) + half; const int qb = (i & 1) ? 15 - s : s;
                ARGP(); FRESH_TID(); const bf16* Z = (const bf16*)(ws + WS_Z);
                attn_body::attn_unit<8>(b, h, qb, (const attn_body::bf16*)Z, (const attn_body::bf16*)(Z + ZS), (const attn_body::bf16*)(Z + 2 * ZS), (attn_body::bf16*)(ws + WS_MIX), ap->in[8], (char*)lds, tid); }
        }
    }
    grid.sync();

    { ARGP(); FRESH_TID(); for (int item = bx; item < 256; item += G) ml::mlstm_item(item, (const bf16*)(ws + WS_QC), (const bf16*)(ws + WS_KC), (const bf16*)(ws + WS_Z) + 5 * ZS, (const float*)(ws + WS_G), ap->in[4], ap->in[5], (float*)(ws + WS_XN), L, tid, lane, wave); }
    grid.sync();

    if (bx < M / 256) { const int pm = bx;
        { ARGP(); FRESH_TID(); mlstm_finalize_panel(pm, (const float*)(ws + WS_XN), (const bf16*)(ws + WS_MO), ap->in[9], (bf16*)(ws + WS_MIX), lane, wave); }
        block_seam();
        { ARGP(); FRESH_TID(); pg8::Gemm g{(const bf16*)(ws + WS_MIX), (const bf16*)(ws + WS_WOUT), M, DM, DM}; pg8::PanelOrder S{pm, 4}; pg8::EpiRes E{ap->in[0], ap->out, (bf16*)(ws + WS_XN)};
          pg8::gemm_phase<pg8::EpiRes, pg8::PanelOrder, true, true>(L, g, S, E, tid); }
        block_seam();
        { ARGP(); FRESH_TID(); panel_rstd(pm, ap->out, (float*)(ws + WS_RSTD), lane, wave); }
        block_seam();
        { ARGP(); FRESH_TID(); pg8::Gemm g{(const bf16*)(ws + WS_XN), (const bf16*)(ws + WS_WUP), M, FF, DM}; pg8::PanelOrder S{pm, 16}; pg8::EpiUp E{(bf16*)(ws + WS_H), (const float*)(ws + WS_RSTD)};
          pg8::gemm_phase<pg8::EpiUp, pg8::PanelOrder, true, true>(L, g, S, E, tid); }
        block_seam();
        { ARGP(); FRESH_TID(); pg8::Gemm g{(const bf16*)(ws + WS_H), (const bf16*)(ws + WS_WDN), M, DM, FF}; pg8::PanelOrder S{pm, 4}; float* o_ = ap->out; pg8::EpiRes E{o_, o_, (bf16*)(ws + WS_XN)};
          pg8::gemm_phase<pg8::EpiRes, pg8::PanelOrder, true, true>(L, g, S, E, tid); }
        block_seam();
        { ARGP(); FRESH_TID(); panel_rstd(pm, ap->out, (float*)(ws + WS_RSTD), lane, wave); }
        { ARGP(); FRESH_TID(); bf16* PLp = (bf16*)(ws + WS_H) + (size_t)pm * 256 * FF - (size_t)pm * 256 * DM;
          pg8::Gemm g{(const bf16*)(ws + WS_PB), (const bf16*)(ws + WS_WPLE), M, DM, PLE}; pg8::PanelOrder S{pm, 4}; pg8::EpiPlain E{PLp, DM};
          pg8::gemm_phase<pg8::EpiPlain, pg8::PanelOrder, true, true>(L, g, S, E, tid); }
        block_seam();
        { ARGP(); FRESH_TID(); const bf16* PLp = (const bf16*)(ws + WS_H) + (size_t)pm * 256 * FF - (size_t)pm * 256 * DM;
          pg8::Gemm g{(const bf16*)(ws + WS_XN), (const bf16*)(ws + WS_WPG), M, DM, DM}; pg8::PanelOrder S{pm, 4}; pg8::EpiGate E{ap->out, PLp, (const float*)(ws + WS_RSTD)};
          pg8::gemm_phase<pg8::EpiGate, pg8::PanelOrder, true, true>(L, g, S, E, tid); }
        block_seam();
        { ARGP(); FRESH_TID(); panel_final_norm(pm, ap->out, ap->in[17], lane, wave); }
    }
}

extern "C" void kernel_launch(void* const* d_in, const int* in_sizes, int n_in, void* d_out, int out_size, void* d_ws, size_t ws_size, hipStream_t stream) {
    static int grid = 0;
    if (grid == 0) {
        if (n_in != 18 || in_sizes[0] != M * DM || out_size != M * DM || ws_size < WS_END) { fprintf(stderr, "kernel_launch: unexpected shapes (n_in %d, in0 %d, out %d, ws %zu)\n", n_in, n_in > 0 ? in_sizes[0] : -1, out_size, ws_size); grid = -1; return; }
        int dev = 0, cus = 0, per_cu = 0;
        if (hipGetDevice(&dev) != hipSuccess || hipDeviceGetAttribute(&cus, hipDeviceAttributeMultiprocessorCount, dev) != hipSuccess) { grid = -1; return; }
        if (hipFuncSetAttribute((const void*)hymba_fwd, hipFuncAttributeMaxDynamicSharedMemorySize, LDS_TOTAL) != hipSuccess) { fprintf(stderr, "kernel_launch: hipFuncSetAttribute failed\n"); grid = -1; return; }
        if (hipOccupancyMaxActiveBlocksPerMultiprocessor(&per_cu, (const void*)hymba_fwd, NTHR, LDS_TOTAL) != hipSuccess || per_cu < 1) { fprintf(stderr, "kernel_launch: occupancy query says %d\n", per_cu); per_cu = 1; }
        (void)hipGetLastError();
        grid = cus * per_cu;
        if (grid > 256) grid = 256;
    }
    if (grid < 0) return;
    Args a{};
    for (int i = 0; i < 18; ++i) a.in[i] = (const float*)d_in[i];
    a.out = (float*)d_out; a.ws = (unsigned char*)d_ws;
    void* params[] = {&a};
    hipError_t e = hipLaunchCooperativeKernel((const void*)hymba_fwd, dim3(grid), dim3(NTHR), params, LDS_TOTAL, stream);
    if (e != hipSuccess) fprintf(stderr, "kernel_launch: cooperative launch failed: %s (grid %d)\n", hipGetErrorString(e), grid);
}
```

```cpp
#include <hip/hip_runtime.h>
#include <cstdio>
#include <cstdint>
namespace pg8 {
#define PG8_LAS __attribute__((address_space(3)))
typedef unsigned short bf16_t;
typedef short bf16x8 __attribute__((ext_vector_type(8)));
typedef float f32x4 __attribute__((ext_vector_type(4)));
typedef unsigned u32x4 __attribute__((ext_vector_type(4)));
constexpr int BM = 256, BK = 64, HALF = 128, HTB = HALF * BK * 2  , STAGE_BYTES = 8 * HTB, NXCD = 8, WGM = 8;

__host__ __device__ __forceinline__ int lds_byte(int r, int c) { const int st = (r >> 4) * 2 + (c >> 5), rr = r & 15, cc = c & 31, ob = rr * 64 + cc * 2; return st * 1024 + (ob ^ (((ob >> 9) & 1) << 5)); }
__host__ __device__ __forceinline__ void stage_rc(int b, int& R, int& C) { const int st = b / 1024, sb = b % 1024, swz = sb ^ (((sb >> 9) & 1) << 5); R = (st >> 1) * 16 + swz / 64; C = (st & 1) * 32 + (swz % 64) / 2; }
__host__ __device__ __forceinline__ int perm32(int rho) { const int n = rho >> 4, i = rho & 15; return 8 * (i >> 2) + 4 * n + (i & 3); }

struct Unit { int pm, pn; };
struct Gemm { const bf16_t* A; const bf16_t* Bt; int M, N, K; };

struct StaticOrder {
    int nM, nN, nwg, G, c;
    __host__ __device__ void init(int M, int N, int G_, int c_) { nM = M / BM; nN = N / BM; nwg = nM * nN; G = G_; c = c_; }
    __host__ __device__ bool next(int i, Unit& u) const {
        const long L = (long)i * G + c; if (L >= nwg) return false;
        int wgid = (int)L; { const int q = nwg / NXCD, r = nwg % NXCD, xcd = wgid % NXCD, off = wgid / NXCD; wgid = (xcd < r ? xcd * (q + 1) : r * (q + 1) + (xcd - r) * q) + off; }
        const int nig = WGM * nN, gid = wgid / nig, fm = gid * WGM, gsz = (nM - fm) < WGM ? (nM - fm) : WGM;
        u.pm = fm + ((wgid % nig) % gsz); u.pn = (wgid % nig) / gsz; return true;
    }
    __device__ __forceinline__ void a_ready(const Unit&) const {}
    __device__ __forceinline__ void done(const Unit&) const {}
};

__device__ __forceinline__ unsigned cvt_pk_bf16(float lo, float hi) { unsigned r; asm volatile("v_cvt_pk_bf16_f32 %0, %1, %2" : "=v"(r) : "v"(lo), "v"(hi)); return r; }
typedef float f32x2 __attribute__((ext_vector_type(2)));
typedef unsigned u32x2 __attribute__((ext_vector_type(2)));
__device__ __forceinline__ float bf_lo(unsigned w) { return __uint_as_float(w << 16); }
__device__ __forceinline__ float bf_hi(unsigned w) { return __uint_as_float(w & 0xffff0000u); }
struct EpiZ {
    static constexpr bool PERM = true, AFTER_DRAIN = false;
    bf16_t* Z; size_t zstride; bf16_t* MO; float* G; float scale0;
    __device__ __forceinline__ void operator()(const f32x4 (&acc)[2][2][4][2], const Unit& u, int wr, int wc, int fr, int fq) const {
        asm volatile("" : "+v"(fr), "+v"(fq));
        const int row0 = u.pm * BM + wr * 64 + fr; const int t = u.pn >> 1;
        if (t < 7) {
            bf16_t* base = (t < 6) ? Z + (size_t)t * zstride : MO;
            const float sc = (t == 0) ? scale0 : 1.f;
            const int col0 = (u.pn & 1) * BM + wc * 32 + 8 * fq;
#pragma unroll
            for (int ai = 0; ai < 2; ++ai)
#pragma unroll
                for (int m = 0; m < 4; ++m) { bf16_t* rowp = base + (size_t)(row0 + ai * HALF + m * 16) * 512 + col0;
#pragma unroll
                    for (int bj = 0; bj < 2; ++bj) { const f32x4 v0 = acc[ai][bj][m][0] * sc, v1 = acc[ai][bj][m][1] * sc;
                        u32x4 w; w.x = cvt_pk_bf16(v0[0], v0[1]); w.y = cvt_pk_bf16(v0[2], v0[3]); w.z = cvt_pk_bf16(v1[0], v1[1]); w.w = cvt_pk_bf16(v1[2], v1[3]);
                        *(u32x4*)(rowp + bj * HALF) = w; } }
        } else if (wc == 0 && fq < 2) {
#pragma unroll
            for (int ai = 0; ai < 2; ++ai)
#pragma unroll
                for (int m = 0; m < 4; ++m) { float* gp = G + (size_t)(row0 + ai * HALF + m * 16) * 16 + 8 * fq;
                    *(f32x4*)gp = acc[ai][0][m][0]; *(f32x4*)(gp + 4) = acc[ai][0][m][1]; }
        }
    }
};
template <int MODE> struct EpiResB {
    static constexpr bool PERM = true, AFTER_DRAIN = false;
    const float* basef; const bf16_t* xb; bf16_t* xo; const bf16_t* pl; const float* rstd; float* ssp;
    __device__ __forceinline__ void operator()(const f32x4 (&acc)[2][2][4][2], const Unit& u, int wr, int wc, int fr, int fq) const {
        asm volatile("" : "+v"(fr), "+v"(fq));
        const int lane = fq * 16 + fr, r0 = u.pm * BM + wr * 64 + fr;
        const size_t off0 = (size_t)r0 * 1024 + u.pn * BM + wc * 32 + 8 * fq;
        u32x4 xbv[2][2], plv[2][2]; float rb[2];
#define ER_LD(slot, it) do { const int rr_ = ((it) >> 2) * HALF + ((it) & 3) * 16; const size_t o_ = off0 + (size_t)rr_ * 1024; if (MODE != 1) rb[slot] = rstd[r0 + rr_]; \
        _Pragma("unroll") for (int bj = 0; bj < 2; ++bj) { \
            xbv[slot][bj] = *(const u32x4*)(xb + o_ + bj * HALF); \
            if (MODE == 2) plv[slot][bj] = *(const u32x4*)(pl + o_ + (size_t)(r0 + rr_) * 1024 + bj * HALF); } } while (0)
        ER_LD(0, 0);
#pragma unroll
        for (int it = 0; it < 8; ++it) {
            if (it + 1 < 8) ER_LD((it + 1) & 1, it + 1);
            const int ai = it >> 2, m = it & 3, rr = ai * HALF + m * 16; const size_t off = off0 + (size_t)rr * 1024; float s = 0.f;
#pragma unroll
            for (int bj = 0; bj < 2; ++bj) { float o[8];
                const f32x4 a0 = acc[ai][bj][m][0], a1 = acc[ai][bj][m][1];
                { const u32x4 xw = xbv[it & 1][bj];
                    const float x[8] = {bf_lo(xw.x), bf_hi(xw.x), bf_lo(xw.y), bf_hi(xw.y), bf_lo(xw.z), bf_hi(xw.z), bf_lo(xw.w), bf_hi(xw.w)};
                    if (MODE == 0) { const float rsi_ = rb[it & 1];
#pragma unroll
                        for (int i = 0; i < 4; ++i) { o[i] = x[i] * rsi_ + a0[i]; o[4 + i] = x[4 + i] * rsi_ + a1[i]; } }
                    else if (MODE == 1) {
#pragma unroll
                        for (int i = 0; i < 4; ++i) { o[i] = x[i] + a0[i]; o[4 + i] = x[4 + i] + a1[i]; } }
                    else { const u32x4 pw = plv[it & 1][bj]; const float rs = rb[it & 1];
                        const float p[8] = {bf_lo(pw.x), bf_hi(pw.x), bf_lo(pw.y), bf_hi(pw.y), bf_lo(pw.z), bf_hi(pw.z), bf_lo(pw.w), bf_hi(pw.w)};
#pragma unroll
                        for (int i = 0; i < 4; ++i) { o[i] = x[i] + p[i] * __builtin_amdgcn_rcpf(1.f + __expf(-a0[i] * rs)); o[4 + i] = x[4 + i] + p[4 + i] * __builtin_amdgcn_rcpf(1.f + __expf(-a1[i] * rs)); } } }
#pragma unroll
                for (int i = 0; i < 8; ++i) s += o[i] * o[i];
                u32x4 w; w.x = cvt_pk_bf16(o[0], o[1]); w.y = cvt_pk_bf16(o[2], o[3]); w.z = cvt_pk_bf16(o[4], o[5]); w.w = cvt_pk_bf16(o[6], o[7]);
                *(u32x4*)(xo + off + (MODE == 2 ? (size_t)(r0 + rr) * 3072 : (size_t)0) + bj * HALF) = w; }
            s += __int_as_float(__builtin_amdgcn_ds_bpermute((lane ^ 16) << 2, __float_as_int(s)));
            s += __int_as_float(__builtin_amdgcn_ds_bpermute((lane ^ 32) << 2, __float_as_int(s)));
            if (fq == 0) ssp[(size_t)(r0 + rr) * 16 + u.pn * 4 + wc] = s;
            asm volatile("" ::: "memory");
        }
#undef ER_LD
    }
};
struct EpiUp {
    static constexpr bool PERM = true, AFTER_DRAIN = false;
    bf16_t* H; const float* rstd;
    __device__ __forceinline__ void operator()(const f32x4 (&acc)[2][2][4][2], const Unit& u, int wr, int wc, int fr, int fq) const {
        asm volatile("" : "+v"(fr), "+v"(fq));
        const int row0 = u.pm * BM + wr * 64 + fr, col0 = u.pn * BM + wc * 32 + 8 * fq;
        float rsv[2][4];
#pragma unroll
        for (int ai = 0; ai < 2; ++ai)
#pragma unroll
            for (int m = 0; m < 4; ++m) rsv[ai][m] = rstd[row0 + ai * HALF + m * 16];
#pragma unroll
        for (int ai = 0; ai < 2; ++ai)
#pragma unroll
            for (int m = 0; m < 4; ++m) { const int r = row0 + ai * HALF + m * 16; const float rs = rsv[ai][m]; bf16_t* rowp = H + (size_t)r * 4096 + col0;
#pragma unroll
                for (int bj = 0; bj < 2; ++bj) { f32x4 v0 = acc[ai][bj][m][0] * rs, v1 = acc[ai][bj][m][1] * rs;
#pragma unroll
                    for (int i = 0; i < 4; ++i) { const float a = fmaxf(v0[i], 0.f), b = fmaxf(v1[i], 0.f); v0[i] = a * a; v1[i] = b * b; }
                    u32x4 w; w.x = cvt_pk_bf16(v0[0], v0[1]); w.y = cvt_pk_bf16(v0[2], v0[3]); w.z = cvt_pk_bf16(v1[0], v1[1]); w.w = cvt_pk_bf16(v1[2], v1[3]);
                    *(u32x4*)(rowp + bj * HALF) = w; } }
    }
};
struct EpiPlain {
    static constexpr bool PERM = true, AFTER_DRAIN = false;
    bf16_t* O; int ldc;
    __device__ __forceinline__ void operator()(const f32x4 (&acc)[2][2][4][2], const Unit& u, int wr, int wc, int fr, int fq) const {
        asm volatile("" : "+v"(fr), "+v"(fq));
        const int row0 = u.pm * BM + wr * 64 + fr, col0 = u.pn * BM + wc * 32 + 8 * fq;
#pragma unroll
        for (int ai = 0; ai < 2; ++ai)
#pragma unroll
            for (int m = 0; m < 4; ++m) { bf16_t* rowp = O + (size_t)(row0 + ai * HALF + m * 16) * ldc + col0;
#pragma unroll
                for (int bj = 0; bj < 2; ++bj) { const f32x4 v0 = acc[ai][bj][m][0], v1 = acc[ai][bj][m][1];
                    u32x4 w; w.x = cvt_pk_bf16(v0[0], v0[1]); w.y = cvt_pk_bf16(v0[2], v0[3]); w.z = cvt_pk_bf16(v1[0], v1[1]); w.w = cvt_pk_bf16(v1[2], v1[3]);
                    *(u32x4*)(rowp + bj * HALF) = w; } }
    }
};
struct GroupOrder {
    int pm0, j, ncj;
    __device__ __forceinline__ bool next(int i, Unit& u) const { if (i >= 4 * ncj) return false; u.pm = pm0 + (i & 3); u.pn = j + 4 * (i >> 2); return true; }
    __device__ __forceinline__ void a_ready(const Unit&) const {}
    __device__ __forceinline__ void done(const Unit&) const {}
};
template <class Epi, class Sched, bool ALIGN_EPI = false, bool SP2 = false>
__device__ __forceinline__ void gemm_phase(PG8_LAS unsigned char* lds, const Gemm g, const Sched& S, const Epi& E, int tid_) {
    asm volatile("" : "+v"(tid_));
    const int tid = tid_, wid = __builtin_amdgcn_readfirstlane(tid >> 6), lane = tid & 63, wr = wid >> 2, wc = wid & 3, fr = lane & 15, fq = lane >> 4;
    const int K = g.K, nt = K / BK;
    unsigned voffA[2], voffB[2];
#pragma unroll
    for (int i = 0; i < 2; ++i) { int R, C; stage_rc(tid * 16 + i * 8192, R, C); const int Rb = Epi::PERM ? ((R & ~31) + perm32(R & 31)) : R;
        voffA[i] = (unsigned)(R * K + C) * 2u; voffB[i] = (unsigned)(Rb * K + C) * 2u; }
    const size_t kstep = (size_t)(BK * 2);
    const size_t hstep = (size_t)HALF * K * 2;
    const size_t tstep = 2 * hstep;
    const unsigned ldsw = (unsigned)wid * 1024u;
    const int aoff = lds_byte(wr * 64 + fr, fq * 8), boff = lds_byte(wc * 32 + fr, fq * 8);
#define PG8_SA(b, h) (((b) * 2 + (h)) * HTB)
#define PG8_SB(b, h) ((4 + (b) * 2 + (h)) * HTB)
#define PG8_STAGE(bufoff, gbase, voff) do { _Pragma("unroll") for (int _i = 0; _i < 2; ++_i) \
        __builtin_amdgcn_global_load_lds((const unsigned*)((const char*)(gbase) + (voff)[_i]), (PG8_LAS unsigned*)(lds + (bufoff) + ldsw + _i * 8192), 16, 0, 0); } while (0)
#define PG8_LDA(dst, b, h) do { _Pragma("unroll") for (int m = 0; m < 4; ++m) _Pragma("unroll") for (int k = 0; k < 2; ++k) dst[m][k] = *(const PG8_LAS bf16x8*)(lds + PG8_SA(b, h) + aoff + m * 2048 + k * 1024); } while (0)
#define PG8_LDB(dst, b, h) do { _Pragma("unroll") for (int n = 0; n < 2; ++n) _Pragma("unroll") for (int k = 0; k < 2; ++k) dst[n][k] = *(const PG8_LAS bf16x8*)(lds + PG8_SB(b, h) + boff + n * 2048 + k * 1024); } while (0)
#define PG8_MMA(ai, bj, At, Bt) do { __builtin_amdgcn_s_setprio(1); _Pragma("unroll") for (int m = 0; m < 4; ++m) _Pragma("unroll") for (int n = 0; n < 2; ++n) _Pragma("unroll") for (int k = 0; k < 2; ++k) \
        acc[ai][bj][m][n] = __builtin_amdgcn_mfma_f32_16x16x32_bf16(Bt[n][k], At[m][k], acc[ai][bj][m][n], 0, 0, 0); __builtin_amdgcn_s_setprio(0); } while (0)
#define PG8_WAIT_V(n) asm volatile("s_waitcnt vmcnt(" #n ")" ::: "memory")
#define PG8_WAIT_L(n) asm volatile("s_waitcnt lgkmcnt(" #n ")" ::: "memory")
#define PG8_BAR __builtin_amdgcn_s_barrier()
#define PG8_SCHED __builtin_amdgcn_sched_barrier(0)
    Unit cur, nxt; int ui = 0;
    if (!S.next(0, cur)) return;
    f32x4 acc[2][2][4][2];
#pragma unroll
    for (int a = 0; a < 2; ++a)
#pragma unroll
        for (int b = 0; b < 2; ++b)
#pragma unroll
            for (int m = 0; m < 4; ++m)
#pragma unroll
                for (int n = 0; n < 2; ++n) acc[a][b][m][n] = (f32x4){0.f, 0.f, 0.f, 0.f};
    bf16x8 At[4][2], B0[2][2], B1[2][2];
    const char* cA = (const char*)g.A + (size_t)cur.pm * tstep; const char* cB = (const char*)g.Bt + (size_t)cur.pn * tstep;
    S.a_ready(cur);
    if constexpr (SP2) {
        PG8_STAGE(PG8_SB(0, 0), cB, voffB); PG8_STAGE(PG8_SB(0, 1), cB + hstep, voffB); PG8_STAGE(PG8_SA(0, 0), cA, voffA); PG8_STAGE(PG8_SA(0, 1), cA + hstep, voffA);
        if (wr == 1) PG8_BAR;
        PG8_WAIT_V(2); PG8_BAR;
        PG8_STAGE(PG8_SB(1, 0), cB + kstep, voffB); PG8_STAGE(PG8_SA(1, 0), cA + kstep, voffA); PG8_STAGE(PG8_SB(1, 1), cB + hstep + kstep, voffB);
        PG8_WAIT_V(6); PG8_BAR;
    } else {
        PG8_STAGE(PG8_SB(0, 0), cB, voffB); PG8_STAGE(PG8_SA(0, 0), cA, voffA); PG8_STAGE(PG8_SB(0, 1), cB + hstep, voffB); PG8_STAGE(PG8_SA(0, 1), cA + hstep, voffA);
        if (wr == 1) PG8_BAR;
        PG8_WAIT_V(4); PG8_BAR;
        PG8_STAGE(PG8_SB(1, 0), cB + kstep, voffB); PG8_STAGE(PG8_SA(1, 0), cA + kstep, voffA); PG8_STAGE(PG8_SB(1, 1), cB + hstep + kstep, voffB);
        PG8_WAIT_V(6); PG8_BAR;
    }
    for (;;) {
        const bool has_next = S.next(ui + 1, nxt);
        const char* nA = has_next ? (const char*)g.A + (size_t)nxt.pm * tstep : cA; const char* nB = has_next ? (const char*)g.Bt + (size_t)nxt.pn * tstep : cB;
        for (int t = 0; t < nt; t += 2) {
            const bool last = (t == nt - 2);
            const char* a1 = cA + (size_t)(t + 1) * kstep;
            const char* a2 = last ? nA : cA + (size_t)(t + 2) * kstep; const char* b2 = last ? nB : cB + (size_t)(t + 2) * kstep;
            const char* a3 = a2 + kstep; const char* b3 = b2 + kstep;
            asm volatile("" : "+s"(a1), "+s"(a2), "+s"(b2), "+s"(a3), "+s"(b3));
            if (last && has_next) S.a_ready(nxt);
            if constexpr (SP2) {
            PG8_LDB(B0, 0, 0); PG8_LDB(B1, 0, 1); PG8_SCHED; PG8_LDA(At, 0, 0); PG8_STAGE(PG8_SA(1, 1), a1 + hstep, voffA);
            PG8_WAIT_V(8); PG8_WAIT_L(0); PG8_BAR; PG8_MMA(0, 0, At, B0); PG8_MMA(0, 1, At, B1); PG8_BAR; PG8_SCHED;
            PG8_LDA(At, 0, 1); PG8_STAGE(PG8_SB(0, 0), b2, voffB); PG8_STAGE(PG8_SB(0, 1), b2 + hstep, voffB); PG8_STAGE(PG8_SA(0, 0), a2, voffA);
            PG8_WAIT_V(8); PG8_WAIT_L(0); PG8_BAR; PG8_MMA(1, 0, At, B0); PG8_MMA(1, 1, At, B1); PG8_BAR; PG8_SCHED;
            PG8_LDB(B0, 1, 0); PG8_LDB(B1, 1, 1); PG8_SCHED; PG8_LDA(At, 1, 0); PG8_STAGE(PG8_SA(0, 1), a2 + hstep, voffA);
            PG8_WAIT_V(8); PG8_WAIT_L(0); PG8_BAR; PG8_MMA(0, 0, At, B0); PG8_MMA(0, 1, At, B1); PG8_BAR; PG8_SCHED;
            PG8_LDA(At, 1, 1); PG8_STAGE(PG8_SB(1, 0), b3, voffB); PG8_STAGE(PG8_SB(1, 1), b3 + hstep, voffB); PG8_STAGE(PG8_SA(1, 0), a3, voffA);
            PG8_WAIT_V(8); PG8_WAIT_L(0); PG8_BAR; PG8_MMA(1, 0, At, B0); PG8_MMA(1, 1, At, B1); PG8_BAR; PG8_SCHED;
            } else {
            PG8_LDB(B0, 0, 0); PG8_SCHED; PG8_LDA(At, 0, 0); PG8_STAGE(PG8_SA(1, 1), a1 + hstep, voffA);
            PG8_WAIT_L(8); PG8_BAR; PG8_WAIT_L(0); PG8_MMA(0, 0, At, B0); PG8_BAR; PG8_SCHED;
            PG8_LDB(B1, 0, 1); PG8_STAGE(PG8_SB(0, 0), b2, voffB);
            PG8_BAR; PG8_WAIT_L(0); PG8_MMA(0, 1, At, B1); PG8_BAR;
            PG8_LDA(At, 0, 1); PG8_STAGE(PG8_SA(0, 0), a2, voffA);
            PG8_BAR; PG8_WAIT_L(0); PG8_MMA(1, 0, At, B0); PG8_BAR; PG8_SCHED;
            PG8_STAGE(PG8_SB(0, 1), b2 + hstep, voffB);
            PG8_WAIT_V(6); PG8_BAR; PG8_MMA(1, 1, At, B1); PG8_BAR;
            PG8_LDB(B0, 1, 0); PG8_SCHED; PG8_LDA(At, 1, 0); PG8_STAGE(PG8_SA(0, 1), a2 + hstep, voffA);
            PG8_WAIT_L(8); PG8_BAR; PG8_WAIT_L(0); PG8_MMA(0, 0, At, B0); PG8_BAR; PG8_SCHED;
            PG8_LDB(B1, 1, 1); PG8_STAGE(PG8_SB(1, 0), b3, voffB);
            PG8_BAR; PG8_WAIT_L(0); PG8_MMA(0, 1, At, B1); PG8_BAR;
            PG8_LDA(At, 1, 1); PG8_STAGE(PG8_SA(1, 0), a3, voffA);
            PG8_BAR; PG8_WAIT_L(0); PG8_MMA(1, 0, At, B0); PG8_BAR; PG8_SCHED;
            PG8_STAGE(PG8_SB(1, 1), b3 + hstep, voffB);
            PG8_WAIT_V(6); PG8_BAR; PG8_MMA(1, 1, At, B1); PG8_BAR;
            }
        }
        if constexpr (ALIGN_EPI) { if (wr == 0) PG8_BAR; }
        if constexpr (!Epi::AFTER_DRAIN) { E(acc, cur, wr, wc, fr, fq); S.done(cur); }
        if (!has_next) break;
#pragma unroll
        for (int a = 0; a < 2; ++a)
#pragma unroll
            for (int b = 0; b < 2; ++b)
#pragma unroll
                for (int m = 0; m < 4; ++m)
#pragma unroll
                    for (int n = 0; n < 2; ++n) acc[a][b][m][n] = (f32x4){0.f, 0.f, 0.f, 0.f};
        cur = nxt; cA = nA; cB = nB; ++ui;
        if constexpr (ALIGN_EPI) { if (wr == 1) PG8_BAR; }
    }
    PG8_WAIT_V(0);
    if constexpr (!ALIGN_EPI) { if (wr == 0) PG8_BAR; }
    PG8_BAR;
    if constexpr (Epi::AFTER_DRAIN) { E.fused(acc, cur, wr, wc, fr, fq, lds, wid, lane); S.done(cur); }
#undef PG8_SA
#undef PG8_SB
#undef PG8_STAGE
#undef PG8_LDA
#undef PG8_LDB
#undef PG8_MMA
#undef PG8_WAIT_V
#undef PG8_WAIT_L
#undef PG8_BAR
#undef PG8_SCHED
}
}
#include <hip/hip_bf16.h>
#include <cmath>
namespace attn_body {
using bf16=__hip_bfloat16;
using bf16x8=__attribute__((ext_vector_type(8)))short;
using s16x4=__attribute__((ext_vector_type(4)))short;
using f32x16=__attribute__((ext_vector_type(16)))float;
using u32x4=__attribute__((ext_vector_type(4)))unsigned;
using f32x4v=__attribute__((ext_vector_type(4)))float;
constexpr int BATCH=16,NHEAD=8,SEQ=4096,D=64,DM=NHEAD*D,OPITCH=1024;
constexpr int NW=8,QBLK=32,QB=QBLK*NW,KVBLK=64,NQB=SEQ/QB;
constexpr int ATTN_PITCH=DM, ATTN_UNIT_ROWS=QB;
__device__ __forceinline__ int crow(int r,int hi){return (r&3)+8*(r>>2)+4*hi;}
#define SBAR() __builtin_amdgcn_sched_barrier(0)
__device__ __forceinline__ void cmask(f32x16&p0,f32x16&p1,int jb,int qrel,int hi){
  const float NEG=-INFINITY; int kb=64*jb+4*hi;
  #pragma unroll
  for(int r=0;r<16;++r){int kv=kb+(r&3)+8*(r>>2); if(kv>qrel)p0[r]=NEG; if(kv+32>qrel)p1[r]=NEG;}
}

constexpr int NSLOT=3, SLOTB=8192;
constexpr int LDS_K=0, LDS_V=NSLOT*SLOTB, LDS_WS=2*NSLOT*SLOTB, LDS_OST=LDS_WS+NW*64*4, LDS_BYTES=LDS_OST+NW*4096;
constexpr int LDS_CB=86016;
constexpr float C2=0.125f*1.4426950408889634f;
__device__ __forceinline__ void glds16(const void*gsrc,unsigned lds_dst){unsigned keep;
  asm volatile("s_mov_b32 %0, m0\n\ts_mov_b32 m0, %2\n\ts_nop 0\n\tglobal_load_lds_dwordx4 %1, off\n\ts_mov_b32 m0, %0":"=&s"(keep):"v"(gsrc),"s"(lds_dst):"memory");}
__device__ __forceinline__ float max3f(float a,float b,float c){float r;asm("v_max3_f32 %0, %1, %2, %3":"=v"(r):"v"(a),"v"(b),"v"(c));return r;}
__device__ __forceinline__ float max2f(float a,float b){float r;asm("v_max_f32_e32 %0, %1, %2":"=v"(r):"v"(a),"v"(b));return r;}
__device__ __forceinline__ float fadd_s(float a,float b){float r;asm("v_add_f32_e32 %0, %1, %2":"=v"(r):"v"(a),"v"(b));return r;}
__device__ __forceinline__ float fsub_s(float a,float b){float r;asm("v_sub_f32_e32 %0, %1, %2":"=v"(r):"v"(a),"v"(b));return r;}
typedef float f32x2_t __attribute__((ext_vector_type(2))); typedef __bf16 bf16x2_t __attribute__((ext_vector_type(2)));
__device__ __forceinline__ unsigned cvtpk_s(float lo,float hi){f32x2_t v={lo,hi};bf16x2_t b=__builtin_convertvector(v,bf16x2_t);return __builtin_bit_cast(unsigned,b);}
#define WAIT_BAR(N) asm volatile("s_waitcnt vmcnt(" #N ") lgkmcnt(0)\n\ts_barrier":::"memory")

__device__ __forceinline__ void qkt(f32x16&p0,f32x16&p1,const char*Kslot,const bf16x8*qr,const f32x16&negm,int r32,int hi){
  const char*kb=Kslot+hi*1024+r32*16;
  #pragma unroll
  for(int d0=0;d0<4;++d0){
    const bf16x8 b0=*reinterpret_cast<const bf16x8*>(kb+d0*2048);
    const bf16x8 b1=*reinterpret_cast<const bf16x8*>(kb+d0*2048+512);
    if(d0==0){p0=__builtin_amdgcn_mfma_f32_32x32x16_bf16(b0,qr[0],negm,0,0,0);p1=__builtin_amdgcn_mfma_f32_32x32x16_bf16(b1,qr[0],negm,0,0,0);}
    else{p0=__builtin_amdgcn_mfma_f32_32x32x16_bf16(b0,qr[d0],p0,0,0,0);p1=__builtin_amdgcn_mfma_f32_32x32x16_bf16(b1,qr[d0],p1,0,0,0);}}
}
typedef __attribute__((address_space(3))) const char* lds_cptr;
typedef short v4i16_t __attribute__((ext_vector_type(4)));
__device__ __forceinline__ void kload8(bf16x8*kf,lds_cptr kp){
  kf[0]=*(const __attribute__((address_space(3))) bf16x8*)(kp);      kf[1]=*(const __attribute__((address_space(3))) bf16x8*)(kp+512);
  kf[2]=*(const __attribute__((address_space(3))) bf16x8*)(kp+2048); kf[3]=*(const __attribute__((address_space(3))) bf16x8*)(kp+2560);
  kf[4]=*(const __attribute__((address_space(3))) bf16x8*)(kp+4096); kf[5]=*(const __attribute__((address_space(3))) bf16x8*)(kp+4608);
  kf[6]=*(const __attribute__((address_space(3))) bf16x8*)(kp+6144); kf[7]=*(const __attribute__((address_space(3))) bf16x8*)(kp+6656);
}
__device__ __forceinline__ void kload2(bf16x8*kf,lds_cptr kp,int j){ kf[2*j]=*(const __attribute__((address_space(3))) bf16x8*)(kp+j*2048); kf[2*j+1]=*(const __attribute__((address_space(3))) bf16x8*)(kp+j*2048+512); }
__device__ __forceinline__ s16x4 vtr(lds_cptr p){ return __builtin_bit_cast(s16x4,__builtin_amdgcn_ds_read_tr16_b64_v4i16((__attribute__((address_space(3))) v4i16_t*)p)); }
__device__ __forceinline__ float rowmax(const f32x16&p0,const f32x16&p1){
  float a=max3f(p0[0],p0[1],p1[0]),b=max3f(p0[2],p0[3],p1[1]);a=max3f(a,p1[2],p1[3]);
  #pragma unroll
  for(int r=4;r<16;r+=4){a=max3f(a,p0[r],p0[r+1]);b=max3f(b,p0[r+2],p0[r+3]);a=max3f(a,p1[r],p1[r+1]);b=max3f(b,p1[r+2],p1[r+3]);}
  const float m=max2f(a,b);
  auto rr=__builtin_amdgcn_permlane32_swap(__float_as_uint(m),__float_as_uint(m),false,false);
  return max2f(__uint_as_float(rr[0]),__uint_as_float(rr[1]));
}
__device__ __forceinline__ void pv(f32x16*o,int vb,bf16x8 pa0,bf16x8 pa1,bf16x8 pa2,bf16x8 pa3){
  #pragma unroll
  for(int d0=0;d0<2;++d0){s16x4 lo[4],hi[4];
    #pragma unroll
    for(int ks=0;ks<4;++ks){
      asm volatile("ds_read_b64_tr_b16 %0,%1 offset:%c2":"=&v"(lo[ks]):"v"(vb),"i"(d0*4096+ks*1024):"memory");
      asm volatile("ds_read_b64_tr_b16 %0,%1 offset:%c2":"=&v"(hi[ks]):"v"(vb),"i"(d0*4096+ks*1024+512):"memory");}
    asm volatile("s_waitcnt lgkmcnt(0)":::"memory");SBAR();
    #define PK(k) (bf16x8){lo[k][0],lo[k][1],lo[k][2],lo[k][3],hi[k][0],hi[k][1],hi[k][2],hi[k][3]}
    o[d0]=__builtin_amdgcn_mfma_f32_32x32x16_bf16(pa0,PK(0),o[d0],0,0,0);
    o[d0]=__builtin_amdgcn_mfma_f32_32x32x16_bf16(pa1,PK(1),o[d0],0,0,0);
    o[d0]=__builtin_amdgcn_mfma_f32_32x32x16_bf16(pa2,PK(2),o[d0],0,0,0);
    o[d0]=__builtin_amdgcn_mfma_f32_32x32x16_bf16(pa3,PK(3),o[d0],0,0,0);
    #undef PK
  }
}

#ifndef ATTN_STORE16
#define ATTN_STORE16(p,v) (*(u32x4*)(p)=(v))
#endif
template<int THRL> __device__ __forceinline__ void attn_unit(int b,int h,int qb,const bf16*Q,const bf16*__restrict__ K,const bf16*__restrict__ V,bf16*O,const float*gfox,char*shm,int tid_,int ts_){
  asm volatile("":"+v"(tid_)); const int tid=tid_,lane=tid&63,r32=lane&31,hi=lane>>5; const int wid=__builtin_amdgcn_readfirstlane(tid>>6);
  const long rowbase=(long)b*SEQ; const int q0=qb*QB;
  const bf16*Qw=Q+(rowbase+q0+wid*QBLK)*DM+h*D;
  const bf16*Kh=K+(rowbase+(long)ts_*KVBLK)*DM+h*D,*Vh=V+(rowbase+(long)ts_*KVBLK)*DM+h*D;
  const unsigned lds0=(unsigned)(uintptr_t)shm;
  float*wsf=(float*)(shm+LDS_WS)+wid*64;
  const bf16*ksrc=Kh+(long)lane*DM+wid*8;
  const bf16*vsrc=Vh+(long)(16*(wid&3)+(lane>>2))*DM+(wid>>2)*32+(lane&3)*8;
  const unsigned kdst=lds0+LDS_K+wid*1024, vdst=lds0+LDS_V+wid*1024;
  #define DMA_K(t,slot) glds16(ksrc+(long)(t)*KVBLK*DM,(unsigned)__builtin_amdgcn_readfirstlane(kdst+(slot)))
  #define DMA_V(t,slot) glds16(vsrc+(long)(t)*KVBLK*DM,(unsigned)__builtin_amdgcn_readfirstlane(vdst+(slot)))
  const int vb0=(int)(lds0+LDS_V)+((lane>>4)&1)*32+(lane&3)*8+(4*hi+((lane&15)>>2))*64;
  const char*Kbase=shm+LDS_K; bf16x8 kf[8];
  const lds_cptr shm3=(lds_cptr)shm; const lds_cptr kp0=shm3+LDS_K+hi*1024+r32*16; const lds_cptr vp0=shm3+LDS_V+((lane>>4)&1)*32+(lane&3)*8+(4*hi+((lane&15)>>2))*64;
  const int NT=(q0+QB)/KVBLK-ts_;
  DMA_K(0,0);DMA_V(0,0);DMA_K(1,SLOTB);
  bf16x8 qr[4];
  #pragma unroll
  for(int d0=0;d0<4;++d0)qr[d0]=*reinterpret_cast<const bf16x8*>(&Qw[(long)r32*DM+d0*16+hi*8]);
  float mhat=0.f,l_reg=0.f;f32x16 o[2]; float zz_=0.f; asm volatile("":"+v"(zz_));
  #pragma unroll
  for(int r=0;r<16;++r){o[0][r]=zz_;o[1][r]=zz_;}
  f32x16 negm;
  #pragma unroll
  for(int r=0;r<16;++r)negm[r]=zz_;
  asm volatile("":"+v"(negm));
  const int qrel=wid*QBLK+r32;
  const __attribute__((address_space(3))) f32x4v* cbq=(const __attribute__((address_space(3))) f32x4v*)((lds_cptr)shm+LDS_CB)+hi+ts_*16;
  #define CINIT(C0,C1,t) do{ const __attribute__((address_space(3))) f32x4v* cb_=cbq+(t)*16; const float nm_=-mhat; \
    _Pragma("unroll") for(int j_=0;j_<4;++j_){ const f32x4v a_=cb_[2*j_], b_=cb_[8+2*j_]; \
      C0[4*j_]=nm_-a_[0]; C0[4*j_+1]=nm_-a_[1]; C0[4*j_+2]=nm_-a_[2]; C0[4*j_+3]=nm_-a_[3]; \
      C1[4*j_]=nm_-b_[0]; C1[4*j_+1]=nm_-b_[1]; C1[4*j_+2]=nm_-b_[2]; C1[4*j_+3]=nm_-b_[3]; } }while(0)
  #define FBIAS(P0,P1,t) do{ const __attribute__((address_space(3))) f32x4v* cb_=cbq+(t)*16; \
    _Pragma("unroll") for(int j_=0;j_<4;++j_){ const f32x4v a_=cb_[2*j_], b_=cb_[8+2*j_]; \
      P0[4*j_]-=a_[0]; P0[4*j_+1]-=a_[1]; P0[4*j_+2]-=a_[2]; P0[4*j_+3]-=a_[3]; \
      P1[4*j_]-=b_[0]; P1[4*j_+1]-=b_[1]; P1[4*j_+2]-=b_[2]; P1[4*j_+3]-=b_[3]; } }while(0)
  #define CMASK(P0,P1,t) do{int jb_=(t)-(NT-4); if(jb_>=0)cmask(P0,P1,jb_,qrel,hi);}while(0)
  bool resc=false;
  #define START(P0,P1) do{ const float rm=rowmax(P0,P1); resc=false; \
    { const float dl=rm; mhat=fadd_s(mhat,dl); \
      _Pragma("unroll") for(int r=0;r<16;++r){P0[r]=fsub_s(P0[r],dl);P1[r]=fsub_s(P1[r],dl);} \
      } \
    _Pragma("unroll") for(int r=0;r<16;++r)P0[r]=__builtin_amdgcn_exp2f(P0[r]); }while(0)
  #define RESC() do{ if(resc){ asm volatile("s_waitcnt lgkmcnt(0)":::"memory"); \
      _Pragma("unroll") for(int d_=0;d_<2;++d_) _Pragma("unroll") for(int r=0;r<16;++r)o[d_][r]*=wsf[crow(r,hi)]; } }while(0)
  f32x16 pA0,pA1,pB0,pB1;
  int sl_prev=0,sl_cur=0,sl_next=SLOTB;
  #define ROT() do{sl_prev=sl_cur;sl_cur=sl_next;sl_next=(sl_next==(NSLOT-1)*SLOTB)?0:sl_next+SLOTB;}while(0)
  DMA_K(2,2*SLOTB);
  WAIT_BAR(3);
  qkt(pA0,pA1,Kbase,qr,negm,r32,hi);asm volatile("s_nop 15\n\ts_nop 7":"+v"(pA0),"+v"(pA1));FBIAS(pA0,pA1,0);CMASK(pA0,pA1,0);
  START(pA0,pA1);
  _Pragma("unroll") for(int r=0;r<16;++r)pA1[r]=__builtin_amdgcn_exp2f(pA1[r]);
  WAIT_BAR(0);
  DMA_K(3,0);DMA_V(1,SLOTB);
  ROT();
  kload8(kf,kp0+sl_cur);
  WAIT_BAR(2);
  s16x4 vlo[8],vhi[8]; u32x4 pw0,pw1,pw2,pw3;
  #define PKW(P,B) cvtpk_s(P[B],P[B+1])
  #define PAF(k) __builtin_bit_cast(bf16x8,pw##k)
  #define VFR(i) (bf16x8){vlo[i][0],vlo[i][1],vlo[i][2],vlo[i][3],vhi[i][0],vhi[i][1],vhi[i][2],vhi[i][3]}
  #define PIN(x) asm volatile("":"+v"(x))
  #define MX3(a,b,c) __builtin_fmaxf(__builtin_fmaxf((a),(b)),(c))
  #define GAPA(MF,A0,A1,A2,A3,W0,W1,PW) do{ MF; sacc+=A0; sacc+=A1; sacc+=A2; sacc+=A3; PIN(sacc); W0; W1; PIN(PW); SBAR(); }while(0)
  #define EX(v) __builtin_amdgcn_exp2f(v)
  #define GAPB(MF,X,B) do{ MF; X[B]=EX(X[B]); X[B+1]=EX(X[B+1]); X[B+2]=EX(X[B+2]); X[B+3]=EX(X[B+3]); PIN(X); SBAR(); }while(0)
  #define VRD(i) do{ vlo[i]=vtr(vp_+(((i)>>2)*4096+((i)&3)*1024)); vhi[i]=vtr(vp_+(((i)>>2)*4096+((i)&3)*1024+512)); }while(0)
  #define KRD(G,j) do{ if(G){ kload2(kf,kp0+sl_next,j); SBAR(); } }while(0)
  #define STEP(C0,C1,P0,P1,t,GK,GV,GL) do{ SBAR(); \
    const lds_cptr vp_=vp0+sl_prev; CINIT(C0,C1,t); SBAR(); \
    VRD(0); SBAR(); float sacc=(P0[0]+P0[1]); \
    GAPA(C0=__builtin_amdgcn_mfma_f32_32x32x16_bf16(kf[0],qr[0],C0,0,0,0), P0[2],P0[3],P0[4],P0[5],     pw0[0]=PKW(P0,0), pw0[1]=PKW(P0,2), pw0); \
    VRD(4); SBAR(); GAPA(C1=__builtin_amdgcn_mfma_f32_32x32x16_bf16(kf[1],qr[0],C1,0,0,0), P0[6],P0[7],P0[8],P0[9],     pw0[2]=PKW(P0,4), pw0[3]=PKW(P0,6), pw0); \
    VRD(1); SBAR(); GAPA(C0=__builtin_amdgcn_mfma_f32_32x32x16_bf16(kf[2],qr[1],C0,0,0,0),   P0[10],P0[11],P0[12],P0[13], pw1[0]=PKW(P0,8), pw1[1]=PKW(P0,10), pw1); \
    VRD(5); SBAR(); GAPA(C1=__builtin_amdgcn_mfma_f32_32x32x16_bf16(kf[3],qr[1],C1,0,0,0),   P0[14],P0[15],P1[0],P1[1],   pw1[2]=PKW(P0,12),pw1[3]=PKW(P0,14), pw1); \
    VRD(2); SBAR(); GAPA(C0=__builtin_amdgcn_mfma_f32_32x32x16_bf16(kf[4],qr[2],C0,0,0,0),   P1[2],P1[3],P1[4],P1[5],     pw2[0]=PKW(P1,0), pw2[1]=PKW(P1,2), pw2); \
    VRD(6); SBAR(); GAPA(C1=__builtin_amdgcn_mfma_f32_32x32x16_bf16(kf[5],qr[2],C1,0,0,0),   P1[6],P1[7],P1[8],P1[9],     pw2[2]=PKW(P1,4), pw2[3]=PKW(P1,6), pw2); \
    VRD(3); SBAR(); GAPA(C0=__builtin_amdgcn_mfma_f32_32x32x16_bf16(kf[6],qr[3],C0,0,0,0),   P1[10],P1[11],P1[12],P1[13], pw3[0]=PKW(P1,8), pw3[1]=PKW(P1,10), pw3); \
    VRD(7); SBAR(); GAPA(C1=__builtin_amdgcn_mfma_f32_32x32x16_bf16(kf[7],qr[3],C1,0,0,0),   P1[14],P1[15],0.f,0.f,       pw3[2]=PKW(P1,12),pw3[3]=PKW(P1,14), pw3); \
    l_reg+=sacc; \
    if(GK){DMA_K((t)+3,sl_cur);} if(GV){DMA_V((t)+1,sl_next);} \
    CMASK(C0,C1,t); \
    { float a=MX3(C0[0],C0[1],C1[0]),b=MX3(C0[2],C0[3],C1[1]); a=MX3(a,C1[2],C1[3]); \
      _Pragma("unroll") for(int r=4;r<16;r+=4){a=MX3(a,C0[r],C0[r+1]);b=MX3(b,C0[r+2],C0[r+3]);a=MX3(a,C1[r],C1[r+1]);b=MX3(b,C1[r+2],C1[r+3]);} \
      float rm=__builtin_fmaxf(a,b); { auto rr=__builtin_amdgcn_permlane32_swap(__float_as_uint(rm),__float_as_uint(rm),false,false); rm=__builtin_fmaxf(__uint_as_float(rr[0]),__uint_as_float(rr[1])); } \
      resc=false; \
      if(__builtin_expect(__any(rm>(float)THRL),0)){ const float dl=__builtin_fmaxf(rm,0.f); mhat+=dl; \
        _Pragma("unroll") for(int r=0;r<16;++r){C0[r]-=dl;C1[r]-=dl;} \
        const float f=__builtin_amdgcn_exp2f(-dl); l_reg*=f; if(hi==0)wsf[r32]=f; resc=true; } } \
    SBAR(); \
    GAPB(o[0]=__builtin_amdgcn_mfma_f32_32x32x16_bf16(PAF(0),VFR(0),o[0],0,0,0), C0,0); \
    GAPB(o[1]=__builtin_amdgcn_mfma_f32_32x32x16_bf16(PAF(0),VFR(4),o[1],0,0,0), C0,4); \
    KRD(GL,0); GAPB(o[0]=__builtin_amdgcn_mfma_f32_32x32x16_bf16(PAF(1),VFR(1),o[0],0,0,0), C0,8); \
    KRD(GL,1); GAPB(o[1]=__builtin_amdgcn_mfma_f32_32x32x16_bf16(PAF(1),VFR(5),o[1],0,0,0), C0,12); \
    KRD(GL,2); GAPB(o[0]=__builtin_amdgcn_mfma_f32_32x32x16_bf16(PAF(2),VFR(2),o[0],0,0,0), C1,0); \
    KRD(GL,3); GAPB(o[1]=__builtin_amdgcn_mfma_f32_32x32x16_bf16(PAF(2),VFR(6),o[1],0,0,0), C1,4); \
    GAPB(o[0]=__builtin_amdgcn_mfma_f32_32x32x16_bf16(PAF(3),VFR(3),o[0],0,0,0), C1,8); \
    GAPB(o[1]=__builtin_amdgcn_mfma_f32_32x32x16_bf16(PAF(3),VFR(7),o[1],0,0,0), C1,12); \
    }while(0)
  int t=1;
  #undef CMASK
  #define CMASK(P0,P1,t) do{}while(0)
  for(;t+5<NT;t+=2){
    STEP(pB0,pB1,pA0,pA1,t,true,true,true);     WAIT_BAR(2); RESC(); ROT();
    STEP(pA0,pA1,pB0,pB1,t+1,true,true,true);   WAIT_BAR(2); RESC(); ROT();
  }
  #undef CMASK
  #define CMASK(P0,P1,t) do{int jb_=(t)-(NT-4); if(jb_>=0)cmask(P0,P1,jb_,qrel,hi);}while(0)
  #define ENDW(tt) do{ if((tt)+3<NT){WAIT_BAR(2);} else if((tt)+2<NT){WAIT_BAR(1);} else {WAIT_BAR(0);} }while(0)
  for(;t+1<NT;t+=2){
    STEP(pB0,pB1,pA0,pA1,t,(t+3<NT),(t+1<NT),(t+1<NT));       ENDW(t);   RESC(); ROT();
    STEP(pA0,pA1,pB0,pB1,t+1,(t+4<NT),(t+2<NT),(t+2<NT));     ENDW(t+1); RESC(); ROT();
  }
  STEP(pB0,pB1,pA0,pA1,NT-1,false,false,false); RESC();
  { float sacc=pB0[0]+pB0[1]; _Pragma("unroll") for(int r=2;r<16;++r)sacc+=pB0[r]; _Pragma("unroll") for(int r=0;r<16;++r)sacc+=pB1[r]; l_reg+=sacc;
    pw0=(u32x4){PKW(pB0,0),PKW(pB0,2),PKW(pB0,4),PKW(pB0,6)};pw1=(u32x4){PKW(pB0,8),PKW(pB0,10),PKW(pB0,12),PKW(pB0,14)};pw2=(u32x4){PKW(pB1,0),PKW(pB1,2),PKW(pB1,4),PKW(pB1,6)};pw3=(u32x4){PKW(pB1,8),PKW(pB1,10),PKW(pB1,12),PKW(pB1,14)};
    SBAR(); pv(o,vb0+sl_cur,PAF(0),PAF(1),PAF(2),PAF(3)); }
  #undef PKW
  #undef PAF
  #undef VFR
  #undef PIN
  #undef MX3
  #undef GAPA
  #undef GAPB
  #undef EX
  #undef VRD
  #undef KRD
  #undef STEP
  #undef ENDW
  {auto rr=__builtin_amdgcn_permlane32_swap(__float_as_uint(l_reg),__float_as_uint(l_reg),false,false);l_reg=__uint_as_float(rr[0])+__uint_as_float(rr[1]);}
  if(hi==0)wsf[32+r32]=l_reg;asm volatile("s_waitcnt lgkmcnt(0)":::"memory");
  float rli[16];
  #pragma unroll
  for(int r=0;r<16;++r)rli[r]=__builtin_amdgcn_rcpf(wsf[32+crow(r,hi)]);
  bf16*Ow=O+(rowbase+q0+wid*QBLK)*OPITCH+h*D;
  { bf16*stg=(bf16*)(shm+LDS_OST)+wid*2048;
    #pragma unroll
    for(int r=0;r<16;++r){const int orow=crow(r,hi);
      #pragma unroll
      for(int d0=0;d0<2;++d0)stg[orow*64+d0*32+r32]=__float2bfloat16(o[d0][r]*rli[r]);}
    asm volatile("s_waitcnt lgkmcnt(0)":::"memory");
    #pragma unroll
    for(int i=0;i<4;++i){const int row=i*8+(lane>>3),ch=lane&7; const u32x4 v=*(const u32x4*)(stg+row*64+ch*8);
      float f[8]; f[0]=__uint_as_float(v.x<<16);f[1]=__uint_as_float(v.x&0xffff0000u);f[2]=__uint_as_float(v.y<<16);f[3]=__uint_as_float(v.y&0xffff0000u);
      f[4]=__uint_as_float(v.z<<16);f[5]=__uint_as_float(v.z&0xffff0000u);f[6]=__uint_as_float(v.w<<16);f[7]=__uint_as_float(v.w&0xffff0000u);
      float ss=0.f;
      #pragma unroll
      for(int j=0;j<8;++j)ss+=f[j]*f[j];
      ss+=__int_as_float(__builtin_amdgcn_ds_bpermute((lane^1)<<2,__float_as_int(ss)));ss+=__int_as_float(__builtin_amdgcn_ds_bpermute((lane^2)<<2,__float_as_int(ss)));ss+=__int_as_float(__builtin_amdgcn_ds_bpermute((lane^4)<<2,__float_as_int(ss)));
      const float rs=1.0f/sqrtf(ss*(1.0f/64.0f)+1e-6f);
      const f32x4v g0=*(const f32x4v*)(gfox+h*D+ch*8),g1=*(const f32x4v*)(gfox+h*D+ch*8+4);
      u32x4 w; w.x=cvtpk_s(f[0]*rs*g0[0],f[1]*rs*g0[1]); w.y=cvtpk_s(f[2]*rs*g0[2],f[3]*rs*g0[3]); w.z=cvtpk_s(f[4]*rs*g1[0],f[5]*rs*g1[1]); w.w=cvtpk_s(f[6]*rs*g1[2],f[7]*rs*g1[3]);
      ATTN_STORE16(Ow+(long)row*OPITCH+ch*8,w);} }
  asm volatile("s_waitcnt lgkmcnt(0)\n\ts_barrier":::"memory");
  #undef DMA_K
  #undef DMA_V
  #undef CMASK
  #undef FBIAS
  #undef CINIT
  #undef START
  #undef RESC
  #undef ROT
}
constexpr int ATTN_LDS_BYTES=LDS_BYTES;
#undef SBAR
#undef WAIT_BAR
}
#include <hip/hip_cooperative_groups.h>
namespace cg = cooperative_groups;
constexpr int NWAVES = 8, NTHR = 512;
constexpr int BATCH = 16, SEQ = 4096, DM = 1024, FF = 4096, M = BATCH * SEQ, PLE = 256, NZ = 3840, WIN_LD = 3600;
constexpr float EPS = 1e-6f;
constexpr size_t MiB = 1u << 20;
constexpr size_t WS_CTL = 0, CTL_BYTES = 65536;
constexpr size_t WS_WIN = 2 * MiB, WS_WOUT = 10 * MiB, WS_WUP = 12 * MiB, WS_WDN = 20 * MiB, WS_WPG = 28 * MiB, WS_WPLE = 30 * MiB;
constexpr size_t WS_XN = 32 * MiB;
constexpr size_t WS_Z = 160 * MiB;
constexpr size_t WS_QC = 544 * MiB, WS_KC = 608 * MiB;
constexpr size_t WS_H = 160 * MiB;
constexpr size_t WS_MO = 672 * MiB, WS_MIX = 736 * MiB, WS_G = 864 * MiB, WS_PB = 868 * MiB, WS_RSTD = 900 * MiB, WS_RSI = 900 * MiB + 512 * 1024, WS_SSP = 901 * MiB, WS_CBG = 906 * MiB, WS_QKB = 908 * MiB, WS_SSP2 = 909 * MiB, WS_SSP3 = 913 * MiB, WS_END = 917 * MiB;
constexpr int RING_BYTES = 131072, LDS_TOTAL = 147456;
#define LAS __attribute__((address_space(3)))
typedef unsigned short bf16;
typedef unsigned v4u __attribute__((ext_vector_type(4)));
typedef unsigned v2u __attribute__((ext_vector_type(2)));
typedef float f32x4 __attribute__((ext_vector_type(4)));
typedef float f32x2 __attribute__((ext_vector_type(2)));
typedef float f32x2_c __attribute__((ext_vector_type(2))); typedef __bf16 bf16x2_c __attribute__((ext_vector_type(2)));
__device__ __forceinline__ unsigned pk2(float lo, float hi) { const f32x2_c v = {lo, hi}; return __builtin_bit_cast(unsigned, __builtin_convertvector(v, bf16x2_c)); }
__device__ __forceinline__ unsigned f2bf(float f) { return pk2(f, 0.f) & 0xffffu; }
__device__ __forceinline__ float bflo(unsigned w) { return __uint_as_float(w << 16); }
__device__ __forceinline__ float bfhi(unsigned w) { return __uint_as_float(w & 0xffff0000u); }
__device__ __forceinline__ float xsig(float x, float y) { return x * __builtin_amdgcn_rcpf(1.f + __expf(-y)); }
__device__ __forceinline__ float shx(float v, int o, int lane) { return __int_as_float(__builtin_amdgcn_ds_bpermute((lane ^ o) << 2, __float_as_int(v))); }
__device__ __forceinline__ float shu(float v, int o, int lane) { return __int_as_float(__builtin_amdgcn_ds_bpermute((lane - o) << 2, __float_as_int(v))); }
__device__ __forceinline__ float shl(float v, int src) { return __int_as_float(__builtin_amdgcn_ds_bpermute(src << 2, __float_as_int(v))); }
__device__ __forceinline__ float wave_sum(float v, int lane) {
#pragma unroll
    for (int o = 1; o < 64; o <<= 1) v += shx(v, o, lane);
    return v;
}
__device__ __forceinline__ void block_seam() {
    asm volatile("s_waitcnt vmcnt(0) lgkmcnt(0)" ::: "memory");
    __syncthreads();
    __builtin_amdgcn_fence(__ATOMIC_ACQUIRE, "agent");
    asm volatile("s_waitcnt vmcnt(0)" ::: "memory");
}
__device__ __forceinline__ void p0_transpose_item(const float* W, int ldw, int ncols, int K, bf16* WT, int row_off, const float* gain, LAS float* scr, int item, int lane) {
    const int nblk = ncols / 32, kb = item / nblk, nb = item % nblk, k0 = 64 * kb, n0 = 32 * nb;
#pragma unroll 16
    for (int i = 0; i < 32; ++i) { const int kk = 2 * i + (lane >> 5); float v = W[(size_t)(k0 + kk) * ldw + n0 + (lane & 31)]; if (gain) v *= gain[k0 + kk]; scr[kk * 33 + (lane & 31)] = v; }
    asm volatile("s_waitcnt lgkmcnt(0)" ::: "memory");
    const int c = lane & 7;
#pragma unroll
    for (int j = 0; j < 4; ++j) { const int n = (lane >> 3) + 8 * j; const LAS float* s = scr + (8 * c) * 33 + n;
        v4u o; o.x = pk2(s[0 * 33], s[1 * 33]); o.y = pk2(s[2 * 33], s[3 * 33]); o.z = pk2(s[4 * 33], s[5 * 33]); o.w = pk2(s[6 * 33], s[7 * 33]);
        *(v4u*)(WT + (size_t)(row_off + n0 + n) * K + k0 + 8 * c) = o; }
    asm volatile("s_waitcnt lgkmcnt(0)" ::: "memory");
}
__device__ __forceinline__ int gate_src_col(int j) { return j < 8 ? 1536 + j : (j < 12 ? 3080 + (j - 8) : 3084 + (j - 12)); }

template <class T> __device__ __forceinline__ T* opq(T* p) { asm volatile("" : "+s"(p)); return p; }
typedef __attribute__((address_space(1))) unsigned gu32;
#define RLX_AGENT __ATOMIC_RELAXED, __HIP_MEMORY_SCOPE_AGENT
#define XB_TMO      128
#define XB_XCNT(j)  (256  + 64 * (j))
#define XB_XSUB(j)  (1280 + 64 * (j))
#define XB_XGEN(j)  (2304 + 64 * (j))
#define XB_TOP      3328
#define XB_TOPGEN   3392
#define XCD_BAR_WORDS 3456
#define XB_SPIN_CAP (1u << 18)

__device__ __forceinline__ unsigned xb_ld(unsigned* p)              { return __hip_atomic_load(p, __ATOMIC_RELAXED, __HIP_MEMORY_SCOPE_AGENT); }
__device__ __forceinline__ unsigned xb_add(unsigned* p, unsigned v) { return __hip_atomic_fetch_add(p, v, __ATOMIC_RELAXED, __HIP_MEMORY_SCOPE_AGENT); }
__device__ __forceinline__ unsigned xb_xcc_id() { return (unsigned)__builtin_amdgcn_s_getreg((3 << 11) | 20) & 0xFu; }
#define XB_SPIN(cond, bar) do { unsigned _sp = 0; while (cond) { __builtin_amdgcn_s_sleep(1); \
    if ((++_sp & 255u) == 0u) { if (xb_ld(&(bar)[XB_TMO])) break; if (_sp > XB_SPIN_CAP) { atomicAdd(&(bar)[XB_TMO], 1u); break; } } } } while (0)

struct XcdBarrier {
    unsigned* bar; unsigned x;
    volatile LAS unsigned* st;
};

__device__ __forceinline__ XcdBarrier xcd_barrier_make(unsigned* bar, volatile LAS unsigned* st) { XcdBarrier b; b.bar = bar; b.x = xb_xcc_id(); b.st = st; return b; }
__device__ __forceinline__ void xcd_barrier_post(const XcdBarrier& b, bool t0) { if (t0) (void)xb_add(&b.bar[XB_XCNT(b.x)], 1u); }
__device__ __forceinline__ void xcd_barrier_complete(unsigned* bar, unsigned x, unsigned& nloc, unsigned& nx) {
    const unsigned G = gridDim.x * gridDim.y * gridDim.z;
    unsigned sum, cnt, mine, sp = 0u;
    for (;;) {
        sum = 0u; cnt = 0u; mine = 0u;
#pragma unroll
        for (unsigned j = 0; j < 16; ++j) { const unsigned c = xb_ld(&bar[XB_XCNT(j)]); sum += c; cnt += (c > 0u) ? 1u : 0u; mine = (j == x) ? c : mine; }
        if (sum == G) break;
        __builtin_amdgcn_s_sleep(1);
        if ((++sp & 255u) == 0u) { if (xb_ld(&bar[XB_TMO])) break; if (sp > XB_SPIN_CAP) { atomicAdd(&bar[XB_TMO], 1u); break; } }
    }
    nloc = mine > 0u ? mine : 1u; nx = cnt > 0u ? cnt : 1u;
}

__device__ __forceinline__ void xcd_barrier(const XcdBarrier& b, bool t0) {
    asm volatile("s_waitcnt vmcnt(0)" ::: "memory");
    __syncthreads();
    if (t0) {
        unsigned* bar = b.bar;
        __builtin_amdgcn_s_waitcnt(0);
        unsigned nloc = b.st[0], nx = b.st[1];
        if (nloc == 0u) { xcd_barrier_complete(bar, b.x, nloc, nx); b.st[0] = nloc; b.st[1] = nx; }
        const unsigned old = xb_add(&bar[XB_XSUB(b.x)], 1u);
        const unsigned gen = old / nloc;
        if (old + 1u == (gen + 1u) * nloc) {
            __builtin_amdgcn_fence(__ATOMIC_RELEASE, "agent");
            asm volatile("s_waitcnt vmcnt(0)" ::: "memory");
            const unsigned og = xb_add(&bar[XB_TOP], 1u);
            const unsigned tg = og / nx;
            if (og + 1u == (tg + 1u) * nx) xb_add(&bar[XB_TOPGEN], 1u);
            else XB_SPIN(xb_ld(&bar[XB_TOPGEN]) == tg, bar);
            __builtin_amdgcn_fence(__ATOMIC_ACQUIRE, "agent");
            xb_add(&bar[XB_XGEN(b.x)], 1u);
            asm volatile("s_waitcnt vmcnt(0)" ::: "memory");
        } else {
            XB_SPIN(xb_ld(&bar[XB_XGEN(b.x)]) == gen, bar);
            __builtin_amdgcn_fence(__ATOMIC_ACQUIRE, "agent");
            asm volatile("s_waitcnt vmcnt(0)" ::: "memory");
        }
    }
    __syncthreads();
}
struct Args { const float* in[18]; float* out; unsigned char* ws; };

__device__ __forceinline__ void p0_prologue(const Args& A, unsigned char* ws, LAS unsigned char* lds, int tid, int lane, int wave, int bx, int G) {
    LAS float* scr = (LAS float*)(lds + wave * 16384);
    const int gw = bx * NWAVES + wave, NGW = G * NWAVES;
    const float* w_in = A.in[2];
    bf16* WinT = (bf16*)(ws + WS_WIN); bf16* WoutT = (bf16*)(ws + WS_WOUT); bf16* WupT = (bf16*)(ws + WS_WUP); bf16* WdnT = (bf16*)(ws + WS_WDN); bf16* WpgT = (bf16*)(ws + WS_WPG); bf16* WpleT = (bf16*)(ws + WS_WPLE);
    constexpr int I_SEG = 16 * 16, I_IN = 7 * I_SEG, I_OUT = 16 * 32, I_UP = 16 * 128, I_DN = 64 * 32, I_PG = 16 * 32, I_PLE = 4 * 32;
    constexpr int NITEMS = I_IN + I_OUT + I_UP + I_DN + I_PG + I_PLE;
    for (int it = gw; it < NITEMS; it += NGW) {
        int r = it;
        if (r < I_IN) { const int s = r / I_SEG; const int srcc = (s == 0) ? 0 : (s == 1) ? 512 : (s == 2) ? 1024 : (s == 3) ? 1544 : (s == 4) ? 2056 : (s == 5) ? 2568 : 3088;
            p0_transpose_item(w_in + srcc, WIN_LD, 512, DM, WinT, 512 * s, A.in[7]  , scr, r % I_SEG, lane); continue; } r -= I_IN;
        if (r < I_OUT) { p0_transpose_item(A.in[10], DM, DM, DM, WoutT, 0, nullptr, scr, r, lane); continue; } r -= I_OUT;
        if (r < I_UP) { p0_transpose_item(A.in[12], FF, FF, DM, WupT, 0, A.in[11], scr, r, lane); continue; } r -= I_UP;
        if (r < I_DN) { p0_transpose_item(A.in[13], DM, DM, FF, WdnT, 0, nullptr, scr, r, lane); continue; } r -= I_DN;
        if (r < I_PG) { p0_transpose_item(A.in[16], DM, DM, DM, WpgT, 0, A.in[15], scr, r, lane); continue; } r -= I_PG;
        p0_transpose_item(A.in[14], DM, DM, PLE, WpleT, 0, nullptr, scr, r, lane);
    }
    const int gt = bx * NTHR + tid, NGT = G * NTHR;
    for (int i = gt; i < 16 * DM; i += NGT) { const int j = i >> 10, k = i & 1023; WinT[(size_t)(3584 + j) * DM + k] = (bf16)f2bf(w_in[(size_t)k * WIN_LD + gate_src_col(j)] * A.in[7][k]); }
    for (int i = gt; i < 240 * DM / 8; i += NGT) ((v4u*)(WinT + (size_t)3600 * DM))[i] = (v4u){0u, 0u, 0u, 0u};
    { const f32x4* p4 = (const f32x4*)A.in[1]; v4u* pb = (v4u*)(ws + WS_PB);
#pragma unroll 4
      for (int i = gt; i < M * PLE / 8; i += NGT) { const f32x4 a = p4[2 * i], b = p4[2 * i + 1]; pb[i] = (v4u){pk2(a[0], a[1]), pk2(a[2], a[3]), pk2(b[0], b[1]), pk2(b[2], b[3])}; } }
    { const float* x = A.in[0]; bf16* XN = (bf16*)(ws + WS_XN);
#pragma unroll 2
      for (int m = gw; m < M; m += NGW) {
          const f32x4* xr = (const f32x4*)(x + (size_t)m * DM) + lane; f32x4 v[4]; float s = 0.f;
#pragma unroll
          for (int j = 0; j < 4; ++j) { v[j] = xr[64 * j]; s += (v[j][0] * v[j][0] + v[j][1] * v[j][1]) + (v[j][2] * v[j][2] + v[j][3] * v[j][3]); }
          const float ms_ = wave_sum(s, lane) * (1.f / DM) + EPS; const float rstd = 1.0f / sqrtf(ms_);
          if (lane == 0) ((float*)(ws + WS_RSI))[m] = sqrtf(ms_);
          v2u* o8 = (v2u*)(XN + (size_t)m * DM) + lane;
#pragma unroll
          for (int j = 0; j < 4; ++j) { const f32x4 y = v[j] * rstd; o8[64 * j] = (v2u){pk2(y[0], y[1]), pk2(y[2], y[3])}; }
      } }
}

__device__ __forceinline__ void conv_silu_phase(const float* w_conv, const bf16* MQ, const bf16* MK, bf16* QC, bf16* KC, int gt, int NGT) {
    for (int it = gt; it < 2 * (M / 32) * 64; it += NGT) {
        const int cgi = it & 63, rb = (it >> 6) & (M / 32 - 1), ten = it >> 17;
        const bf16* src = (ten ? MK : MQ) + cgi * 8; bf16* dst = (ten ? KC : QC) + cgi * 8;
        const float osc = ten ? 0.08838834764831845f : 1.0f;
        float w[4][8];
#pragma unroll
        for (int j = 0; j < 4; ++j) { const f32x4 a = *(const f32x4*)(w_conv + j * 1024 + ten * 512 + cgi * 8), b = *(const f32x4*)(w_conv + j * 1024 + ten * 512 + cgi * 8 + 4);
            w[j][0] = a[0]; w[j][1] = a[1]; w[j][2] = a[2]; w[j][3] = a[3]; w[j][4] = b[0]; w[j][5] = b[1]; w[j][6] = b[2]; w[j][7] = b[3]; }
        const int t0 = rb * 32; const bool first = (t0 % SEQ) == 0;
        float h0[8], h1[8], h2[8];
#pragma unroll
        for (int i = 0; i < 8; ++i) { h0[i] = 0.f; h1[i] = 0.f; h2[i] = 0.f; }
        if (!first) {
            const v4u a = *(const v4u*)(src + (size_t)(t0 - 3) * 512), b = *(const v4u*)(src + (size_t)(t0 - 2) * 512), c = *(const v4u*)(src + (size_t)(t0 - 1) * 512);
#pragma unroll
            for (int i = 0; i < 4; ++i) { h0[2 * i] = bflo(a[i]); h0[2 * i + 1] = bfhi(a[i]); h1[2 * i] = bflo(b[i]); h1[2 * i + 1] = bfhi(b[i]); h2[2 * i] = bflo(c[i]); h2[2 * i + 1] = bfhi(c[i]); }
        }
#pragma unroll 8
        for (int r = 0; r < 32; ++r) {
            const v4u cu = *(const v4u*)(src + (size_t)(t0 + r) * 512); float c[8], o[8];
#pragma unroll
            for (int i = 0; i < 4; ++i) { c[2 * i] = bflo(cu[i]); c[2 * i + 1] = bfhi(cu[i]); }
#pragma unroll
            for (int i = 0; i < 8; ++i) { const float y = w[0][i] * h0[i] + w[1][i] * h1[i] + w[2][i] * h2[i] + w[3][i] * c[i];
                o[i] = osc * xsig(y, y); h0[i] = h1[i]; h1[i] = h2[i]; h2[i] = c[i]; }
            *(v4u*)(dst + (size_t)(t0 + r) * 512) = (v4u){pk2(o[0], o[1]), pk2(o[2], o[3]), pk2(o[4], o[5]), pk2(o[6], o[7])};
        }
    }
}

__device__ __forceinline__ void fox_cumsum(LAS float* CB, LAS float* red, const float* Gt, float bias, int b, int h, int tid, int lane, int wave) {
    float v[8]; const float* base = Gt + ((size_t)b * SEQ + tid * 8) * 16 + h;
#pragma unroll
    for (int i = 0; i < 8; ++i) { const float z = base[i * 16] + bias; v[i] = (fminf(z, 0.f) - log1pf(expf(-fabsf(z)))) * 1.4426950408889634f; }
#pragma unroll
    for (int i = 1; i < 8; ++i) v[i] += v[i - 1];
    const float tot = v[7]; float sc = tot;
#pragma unroll
    for (int o = 1; o < 64; o <<= 1) { const float n = shu(sc, o, lane); if (lane >= o) sc += n; }
    if (lane == 63) red[wave] = sc;
    __syncthreads();
    float off = sc - tot;
    for (int w = 0; w < wave; ++w) off += red[w];
#pragma unroll
    for (int i = 0; i < 8; ++i) CB[tid * 8 + i] = v[i] + off;
    __syncthreads();
}

__device__ __forceinline__ float fox_row_stats(LAS float* red, LAS float* QN, LAS float* DD, const bf16* FQ, const bf16* FK, int b, int h, int tid, int lane, int wave) {
    float mk = 0.f;
    for (int r = tid; r < SEQ; r += NTHR) { const v4u* qp = (const v4u*)(FQ + ((size_t)b * SEQ + r) * 512 + h * 64); const v4u* kp = (const v4u*)(FK + ((size_t)b * SEQ + r) * 512 + h * 64); float sq = 0.f, sk = 0.f, dd = 0.f;
#pragma unroll
        for (int j = 0; j < 8; ++j) { const v4u a = qp[j], c = kp[j];
#pragma unroll
            for (int i = 0; i < 4; ++i) { const float q0 = bflo(a[i]), q1 = bfhi(a[i]), k0 = bflo(c[i]), k1 = bfhi(c[i]); sq += q0 * q0 + q1 * q1; sk += k0 * k0 + k1 * k1; dd += q0 * k0 + q1 * k1; } }
        QN[r] = sqrtf(sq); DD[r] = dd; mk = fmaxf(mk, sk); }
#pragma unroll
    for (int o = 1; o < 64; o <<= 1) mk = fmaxf(mk, shx(mk, o, lane));
    __syncthreads();
    if (lane == 0) red[wave] = mk;
    __syncthreads();
    float c = 0.f;
    for (int w = 0; w < NWAVES; ++w) c = fmaxf(c, red[w]);
    __syncthreads();
    return sqrtf(c);
}

namespace ml {
typedef short bf16x8 __attribute__((ext_vector_type(8)));
typedef short v4i16_t __attribute__((ext_vector_type(4)));
constexpr int PK = 288, PC = 288, NEB = 9, NITEMS = BATCH * 4;
constexpr int L_K = 0, L_V = 36864, L_CT = 73728, L_U = L_CT + 144 * PC, L_MT = L_U + 512, L_BT = L_MT + 512, L_WK = L_BT + 512, L_G = L_WK + 512, L_END = L_G + 512;
static_assert(L_END <= 131072, "mLSTM LDS map");
__device__ __forceinline__ float logsig(float z) { return fminf(z, 0.f) - log1pf(__expf(-fabsf(z))); }
__device__ __forceinline__ bf16x8 cat8(v2u lo, v2u hi) { const v4u w = (v4u){lo.x, lo.y, hi.x, hi.y}; return __builtin_bit_cast(bf16x8, w); }
__device__ __forceinline__ v2u vtr(LAS unsigned char* p) { return __builtin_bit_cast(v2u, __builtin_amdgcn_ds_read_tr16_b64_v4i16((LAS v4i16_t*)p)); }
#define ML_MFMA(a, b, c) __builtin_amdgcn_mfma_f32_16x16x32_bf16((a), (b), (c), 0, 0, 0)
__device__ __forceinline__ void mlstm_item(int item, const bf16* QC, const bf16* KC, const bf16* MV, const bf16* MO, const float* Gt, const float* b_i, const float* b_f, const float* gout, bf16* MIX, LAS unsigned char* L, int tid, int lane, int wave) {
    const int hd = item & 3, b = item >> 2;
    const int hcol = hd * 128;
    const float bi = b_i[hd], bff = b_f[hd];
    const int j16 = lane & 15, kq = lane >> 4, q4 = j16 >> 2, p4 = j16 & 3;
    const int tb = (wave < 4) ? wave : 11 - wave, t = 16 * tb + j16, gmax = tb >> 1;
    unsigned rowb = (unsigned)(j16 * PK + kq * 16), trb = (unsigned)((4 * kq + q4) * PK + p4 * 8), trk = trb + 32u * (unsigned)wave, ub4 = (unsigned)(kq * 16),
             cwb = (unsigned)(4 * kq * PC + (16 * wave + j16) * 2), stb = (unsigned)((tid >> 4) * PK + (tid & 15) * 16), ulb = (unsigned)(8 * lane), tlb = (unsigned)(4 * t);
    asm volatile("" : "+v"(rowb), "+v"(trb), "+v"(trk), "+v"(ub4), "+v"(cwb), "+v"(stb), "+v"(ulb), "+v"(tlb));
    __syncthreads();
    for (int i = tid; i < 144 * PC / 4; i += NTHR) ((LAS unsigned*)(L + L_CT))[i] = 0u;
    for (int i = tid; i < 128 * 8; i += NTHR) ((LAS unsigned*)(L + L_V + (i >> 3) * PK + 256))[i & 7] = ((i & 7) == 0) ? 0x00003F80u : 0u;
    if (tid < 128) *(LAS float*)(L + L_G + 4 * tid) = gout[hcol + tid];
    f32x4 Cacc[NEB];
#pragma unroll
    for (int eb = 0; eb < NEB; ++eb) Cacc[eb] = (f32x4){0.f, 0.f, 0.f, 0.f};
    float m_prev = 0.f;
    v4u kreg[4], vreg[4]; bf16x8 qreg[4]; float gi0, gi1, gf0, gf1, hi0, hi1, hf0, hf1;
#define ML_GATES(cc, a0, a1, c0, c1) do { const float* g0_ = Gt + ((size_t)b * SEQ + (size_t)(cc) * 128 + 2 * lane) * 16; a0 = g0_[8 + hd]; a1 = g0_[24 + hd]; c0 = g0_[12 + hd]; c1 = g0_[28 + hd]; } while (0)
#define ML_LOAD(cc) do { const size_t r0_ = (size_t)b * SEQ + (size_t)(cc) * 128; \
        _Pragma("unroll") for (int j = 0; j < 4; ++j) { const int id = tid + NTHR * j, r = id >> 4, c16 = id & 15; kreg[j] = *(const v4u*)(KC + (r0_ + r) * 512 + hcol + c16 * 8); vreg[j] = *(const v4u*)(MV + (r0_ + r) * 512 + hcol + c16 * 8); } \
        _Pragma("unroll") for (int ks = 0; ks < 4; ++ks) qreg[ks] = *(const bf16x8*)(QC + (r0_ + t) * 512 + hcol + 32 * ks + 8 * kq); } while (0)
    ML_GATES(0, gi0, gi1, gf0, gf1); ML_GATES(1, hi0, hi1, hf0, hf1);
    ML_LOAD(0);
    float u0, u1, M0, M1, b0, b1, Mlast, bL;
#define ML_SCALARS(mp) do { const float i0_ = gi0 + bi, i1_ = gi1 + bi; const float f0_ = logsig(gf0 + bff), f1_ = logsig(gf1 + bff); \
        b0 = f0_; b1 = f0_ + f1_; \
        { float sc = b1; _Pragma("unroll") for (int o = 1; o < 64; o <<= 1) { const float n = shu(sc, o, lane); if (lane >= o) sc += n; } const float off = sc - b1; b0 += off; b1 += off; } \
        u0 = i0_ - b0; u1 = i1_ - b1; \
        float c0_ = u0, c1_ = fmaxf(u0, u1); \
        { float pm = c1_; _Pragma("unroll") for (int o = 1; o < 64; o <<= 1) { const float n = shu(pm, o, lane); if (lane >= o) pm = fmaxf(pm, n); } \
          float prev = shu(pm, 1, lane); if (lane == 0) prev = -INFINITY; c0_ = fmaxf(c0_, prev); c1_ = fmaxf(c1_, prev); } \
        M0 = fmaxf((mp), c0_); M1 = fmaxf((mp), c1_); Mlast = shl(M1, 63); bL = shl(b1, 63); } while (0)
    ML_SCALARS(m_prev);
    gi0 = hi0; gi1 = hi1; gf0 = hf0; gf1 = hf1;
    for (int c = 0; c < SEQ / 128; ++c) {
        const size_t row0 = (size_t)b * SEQ + (size_t)c * 128;
        if (wave == 0) { *(LAS f32x2*)(L + L_U + ulb) = (f32x2){u0, u1}; *(LAS f32x2*)(L + L_MT + ulb) = (f32x2){M0, M1}; *(LAS f32x2*)(L + L_BT + ulb) = (f32x2){b0, b1};
                         *(LAS f32x2*)(L + L_WK + ulb) = (f32x2){__expf(u0 - Mlast), __expf(u1 - Mlast)}; }
        const float Mlast_c = Mlast, m_next = bL + Mlast;
#pragma unroll
        for (int j = 0; j < 4; ++j) { *(LAS v4u*)(L + L_K + stb + 32 * j * PK) = kreg[j]; *(LAS v4u*)(L + L_V + stb + 32 * j * PK) = vreg[j]; }
        bf16x8 qf[4]; v2u mo[8];
#pragma unroll
        for (int ks = 0; ks < 4; ++ks) qf[ks] = qreg[ks];
        __syncthreads();
        if (c + 1 < SEQ / 128) ML_LOAD(c + 1);
        { const int c2 = (c + 2 < SEQ / 128) ? c + 2 : SEQ / 128 - 1; ML_GATES(c2, hi0, hi1, hf0, hf1); }
        ML_SCALARS(m_next);
        gi0 = hi0; gi1 = hi1; gf0 = hf0; gf1 = hf1;
#pragma unroll
        for (int eb = 0; eb < 8; ++eb) mo[eb] = *(const v2u*)(MO + (row0 + t) * 512 + hcol + 16 * eb + 4 * kq);
        const float Mt = *(const LAS float*)(L + L_MT + tlb), bt = *(const LAS float*)(L + L_BT + tlb);
        const float winter = __expf(m_prev - Mt), thr = __expf(-(bt + Mt));
        f32x4 acc[NEB];
#pragma unroll
        for (int eb = 0; eb < NEB; ++eb) { f32x4 a4 = (f32x4){0.f, 0.f, 0.f, 0.f};
#pragma unroll
            for (int ks = 0; ks < 4; ++ks) { const bf16x8 a = *(const LAS bf16x8*)(L + L_CT + rowb + (16 * eb * PC + 64 * ks)); a4 = ML_MFMA(a, qf[ks], a4); }
            acc[eb] = a4 * winter; }
        { const float decay = __expf(m_prev - Mlast_c);
#pragma unroll
          for (int eb = 0; eb < NEB; ++eb) Cacc[eb] = Cacc[eb] * decay; }
#pragma unroll
        for (int g = 0; g < 4; ++g) {
            bf16x8 pf; const bool live = (g <= gmax);
            if (live) {
                f32x4 s0 = (f32x4){0.f, 0.f, 0.f, 0.f}, s1 = s0;
#pragma unroll
                for (int ks = 0; ks < 4; ++ks) { const bf16x8 a0 = *(const LAS bf16x8*)(L + L_K + rowb + (32 * g * PK + 64 * ks)), a1 = *(const LAS bf16x8*)(L + L_K + rowb + ((32 * g + 16) * PK + 64 * ks));
                    s0 = ML_MFMA(a0, qf[ks], s0); s1 = ML_MFMA(a1, qf[ks], s1); }
                const f32x4 ua = *(const LAS f32x4*)(L + L_U + ub4 + 128 * g), ub = *(const LAS f32x4*)(L + L_U + ub4 + 128 * g + 64);
                float p[8];
#pragma unroll
                for (int i = 0; i < 4; ++i) { const int sa = 32 * g + 4 * kq + i;
                    p[i] = (sa <= t) ? s0[i] * __expf(ua[i] - Mt) : 0.f; p[4 + i] = (sa + 16 <= t) ? s1[i] * __expf(ub[i] - Mt) : 0.f; }
                const v4u pw = (v4u){pk2(p[0], p[1]), pk2(p[2], p[3]), pk2(p[4], p[5]), pk2(p[6], p[7])};
                pf = __builtin_bit_cast(bf16x8, pw);
            }
            bf16x8 bfr;
            { LAS unsigned char* kp = L + L_K + trk + 32 * g * PK;
              const v2u klo = vtr(kp), khi = vtr(kp + 16 * PK);
              const f32x4 wa = *(const LAS f32x4*)(L + L_WK + ub4 + 128 * g), wb = *(const LAS f32x4*)(L + L_WK + ub4 + 128 * g + 64);
              const v4u kw = (v4u){pk2(bflo(klo.x) * wa[0], bfhi(klo.x) * wa[1]), pk2(bflo(klo.y) * wa[2], bfhi(klo.y) * wa[3]), pk2(bflo(khi.x) * wb[0], bfhi(khi.x) * wb[1]), pk2(bflo(khi.y) * wb[2], bfhi(khi.y) * wb[3])};
              bfr = __builtin_bit_cast(bf16x8, kw); }
#pragma unroll
            for (int e0 = 0; e0 < NEB; e0 += 3) {
                bf16x8 af[3];
#pragma unroll
                for (int k = 0; k < 3; ++k) { LAS unsigned char* vp = L + L_V + trb + (32 * g * PK + 32 * (e0 + k)); af[k] = cat8(vtr(vp), vtr(vp + 16 * PK)); }
                if (live) {
#pragma unroll
                    for (int k = 0; k < 3; ++k) acc[e0 + k] = ML_MFMA(af[k], pf, acc[e0 + k]); }
#pragma unroll
                for (int k = 0; k < 3; ++k) Cacc[e0 + k] = ML_MFMA(af[k], bfr, Cacc[e0 + k]);
            }
        }
        { const float den = shl(acc[8][0], j16); const float inv = __builtin_amdgcn_rcpf(fmaxf(fabsf(den), thr));
          float ss = 0.f;
#pragma unroll
          for (int eb = 0; eb < 8; ++eb) { acc[eb] = acc[eb] * inv; ss += (acc[eb][0] * acc[eb][0] + acc[eb][1] * acc[eb][1]) + (acc[eb][2] * acc[eb][2] + acc[eb][3] * acc[eb][3]); }
          ss += shx(ss, 16, lane); ss += shx(ss, 32, lane);
          const float rs = __builtin_amdgcn_rsqf(ss * (1.f / 128.f) + EPS);
          bf16* op = MIX + (row0 + t) * 1024 + 512 + hcol + 4 * kq;
#pragma unroll
          for (int eb = 0; eb < 8; ++eb) { const f32x4 h = acc[eb] * rs * *(const LAS f32x4*)(L + L_G + ub4 + 64 * eb); const v2u m2 = mo[eb];
              const float o0 = xsig(h[0], bflo(m2.x)), o1 = xsig(h[1], bfhi(m2.x)), o2 = xsig(h[2], bflo(m2.y)), o3 = xsig(h[3], bfhi(m2.y));
              *(v2u*)(op + 16 * eb) = (v2u){pk2(o0, o1), pk2(o2, o3)}; } }
        __syncthreads();
#pragma unroll
        for (int eb = 0; eb < NEB; ++eb) { const unsigned w01 = pk2(Cacc[eb][0], Cacc[eb][1]), w23 = pk2(Cacc[eb][2], Cacc[eb][3]);
            *(LAS unsigned short*)(L + L_CT + cwb + (16 * eb + 0) * PC) = (unsigned short)(w01 & 0xffffu); *(LAS unsigned short*)(L + L_CT + cwb + (16 * eb + 1) * PC) = (unsigned short)(w01 >> 16);
            *(LAS unsigned short*)(L + L_CT + cwb + (16 * eb + 2) * PC) = (unsigned short)(w23 & 0xffffu); *(LAS unsigned short*)(L + L_CT + cwb + (16 * eb + 3) * PC) = (unsigned short)(w23 >> 16); }
        m_prev = m_next;
    }
}
#undef ML_MFMA
#undef ML_LOAD
#undef ML_GATES
#undef ML_SCALARS
}
__device__ __forceinline__ void panel_rstd(int row0, int nrows, const float* SSP, float* RSTD, int tid) {
    for (int rr = tid; rr < nrows; rr += NTHR) { const int row = row0 + rr; const f32x4* p = (const f32x4*)(SSP + (size_t)row * 16); const f32x4 a = p[0], b = p[1], c = p[2], d = p[3];
        const float s = (((a[0] + a[1]) + (a[2] + a[3])) + ((b[0] + b[1]) + (b[2] + b[3]))) + (((c[0] + c[1]) + (c[2] + c[3])) + ((d[0] + d[1]) + (d[2] + d[3])));
        RSTD[row] = 1.0f / sqrtf(s * (1.f / DM) + EPS); }
}
__device__ __forceinline__ void panel_final_norm(int pm, const bf16* XB, int xpitch, const float* RSTD, const float* g, float* out, int lane, int wave) {
    const f32x4* g4 = (const f32x4*)g;
#pragma unroll 4
    for (int i = wave; i < 256; i += NWAVES) { const int row = pm * 256 + i; const float rs = RSTD[row];
#pragma unroll
        for (int j = 0; j < 2; ++j) { const v4u w = *((const v4u*)(XB + (size_t)row * xpitch) + lane + 64 * j); const f32x4 ga = g4[2 * (lane + 64 * j)], gb = g4[2 * (lane + 64 * j) + 1];
            f32x4* o = (f32x4*)(out + (size_t)row * DM) + 2 * (lane + 64 * j);
            o[0] = (f32x4){bflo(w.x) * rs * ga[0], bfhi(w.x) * rs * ga[1], bflo(w.y) * rs * ga[2], bfhi(w.y) * rs * ga[3]};
            o[1] = (f32x4){bflo(w.z) * rs * gb[0], bfhi(w.z) * rs * gb[1], bflo(w.w) * rs * gb[2], bfhi(w.w) * rs * gb[3]}; } }
}

__device__ __forceinline__ void group_barrier(unsigned* cnt, unsigned want, bool t0) {
    asm volatile("s_waitcnt vmcnt(0) lgkmcnt(0)" ::: "memory");
    __syncthreads();
    if (t0) {
        __builtin_amdgcn_fence(__ATOMIC_RELEASE, "agent");
        asm volatile("s_waitcnt vmcnt(0)" ::: "memory");
        __hip_atomic_fetch_add(cnt, 1u, __ATOMIC_RELAXED, __HIP_MEMORY_SCOPE_AGENT);
        unsigned sp = 0;
        while (__hip_atomic_load(cnt, __ATOMIC_RELAXED, __HIP_MEMORY_SCOPE_AGENT) < want) { __builtin_amdgcn_s_sleep(1); if (++sp > (1u << 24)) break; }
        __builtin_amdgcn_fence(__ATOMIC_ACQUIRE, "agent");
        asm volatile("s_waitcnt vmcnt(0)" ::: "memory");
    }
    __syncthreads();
    __builtin_amdgcn_fence(__ATOMIC_ACQUIRE, "agent");
    asm volatile("s_waitcnt vmcnt(0)" ::: "memory");
}
#if defined(PROBE_DUP) && PROBE_DUP == 3
#define PROBE_ML_REP 2
#else
#define PROBE_ML_REP 1
#endif
typedef const __attribute__((address_space(4))) Args* ArgsP;
__global__ void __launch_bounds__(NTHR, 2) hymba_fwd(Args args_unused) {
    extern __shared__ __attribute__((aligned(16))) unsigned char lds[];
    cg::grid_group grid = cg::this_grid();
    LAS unsigned char* L = (LAS unsigned char*)lds;
    const int wave0 = __builtin_amdgcn_readfirstlane((int)threadIdx.x >> 6);
    const int G = gridDim.x, bx = blockIdx.x;
#define ARGP() ArgsP ap = (ArgsP)__builtin_amdgcn_kernarg_segment_ptr(); asm volatile("" : "+s"(ap)); unsigned char* ws = ap->ws; (void)ws
#define FRESH_TID() int tid_; asm volatile("v_mbcnt_lo_u32_b32 %0, -1, 0\n\tv_mbcnt_hi_u32_b32 %0, -1, %0" : "=v"(tid_)); tid_ += wave0 * 64; asm volatile("" : "+v"(tid_));     const int tid = tid_, lane = tid & 63, wave = __builtin_amdgcn_readfirstlane(tid >> 6); (void)lane; (void)wave
    constexpr size_t ZS = (size_t)M * 512;
#ifdef PROBE_A
    volatile LAS unsigned long long* TS = (volatile LAS unsigned long long*)(L + 140000);
#define STAMP(k) do { if (bx == 0 && wave0 == 0) TS[k] = __builtin_amdgcn_s_memrealtime(); } while (0)
#else
#define STAMP(k) do {} while (0)
#endif
    STAMP(0);
    volatile LAS unsigned* xst = (volatile LAS unsigned*)(L + RING_BYTES + 64);
    if (wave0 == 0) { xst[0] = 0u; xst[1] = 0u; }
    __syncthreads();
    { ARGP(); FRESH_TID(); const XcdBarrier xb0 = xcd_barrier_make((unsigned*)(ws + WS_CTL), xst); xcd_barrier_post(xb0, tid == 0); }
#define SEAM() do { ARGP(); FRESH_TID(); const XcdBarrier xb_ = xcd_barrier_make((unsigned*)(ws + WS_CTL), xst); xcd_barrier(xb_, tid == 0); } while (0)

    { ARGP(); FRESH_TID(); Args a;
#pragma unroll
      for (int i = 0; i < 18; ++i) a.in[i] = ap->in[i];
      a.out = ap->out; a.ws = ws;
      p0_prologue(a, ws, L, tid, lane, wave, bx, G);
#if defined(PROBE_DUP) && (PROBE_DUP == 4 || PROBE_DUP == 6)
      block_seam(); p0_prologue(a, ws, L, tid, lane, wave, bx, G);
#endif
    }
    grid.sync();
    STAMP(1);

    {
        ARGP(); FRESH_TID();
        pg8::Gemm g{(const bf16*)(ws + WS_XN), (const bf16*)(ws + WS_WIN), M, NZ, DM}; pg8::StaticOrder S; S.init(M, NZ, G, bx);
        pg8::EpiZ E{(bf16*)(ws + WS_Z), ZS, (bf16*)(ws + WS_MO), (float*)(ws + WS_G), attn_body::C2};
        pg8::gemm_phase<pg8::EpiZ, pg8::StaticOrder, true, true>(L, g, S, E, tid);
#if defined(PROBE_DUP) && PROBE_DUP == 1
        block_seam(); pg8::gemm_phase<pg8::EpiZ, pg8::StaticOrder, true, true>(L, g, S, E, tid);
#endif
    }
    SEAM();
    STAMP(2);

    { ARGP(); FRESH_TID(); bf16* Z = (bf16*)(ws + WS_Z); conv_silu_phase(ap->in[6], Z + 3 * ZS, Z + 4 * ZS, (bf16*)(ws + WS_QC), (bf16*)(ws + WS_KC), bx * NTHR + tid, G * NTHR);
#if defined(PROBE_DUP) && (PROBE_DUP == 5 || PROBE_DUP == 6)
      block_seam(); conv_silu_phase(ap->in[6], Z + 3 * ZS, Z + 4 * ZS, (bf16*)(ws + WS_QC), (bf16*)(ws + WS_KC), bx * NTHR + tid, G * NTHR);
#endif
    }
    STAMP(3);
    {
        const int vcu0 = (G % 8 == 0) ? (bx % 8) * (G / 8) + bx / 8 : bx;
        for (int bh = vcu0; bh < 128; bh += G) { ARGP(); FRESH_TID(); const int b = bh >> 3, h = bh & 7;
            LAS float* CBl = (LAS float*)(L + attn_body::LDS_CB); LAS float* red = (LAS float*)(L + attn_body::LDS_CB + 16384);
            __syncthreads();
            fox_cumsum(CBl, red, (const float*)(ws + WS_G), ap->in[3][h], b, h, tid, lane, wave);
            for (int i = tid; i < SEQ / 4; i += NTHR) ((f32x4*)(ws + WS_CBG) + (size_t)bh * (SEQ / 4))[i] = ((const LAS f32x4*)CBl)[i];
            LAS float* QN = (LAS float*)L; LAS float* DD = (LAS float*)(L + 16384);
            const float kmax = fox_row_stats(red, QN, DD, (const bf16*)(ws + WS_Z), (const bf16*)(ws + WS_Z) + ZS, b, h, tid, lane, wave);
#pragma unroll
            for (int k = 0; k < 2; ++k) { const int qb = wave + 8 * k, NT = 4 * qb + 4; float e = 0.f;
#pragma unroll
                for (int q = 0; q < 4; ++q) { const int i = 256 * qb + 4 * lane + q; e = fmaxf(e, 1.02f * QN[i] * kmax - DD[i]); }
#pragma unroll
                for (int o = 1; o < 64; o <<= 1) e = fmaxf(e, shx(e, o, lane));
                const float thr = 40.f + e, c0 = CBl[256 * qb];
                const bool cond = (lane < NT - 4) && (CBl[64 * lane + 63] - c0 >= thr);
                const int ts = (int)__builtin_popcountll(__ballot(cond)) & ~1;
                if (lane == 0) ((int*)(ws + WS_QKB))[bh * 16 + qb] = ts; } }
    }
    SEAM();
    {
        for (;;) { ARGP(); FRESH_TID();
            unsigned qoff = RING_BYTES + 128; asm volatile("" : "+v"(qoff));
            volatile LAS int* qslot = (volatile LAS int*)(L + qoff);
            __syncthreads();
            if (tid == 0) *qslot = (int)atomicAdd((unsigned*)(ws + WS_CTL) + 4000, 1u);
            __syncthreads();
            const int u0 = __builtin_amdgcn_readfirstlane(*qslot);
            if (u0 >= ml::NITEMS + 2048) break;
            if (u0 < ml::NITEMS) {
                ml::mlstm_item(u0, (const bf16*)(ws + WS_QC), (const bf16*)(ws + WS_KC), (const bf16*)(ws + WS_Z) + 5 * ZS, (const bf16*)(ws + WS_MO), (const float*)(ws + WS_G), ap->in[4], ap->in[5], ap->in[9], (bf16*)(ws + WS_MIX), L, tid, lane, wave);
                continue; }
            const int u = u0 - ml::NITEMS;
            const int qb = 15 - (u >> 7), bh = u & 127, b = bh >> 3, h = bh & 7;
            const int ts = __builtin_amdgcn_readfirstlane(((const int*)(ws + WS_QKB))[bh * 16 + qb]);
            { LAS f32x4* CB4 = (LAS f32x4*)(L + attn_body::LDS_CB); const f32x4* src = (const f32x4*)(ws + WS_CBG) + (size_t)bh * (SEQ / 4);
              for (int i = ts * 16 + tid; i < (qb + 1) * 64; i += NTHR) CB4[i] = src[i]; }
            __syncthreads();
            const bf16* Z = (const bf16*)(ws + WS_Z);
            attn_body::attn_unit<20>(b, h, qb, (const attn_body::bf16*)Z, (const attn_body::bf16*)(Z + ZS), (const attn_body::bf16*)(Z + 2 * ZS), (attn_body::bf16*)(ws + WS_MIX), ap->in[8], (char*)lds, tid, ts); }
    }
    SEAM();
    STAMP(5);

    if (G == M / 256) {
        const int vcu = (bx % 8) * (G / 8) + bx / 8, grp = vcu >> 2, mj = vcu & 3, pm0 = 4 * grp, pmine = pm0 + mj;
        unsigned gbk = 0;
#define GROUP_BAR() do { ARGP(); FRESH_TID(); gbk += 4u; group_barrier((unsigned*)(ws + WS_CTL) + 4096 + 64 * grp, gbk, tid == 0); } while (0)
        { ARGP(); FRESH_TID(); pg8::Gemm g{(const bf16*)(ws + WS_MIX), (const bf16*)(ws + WS_WOUT), M, DM, DM}; pg8::GroupOrder S{pm0, mj, 1};
          pg8::EpiResB<0> E{nullptr, (const bf16*)(ws + WS_XN), (bf16*)(ws + WS_XN), nullptr, (const float*)(ws + WS_RSI), (float*)(ws + WS_SSP)};
          pg8::gemm_phase<pg8::EpiResB<0>, pg8::GroupOrder, true, true>(L, g, S, E, tid); }
        GROUP_BAR();
        { ARGP(); FRESH_TID(); panel_rstd(pm0 * 256, 1024, (const float*)(ws + WS_SSP), (float*)(ws + WS_RSTD), tid); }
        block_seam();
        { ARGP(); FRESH_TID(); pg8::Gemm g{(const bf16*)(ws + WS_XN), (const bf16*)(ws + WS_WUP), M, FF, DM}; pg8::GroupOrder S{pm0, mj, 4}; pg8::EpiUp E{(bf16*)(ws + WS_H), (const float*)(ws + WS_RSTD)};
          pg8::gemm_phase<pg8::EpiUp, pg8::GroupOrder, true, true>(L, g, S, E, tid); }
        GROUP_BAR();
        { ARGP(); FRESH_TID(); pg8::Gemm g{(const bf16*)(ws + WS_H), (const bf16*)(ws + WS_WDN), M, DM, FF}; pg8::GroupOrder S{pm0, mj, 1};
          pg8::EpiResB<1> E{nullptr, (const bf16*)(ws + WS_XN), (bf16*)(ws + WS_XN), nullptr, nullptr, (float*)(ws + WS_SSP2)};
          pg8::gemm_phase<pg8::EpiResB<1>, pg8::GroupOrder, true, true>(L, g, S, E, tid); }
        GROUP_BAR();
        { ARGP(); FRESH_TID(); panel_rstd(pm0 * 256, 1024, (const float*)(ws + WS_SSP2), (float*)(ws + WS_RSTD), tid); }
        { ARGP(); FRESH_TID(); pg8::Gemm g{(const bf16*)(ws + WS_PB), (const bf16*)(ws + WS_WPLE), M, DM, PLE}; pg8::GroupOrder S{pm0, mj, 1}; pg8::EpiPlain E{(bf16*)ap->out, 2 * DM};
          pg8::gemm_phase<pg8::EpiPlain, pg8::GroupOrder, true, true>(L, g, S, E, tid); }
        block_seam();
        { ARGP(); FRESH_TID();
          pg8::Gemm g{(const bf16*)(ws + WS_XN), (const bf16*)(ws + WS_WPG), M, DM, DM}; pg8::GroupOrder S{pm0, mj, 1};
          pg8::EpiResB<2> E{nullptr, (const bf16*)(ws + WS_XN), (bf16*)(ws + WS_H), (const bf16*)ap->out, (const float*)(ws + WS_RSTD), (float*)(ws + WS_SSP3)};
          pg8::gemm_phase<pg8::EpiResB<2>, pg8::GroupOrder, true, true>(L, g, S, E, tid); }
        GROUP_BAR();
        { ARGP(); FRESH_TID(); panel_rstd(pmine * 256, 256, (const float*)(ws + WS_SSP3), (float*)(ws + WS_RSTD), tid); }
        block_seam();
        { ARGP(); FRESH_TID(); panel_final_norm(pmine, (const bf16*)(ws + WS_H), FF, (const float*)(ws + WS_RSTD), ap->in[17], ap->out, lane, wave); }
#undef GROUP_BAR
    }
}

extern "C" void kernel_launch(void* const* d_in, const int* in_sizes, int n_in, void* d_out, int out_size, void* d_ws, size_t ws_size, hipStream_t stream) {
    static int grid = 0;
    if (grid == 0) {
        if (n_in != 18 || in_sizes[0] != M * DM || out_size != M * DM || ws_size < WS_END) { fprintf(stderr, "kernel_launch: unexpected shapes (n_in %d, in0 %d, out %d, ws %zu)\n", n_in, n_in > 0 ? in_sizes[0] : -1, out_size, ws_size); grid = -1; return; }
        int dev = 0, cus = 0, per_cu = 0;
        if (hipGetDevice(&dev) != hipSuccess || hipDeviceGetAttribute(&cus, hipDeviceAttributeMultiprocessorCount, dev) != hipSuccess) { grid = -1; return; }
        if (hipFuncSetAttribute((const void*)hymba_fwd, hipFuncAttributeMaxDynamicSharedMemorySize, LDS_TOTAL) != hipSuccess) { fprintf(stderr, "kernel_launch: hipFuncSetAttribute failed\n"); grid = -1; return; }
        if (hipOccupancyMaxActiveBlocksPerMultiprocessor(&per_cu, (const void*)hymba_fwd, NTHR, LDS_TOTAL) != hipSuccess || per_cu < 1) { fprintf(stderr, "kernel_launch: occupancy query says %d\n", per_cu); per_cu = 1; }
        (void)hipGetLastError();
        grid = cus * per_cu;
        if (grid > 256) grid = 256;
    }
    if (grid < 0) return;
    if (hipMemsetAsync((char*)d_ws + WS_CTL, 0, CTL_BYTES, stream) != hipSuccess) { fprintf(stderr, "kernel_launch: memset of the barrier words failed\n"); return; }
    Args a{};
    for (int i = 0; i < 18; ++i) a.in[i] = (const float*)d_in[i];
    a.out = (float*)d_out; a.ws = (unsigned char*)d_ws;
    void* params[] = {&a};
    hipError_t e = hipLaunchCooperativeKernel((const void*)hymba_fwd, dim3(grid), dim3(NTHR), params, LDS_TOTAL, stream);
    if (e != hipSuccess) fprintf(stderr, "kernel_launch: cooperative launch failed: %s (grid %d)\n", hipGetErrorString(e), grid);
}
```

```cpp
#include <hip/hip_runtime.h>
#include <cstdio>
#include <cstdint>
namespace pg8 {
#define PG8_LAS __attribute__((address_space(3)))
typedef unsigned short bf16_t;
typedef short bf16x8 __attribute__((ext_vector_type(8)));
typedef float f32x4 __attribute__((ext_vector_type(4)));
typedef unsigned u32x4 __attribute__((ext_vector_type(4)));
constexpr int BM = 256, BK = 64, HALF = 128, HTB = HALF * BK * 2  , STAGE_BYTES = 8 * HTB, NXCD = 8, WGM = 8;

__host__ __device__ __forceinline__ int lds_byte(int r, int c) { const int st = (r >> 4) * 2 + (c >> 5), rr = r & 15, cc = c & 31, ob = rr * 64 + cc * 2; return st * 1024 + (ob ^ (((ob >> 9) & 1) << 5)); }
__host__ __device__ __forceinline__ void stage_rc(int b, int& R, int& C) { const int st = b / 1024, sb = b % 1024, swz = sb ^ (((sb >> 9) & 1) << 5); R = (st >> 1) * 16 + swz / 64; C = (st & 1) * 32 + (swz % 64) / 2; }
__host__ __device__ __forceinline__ int perm32(int rho) { const int n = rho >> 4, i = rho & 15; return 8 * (i >> 2) + 4 * n + (i & 3); }

struct Unit { int pm, pn; };
struct Gemm { const bf16_t* A; const bf16_t* Bt; int M, N, K; };

struct StaticOrder {
    int nM, nN, nwg, G, c;
    __host__ __device__ void init(int M, int N, int G_, int c_) { nM = M / BM; nN = N / BM; nwg = nM * nN; G = G_; c = c_; }
    __host__ __device__ bool next(int i, Unit& u) const {
        const long L = (long)i * G + c; if (L >= nwg) return false;
        int wgid = (int)L; { const int q = nwg / NXCD, r = nwg % NXCD, xcd = wgid % NXCD, off = wgid / NXCD; wgid = (xcd < r ? xcd * (q + 1) : r * (q + 1) + (xcd - r) * q) + off; }
        const int nig = WGM * nN, gid = wgid / nig, fm = gid * WGM, gsz = (nM - fm) < WGM ? (nM - fm) : WGM;
        u.pm = fm + ((wgid % nig) % gsz); u.pn = (wgid % nig) / gsz; return true;
    }
    __device__ __forceinline__ void a_ready(const Unit&) const {}
    __device__ __forceinline__ void done(const Unit&) const {}
};

__device__ __forceinline__ unsigned cvt_pk_bf16(float lo, float hi) { unsigned r; asm volatile("v_cvt_pk_bf16_f32 %0, %1, %2" : "=v"(r) : "v"(lo), "v"(hi)); return r; }
typedef float f32x2 __attribute__((ext_vector_type(2)));
typedef unsigned u32x2 __attribute__((ext_vector_type(2)));
__device__ __forceinline__ float bf_lo(unsigned w) { return __uint_as_float(w << 16); }
__device__ __forceinline__ float bf_hi(unsigned w) { return __uint_as_float(w & 0xffff0000u); }
struct EpiZ {
    static constexpr bool PERM = true, AFTER_DRAIN = false;
    bf16_t* Z; size_t zstride; bf16_t* MO; float* G; float scale0;
    __device__ __forceinline__ void operator()(const f32x4 (&acc)[2][2][4][2], const Unit& u, int wr, int wc, int fr, int fq) const {
        asm volatile("" : "+v"(fr), "+v"(fq));
        const int row0 = u.pm * BM + wr * 64 + fr; const int t = u.pn >> 1;
        if (t < 7) {
            bf16_t* base = (t < 6) ? Z + (size_t)t * zstride : MO;
            const float sc = (t == 0) ? scale0 : 1.f;
            const int col0 = (u.pn & 1) * BM + wc * 32 + 8 * fq;
#pragma unroll
            for (int ai = 0; ai < 2; ++ai)
#pragma unroll
                for (int m = 0; m < 4; ++m) { bf16_t* rowp = base + (size_t)(row0 + ai * HALF + m * 16) * 512 + col0;
#pragma unroll
                    for (int bj = 0; bj < 2; ++bj) { const f32x4 v0 = acc[ai][bj][m][0] * sc, v1 = acc[ai][bj][m][1] * sc;
                        u32x4 w; w.x = cvt_pk_bf16(v0[0], v0[1]); w.y = cvt_pk_bf16(v0[2], v0[3]); w.z = cvt_pk_bf16(v1[0], v1[1]); w.w = cvt_pk_bf16(v1[2], v1[3]);
                        *(u32x4*)(rowp + bj * HALF) = w; } }
        } else if (wc == 0 && fq < 2) {
#pragma unroll
            for (int ai = 0; ai < 2; ++ai)
#pragma unroll
                for (int m = 0; m < 4; ++m) { float* gp = G + (size_t)(row0 + ai * HALF + m * 16) * 16 + 8 * fq;
                    *(f32x4*)gp = acc[ai][0][m][0]; *(f32x4*)(gp + 4) = acc[ai][0][m][1]; }
        }
    }
};
template <int MODE> struct EpiResB {
    static constexpr bool PERM = true, AFTER_DRAIN = false;
    const float* basef; const bf16_t* xb; bf16_t* xo; const bf16_t* pl; const float* rstd; float* ssp;
    __device__ __forceinline__ void operator()(const f32x4 (&acc)[2][2][4][2], const Unit& u, int wr, int wc, int fr, int fq) const {
        asm volatile("" : "+v"(fr), "+v"(fq));
        const int lane = fq * 16 + fr, r0 = u.pm * BM + wr * 64 + fr;
        const size_t off0 = (size_t)r0 * 1024 + u.pn * BM + wc * 32 + 8 * fq;
        u32x4 xbv[2][2], plv[2][2]; float rb[2];
#define ER_LD(slot, it) do { const int rr_ = ((it) >> 2) * HALF + ((it) & 3) * 16; const size_t o_ = off0 + (size_t)rr_ * 1024; if (MODE != 1) rb[slot] = rstd[r0 + rr_]; \
        _Pragma("unroll") for (int bj = 0; bj < 2; ++bj) { \
            xbv[slot][bj] = *(const u32x4*)(xb + o_ + bj * HALF); \
            if (MODE == 2) plv[slot][bj] = *(const u32x4*)(pl + o_ + (size_t)(r0 + rr_) * 1024 + bj * HALF); } } while (0)
        ER_LD(0, 0);
#pragma unroll
        for (int it = 0; it < 8; ++it) {
            if (it + 1 < 8) ER_LD((it + 1) & 1, it + 1);
            const int ai = it >> 2, m = it & 3, rr = ai * HALF + m * 16; const size_t off = off0 + (size_t)rr * 1024; float s = 0.f;
#pragma unroll
            for (int bj = 0; bj < 2; ++bj) { float o[8];
                const f32x4 a0 = acc[ai][bj][m][0], a1 = acc[ai][bj][m][1];
                { const u32x4 xw = xbv[it & 1][bj];
                    const float x[8] = {bf_lo(xw.x), bf_hi(xw.x), bf_lo(xw.y), bf_hi(xw.y), bf_lo(xw.z), bf_hi(xw.z), bf_lo(xw.w), bf_hi(xw.w)};
                    if (MODE == 0) { const float rsi_ = rb[it & 1];
#pragma unroll
                        for (int i = 0; i < 4; ++i) { o[i] = x[i] * rsi_ + a0[i]; o[4 + i] = x[4 + i] * rsi_ + a1[i]; } }
                    else if (MODE == 1) {
#pragma unroll
                        for (int i = 0; i < 4; ++i) { o[i] = x[i] + a0[i]; o[4 + i] = x[4 + i] + a1[i]; } }
                    else { const u32x4 pw = plv[it & 1][bj]; const float rs = rb[it & 1];
                        const float p[8] = {bf_lo(pw.x), bf_hi(pw.x), bf_lo(pw.y), bf_hi(pw.y), bf_lo(pw.z), bf_hi(pw.z), bf_lo(pw.w), bf_hi(pw.w)};
#pragma unroll
                        for (int i = 0; i < 4; ++i) { o[i] = x[i] + p[i] * __builtin_amdgcn_rcpf(1.f + __expf(-a0[i] * rs)); o[4 + i] = x[4 + i] + p[4 + i] * __builtin_amdgcn_rcpf(1.f + __expf(-a1[i] * rs)); } } }
#pragma unroll
                for (int i = 0; i < 8; ++i) s += o[i] * o[i];
                u32x4 w; w.x = cvt_pk_bf16(o[0], o[1]); w.y = cvt_pk_bf16(o[2], o[3]); w.z = cvt_pk_bf16(o[4], o[5]); w.w = cvt_pk_bf16(o[6], o[7]);
                *(u32x4*)(xo + off + (MODE == 2 ? (size_t)(r0 + rr) * 3072 : (size_t)0) + bj * HALF) = w; }
            s += __int_as_float(__builtin_amdgcn_ds_bpermute((lane ^ 16) << 2, __float_as_int(s)));
            s += __int_as_float(__builtin_amdgcn_ds_bpermute((lane ^ 32) << 2, __float_as_int(s)));
            if (fq == 0) ssp[(size_t)(r0 + rr) * 16 + u.pn * 4 + wc] = s;
            asm volatile("" ::: "memory");
        }
#undef ER_LD
    }
};
struct EpiUp {
    static constexpr bool PERM = true, AFTER_DRAIN = false;
    bf16_t* H; const float* rstd;
    __device__ __forceinline__ void operator()(const f32x4 (&acc)[2][2][4][2], const Unit& u, int wr, int wc, int fr, int fq) const {
        asm volatile("" : "+v"(fr), "+v"(fq));
        const int row0 = u.pm * BM + wr * 64 + fr, col0 = u.pn * BM + wc * 32 + 8 * fq;
        float rsv[2][4];
#pragma unroll
        for (int ai = 0; ai < 2; ++ai)
#pragma unroll
            for (int m = 0; m < 4; ++m) rsv[ai][m] = rstd[row0 + ai * HALF + m * 16];
#pragma unroll
        for (int ai = 0; ai < 2; ++ai)
#pragma unroll
            for (int m = 0; m < 4; ++m) { const int r = row0 + ai * HALF + m * 16; const float rs = rsv[ai][m]; bf16_t* rowp = H + (size_t)r * 4096 + col0;
#pragma unroll
                for (int bj = 0; bj < 2; ++bj) { f32x4 v0 = acc[ai][bj][m][0] * rs, v1 = acc[ai][bj][m][1] * rs;
#pragma unroll
                    for (int i = 0; i < 4; ++i) { const float a = fmaxf(v0[i], 0.f), b = fmaxf(v1[i], 0.f); v0[i] = a * a; v1[i] = b * b; }
                    u32x4 w; w.x = cvt_pk_bf16(v0[0], v0[1]); w.y = cvt_pk_bf16(v0[2], v0[3]); w.z = cvt_pk_bf16(v1[0], v1[1]); w.w = cvt_pk_bf16(v1[2], v1[3]);
                    *(u32x4*)(rowp + bj * HALF) = w; } }
    }
};
struct EpiPlain {
    static constexpr bool PERM = true, AFTER_DRAIN = false;
    bf16_t* O; int ldc;
    __device__ __forceinline__ void operator()(const f32x4 (&acc)[2][2][4][2], const Unit& u, int wr, int wc, int fr, int fq) const {
        asm volatile("" : "+v"(fr), "+v"(fq));
        const int row0 = u.pm * BM + wr * 64 + fr, col0 = u.pn * BM + wc * 32 + 8 * fq;
#pragma unroll
        for (int ai = 0; ai < 2; ++ai)
#pragma unroll
            for (int m = 0; m < 4; ++m) { bf16_t* rowp = O + (size_t)(row0 + ai * HALF + m * 16) * ldc + col0;
#pragma unroll
                for (int bj = 0; bj < 2; ++bj) { const f32x4 v0 = acc[ai][bj][m][0], v1 = acc[ai][bj][m][1];
                    u32x4 w; w.x = cvt_pk_bf16(v0[0], v0[1]); w.y = cvt_pk_bf16(v0[2], v0[3]); w.z = cvt_pk_bf16(v1[0], v1[1]); w.w = cvt_pk_bf16(v1[2], v1[3]);
                    *(u32x4*)(rowp + bj * HALF) = w; } }
    }
};
struct RowOrder {
    int pm, nN;
    __device__ __forceinline__ bool next(int i, Unit& u) const { if (i >= nN) return false; u.pm = pm; u.pn = i; return true; }
    __device__ __forceinline__ void a_ready(const Unit&) const {}
    __device__ __forceinline__ void done(const Unit&) const {}
};
struct GroupOrder {
    int pm0, j, ncj;
    __device__ __forceinline__ bool next(int i, Unit& u) const { if (i >= 4 * ncj) return false; u.pm = pm0 + (i & 3); u.pn = j + 4 * (i >> 2); return true; }
    __device__ __forceinline__ void a_ready(const Unit&) const {}
    __device__ __forceinline__ void done(const Unit&) const {}
};
template <class Epi, class Sched, bool ALIGN_EPI = false, bool SP2 = false>
__device__ __forceinline__ void gemm_phase(PG8_LAS unsigned char* lds, const Gemm g, const Sched& S, const Epi& E, int tid_) {
    asm volatile("" : "+v"(tid_));
    const int tid = tid_, wid = __builtin_amdgcn_readfirstlane(tid >> 6), lane = tid & 63, wr = wid >> 2, wc = wid & 3, fr = lane & 15, fq = lane >> 4;
    const int K = g.K, nt = K / BK;
    unsigned voffA[2], voffB[2];
#pragma unroll
    for (int i = 0; i < 2; ++i) { int R, C; stage_rc(tid * 16 + i * 8192, R, C); const int Rb = Epi::PERM ? ((R & ~31) + perm32(R & 31)) : R;
        voffA[i] = (unsigned)(R * K + C) * 2u; voffB[i] = (unsigned)(Rb * K + C) * 2u; }
    const size_t kstep = (size_t)(BK * 2);
    const size_t hstep = (size_t)HALF * K * 2;
    const size_t tstep = 2 * hstep;
    const unsigned ldsw = (unsigned)wid * 1024u;
    const int aoff = lds_byte(wr * 64 + fr, fq * 8), boff = lds_byte(wc * 32 + fr, fq * 8);
#define PG8_SA(b, h) (((b) * 2 + (h)) * HTB)
#define PG8_SB(b, h) ((4 + (b) * 2 + (h)) * HTB)
#define PG8_STAGE(bufoff, gbase, voff) do { _Pragma("unroll") for (int _i = 0; _i < 2; ++_i) \
        __builtin_amdgcn_global_load_lds((const unsigned*)((const char*)(gbase) + (voff)[_i]), (PG8_LAS unsigned*)(lds + (bufoff) + ldsw + _i * 8192), 16, 0, 0); } while (0)
#define PG8_LDA(dst, b, h) do { _Pragma("unroll") for (int m = 0; m < 4; ++m) _Pragma("unroll") for (int k = 0; k < 2; ++k) dst[m][k] = *(const PG8_LAS bf16x8*)(lds + PG8_SA(b, h) + aoff + m * 2048 + k * 1024); } while (0)
#define PG8_LDB(dst, b, h) do { _Pragma("unroll") for (int n = 0; n < 2; ++n) _Pragma("unroll") for (int k = 0; k < 2; ++k) dst[n][k] = *(const PG8_LAS bf16x8*)(lds + PG8_SB(b, h) + boff + n * 2048 + k * 1024); } while (0)
#define PG8_MMA(ai, bj, At, Bt) do { __builtin_amdgcn_s_setprio(1); _Pragma("unroll") for (int m = 0; m < 4; ++m) _Pragma("unroll") for (int n = 0; n < 2; ++n) _Pragma("unroll") for (int k = 0; k < 2; ++k) \
        acc[ai][bj][m][n] = __builtin_amdgcn_mfma_f32_16x16x32_bf16(Bt[n][k], At[m][k], acc[ai][bj][m][n], 0, 0, 0); __builtin_amdgcn_s_setprio(0); } while (0)
#define PG8_WAIT_V(n) asm volatile("s_waitcnt vmcnt(" #n ")" ::: "memory")
#define PG8_WAIT_L(n) asm volatile("s_waitcnt lgkmcnt(" #n ")" ::: "memory")
#define PG8_BAR __builtin_amdgcn_s_barrier()
#define PG8_SCHED __builtin_amdgcn_sched_barrier(0)
    Unit cur, nxt; int ui = 0;
    if (!S.next(0, cur)) return;
    f32x4 acc[2][2][4][2];
#pragma unroll
    for (int a = 0; a < 2; ++a)
#pragma unroll
        for (int b = 0; b < 2; ++b)
#pragma unroll
            for (int m = 0; m < 4; ++m)
#pragma unroll
                for (int n = 0; n < 2; ++n) acc[a][b][m][n] = (f32x4){0.f, 0.f, 0.f, 0.f};
    bf16x8 At[4][2], B0[2][2], B1[2][2];
    const char* cA = (const char*)g.A + (size_t)cur.pm * tstep; const char* cB = (const char*)g.Bt + (size_t)cur.pn * tstep;
    S.a_ready(cur);
    if constexpr (SP2) {
        PG8_STAGE(PG8_SB(0, 0), cB, voffB); PG8_STAGE(PG8_SB(0, 1), cB + hstep, voffB); PG8_STAGE(PG8_SA(0, 0), cA, voffA); PG8_STAGE(PG8_SA(0, 1), cA + hstep, voffA);
        if (wr == 1) PG8_BAR;
        PG8_WAIT_V(2); PG8_BAR;
        PG8_STAGE(PG8_SB(1, 0), cB + kstep, voffB); PG8_STAGE(PG8_SA(1, 0), cA + kstep, voffA); PG8_STAGE(PG8_SB(1, 1), cB + hstep + kstep, voffB);
        PG8_WAIT_V(6); PG8_BAR;
    } else {
        PG8_STAGE(PG8_SB(0, 0), cB, voffB); PG8_STAGE(PG8_SA(0, 0), cA, voffA); PG8_STAGE(PG8_SB(0, 1), cB + hstep, voffB); PG8_STAGE(PG8_SA(0, 1), cA + hstep, voffA);
        if (wr == 1) PG8_BAR;
        PG8_WAIT_V(4); PG8_BAR;
        PG8_STAGE(PG8_SB(1, 0), cB + kstep, voffB); PG8_STAGE(PG8_SA(1, 0), cA + kstep, voffA); PG8_STAGE(PG8_SB(1, 1), cB + hstep + kstep, voffB);
        PG8_WAIT_V(6); PG8_BAR;
    }
    for (;;) {
        const bool has_next = S.next(ui + 1, nxt);
        const char* nA = has_next ? (const char*)g.A + (size_t)nxt.pm * tstep : cA; const char* nB = has_next ? (const char*)g.Bt + (size_t)nxt.pn * tstep : cB;
        for (int t = 0; t < nt; t += 2) {
            const bool last = (t == nt - 2);
            const char* a1 = cA + (size_t)(t + 1) * kstep;
            const char* a2 = last ? nA : cA + (size_t)(t + 2) * kstep; const char* b2 = last ? nB : cB + (size_t)(t + 2) * kstep;
            const char* a3 = a2 + kstep; const char* b3 = b2 + kstep;
            asm volatile("" : "+s"(a1), "+s"(a2), "+s"(b2), "+s"(a3), "+s"(b3));
            if (last && has_next) S.a_ready(nxt);
            if constexpr (SP2) {
            PG8_LDB(B0, 0, 0); PG8_LDB(B1, 0, 1); PG8_SCHED; PG8_LDA(At, 0, 0); PG8_STAGE(PG8_SA(1, 1), a1 + hstep, voffA);
            PG8_WAIT_V(8); PG8_WAIT_L(0); PG8_BAR; PG8_MMA(0, 0, At, B0); PG8_MMA(0, 1, At, B1); PG8_BAR; PG8_SCHED;
            PG8_LDA(At, 0, 1); PG8_STAGE(PG8_SB(0, 0), b2, voffB); PG8_STAGE(PG8_SB(0, 1), b2 + hstep, voffB); PG8_STAGE(PG8_SA(0, 0), a2, voffA);
            PG8_WAIT_V(8); PG8_WAIT_L(0); PG8_BAR; PG8_MMA(1, 0, At, B0); PG8_MMA(1, 1, At, B1); PG8_BAR; PG8_SCHED;
            PG8_LDB(B0, 1, 0); PG8_LDB(B1, 1, 1); PG8_SCHED; PG8_LDA(At, 1, 0); PG8_STAGE(PG8_SA(0, 1), a2 + hstep, voffA);
            PG8_WAIT_V(8); PG8_WAIT_L(0); PG8_BAR; PG8_MMA(0, 0, At, B0); PG8_MMA(0, 1, At, B1); PG8_BAR; PG8_SCHED;
            PG8_LDA(At, 1, 1); PG8_STAGE(PG8_SB(1, 0), b3, voffB); PG8_STAGE(PG8_SB(1, 1), b3 + hstep, voffB); PG8_STAGE(PG8_SA(1, 0), a3, voffA);
            PG8_WAIT_V(8); PG8_WAIT_L(0); PG8_BAR; PG8_MMA(1, 0, At, B0); PG8_MMA(1, 1, At, B1); PG8_BAR; PG8_SCHED;
            } else {
            PG8_LDB(B0, 0, 0); PG8_SCHED; PG8_LDA(At, 0, 0); PG8_STAGE(PG8_SA(1, 1), a1 + hstep, voffA);
            PG8_WAIT_L(8); PG8_BAR; PG8_WAIT_L(0); PG8_MMA(0, 0, At, B0); PG8_BAR; PG8_SCHED;
            PG8_LDB(B1, 0, 1); PG8_STAGE(PG8_SB(0, 0), b2, voffB);
            PG8_BAR; PG8_WAIT_L(0); PG8_MMA(0, 1, At, B1); PG8_BAR;
            PG8_LDA(At, 0, 1); PG8_STAGE(PG8_SA(0, 0), a2, voffA);
            PG8_BAR; PG8_WAIT_L(0); PG8_MMA(1, 0, At, B0); PG8_BAR; PG8_SCHED;
            PG8_STAGE(PG8_SB(0, 1), b2 + hstep, voffB);
            PG8_WAIT_V(6); PG8_BAR; PG8_MMA(1, 1, At, B1); PG8_BAR;
            PG8_LDB(B0, 1, 0); PG8_SCHED; PG8_LDA(At, 1, 0); PG8_STAGE(PG8_SA(0, 1), a2 + hstep, voffA);
            PG8_WAIT_L(8); PG8_BAR; PG8_WAIT_L(0); PG8_MMA(0, 0, At, B0); PG8_BAR; PG8_SCHED;
            PG8_LDB(B1, 1, 1); PG8_STAGE(PG8_SB(1, 0), b3, voffB);
            PG8_BAR; PG8_WAIT_L(0); PG8_MMA(0, 1, At, B1); PG8_BAR;
            PG8_LDA(At, 1, 1); PG8_STAGE(PG8_SA(1, 0), a3, voffA);
            PG8_BAR; PG8_WAIT_L(0); PG8_MMA(1, 0, At, B0); PG8_BAR; PG8_SCHED;
            PG8_STAGE(PG8_SB(1, 1), b3 + hstep, voffB);
            PG8_WAIT_V(6); PG8_BAR; PG8_MMA(1, 1, At, B1); PG8_BAR;
            }
        }
        if constexpr (ALIGN_EPI) { if (wr == 0) PG8_BAR; }
        if constexpr (!Epi::AFTER_DRAIN) { E(acc, cur, wr, wc, fr, fq); S.done(cur); }
        if (!has_next) break;
#pragma unroll
        for (int a = 0; a < 2; ++a)
#pragma unroll
            for (int b = 0; b < 2; ++b)
#pragma unroll
                for (int m = 0; m < 4; ++m)
#pragma unroll
                    for (int n = 0; n < 2; ++n) acc[a][b][m][n] = (f32x4){0.f, 0.f, 0.f, 0.f};
        cur = nxt; cA = nA; cB = nB; ++ui;
        if constexpr (ALIGN_EPI) { if (wr == 1) PG8_BAR; }
    }
    PG8_WAIT_V(0);
    if constexpr (!ALIGN_EPI) { if (wr == 0) PG8_BAR; }
    PG8_BAR;
    if constexpr (Epi::AFTER_DRAIN) { E.fused(acc, cur, wr, wc, fr, fq, lds, wid, lane); S.done(cur); }
#undef PG8_SA
#undef PG8_SB
#undef PG8_STAGE
#undef PG8_LDA
#undef PG8_LDB
#undef PG8_MMA
#undef PG8_WAIT_V
#undef PG8_WAIT_L
#undef PG8_BAR
#undef PG8_SCHED
}
}
#include <hip/hip_bf16.h>
#include <cmath>
namespace attn_body {
using bf16=__hip_bfloat16;
using bf16x8=__attribute__((ext_vector_type(8)))short;
using s16x4=__attribute__((ext_vector_type(4)))short;
using f32x16=__attribute__((ext_vector_type(16)))float;
using u32x4=__attribute__((ext_vector_type(4)))unsigned;
using f32x4v=__attribute__((ext_vector_type(4)))float;
constexpr int BATCH=16,NHEAD=8,SEQ=4096,D=64,DM=NHEAD*D,OPITCH=1024;
constexpr int NW=8,QBLK=32,QB=QBLK*NW,KVBLK=64,NQB=SEQ/QB;
constexpr int ATTN_PITCH=DM, ATTN_UNIT_ROWS=QB;
__device__ __forceinline__ int crow(int r,int hi){return (r&3)+8*(r>>2)+4*hi;}
#define SBAR() __builtin_amdgcn_sched_barrier(0)
__device__ __forceinline__ void cmask(f32x16&p0,f32x16&p1,int jb,int qrel,int hi){
  const float NEG=-INFINITY; int kb=64*jb+4*hi;
  #pragma unroll
  for(int r=0;r<16;++r){int kv=kb+(r&3)+8*(r>>2); if(kv>qrel)p0[r]=NEG; if(kv+32>qrel)p1[r]=NEG;}
}

constexpr int NSLOT=3, SLOTB=8192;
constexpr int LDS_K=0, LDS_V=NSLOT*SLOTB, LDS_WS=2*NSLOT*SLOTB, LDS_OST=LDS_WS+NW*64*4, LDS_BYTES=LDS_OST+NW*4096;
constexpr int LDS_CB=86016;
constexpr float C2=0.125f*1.4426950408889634f;
__device__ __forceinline__ void glds16(const void*gsrc,unsigned lds_dst){unsigned keep;
  asm volatile("s_mov_b32 %0, m0\n\ts_mov_b32 m0, %2\n\ts_nop 0\n\tglobal_load_lds_dwordx4 %1, off\n\ts_mov_b32 m0, %0":"=&s"(keep):"v"(gsrc),"s"(lds_dst):"memory");}
__device__ __forceinline__ float max3f(float a,float b,float c){float r;asm("v_max3_f32 %0, %1, %2, %3":"=v"(r):"v"(a),"v"(b),"v"(c));return r;}
__device__ __forceinline__ float max2f(float a,float b){float r;asm("v_max_f32_e32 %0, %1, %2":"=v"(r):"v"(a),"v"(b));return r;}
__device__ __forceinline__ float fadd_s(float a,float b){float r;asm("v_add_f32_e32 %0, %1, %2":"=v"(r):"v"(a),"v"(b));return r;}
__device__ __forceinline__ float fsub_s(float a,float b){float r;asm("v_sub_f32_e32 %0, %1, %2":"=v"(r):"v"(a),"v"(b));return r;}
typedef float f32x2_t __attribute__((ext_vector_type(2))); typedef __bf16 bf16x2_t __attribute__((ext_vector_type(2)));
__device__ __forceinline__ unsigned cvtpk_s(float lo,float hi){f32x2_t v={lo,hi};bf16x2_t b=__builtin_convertvector(v,bf16x2_t);return __builtin_bit_cast(unsigned,b);}
#define WAIT_BAR(N) asm volatile("s_waitcnt vmcnt(" #N ") lgkmcnt(0)\n\ts_barrier":::"memory")

__device__ __forceinline__ void qkt(f32x16&p0,f32x16&p1,const char*Kslot,const bf16x8*qr,const f32x16&negm,int r32,int hi){
  const char*kb=Kslot+hi*1024+r32*16;
  #pragma unroll
  for(int d0=0;d0<4;++d0){
    const bf16x8 b0=*reinterpret_cast<const bf16x8*>(kb+d0*2048);
    const bf16x8 b1=*reinterpret_cast<const bf16x8*>(kb+d0*2048+512);
    if(d0==0){p0=__builtin_amdgcn_mfma_f32_32x32x16_bf16(b0,qr[0],negm,0,0,0);p1=__builtin_amdgcn_mfma_f32_32x32x16_bf16(b1,qr[0],negm,0,0,0);}
    else{p0=__builtin_amdgcn_mfma_f32_32x32x16_bf16(b0,qr[d0],p0,0,0,0);p1=__builtin_amdgcn_mfma_f32_32x32x16_bf16(b1,qr[d0],p1,0,0,0);}}
}
typedef __attribute__((address_space(3))) const char* lds_cptr;
typedef short v4i16_t __attribute__((ext_vector_type(4)));
__device__ __forceinline__ void kload8(bf16x8*kf,lds_cptr kp){
  kf[0]=*(const __attribute__((address_space(3))) bf16x8*)(kp);      kf[1]=*(const __attribute__((address_space(3))) bf16x8*)(kp+512);
  kf[2]=*(const __attribute__((address_space(3))) bf16x8*)(kp+2048); kf[3]=*(const __attribute__((address_space(3))) bf16x8*)(kp+2560);
  kf[4]=*(const __attribute__((address_space(3))) bf16x8*)(kp+4096); kf[5]=*(const __attribute__((address_space(3))) bf16x8*)(kp+4608);
  kf[6]=*(const __attribute__((address_space(3))) bf16x8*)(kp+6144); kf[7]=*(const __attribute__((address_space(3))) bf16x8*)(kp+6656);
}
__device__ __forceinline__ void kload2(bf16x8*kf,lds_cptr kp,int j){ kf[2*j]=*(const __attribute__((address_space(3))) bf16x8*)(kp+j*2048); kf[2*j+1]=*(const __attribute__((address_space(3))) bf16x8*)(kp+j*2048+512); }
__device__ __forceinline__ s16x4 vtr(lds_cptr p){ return __builtin_bit_cast(s16x4,__builtin_amdgcn_ds_read_tr16_b64_v4i16((__attribute__((address_space(3))) v4i16_t*)p)); }
__device__ __forceinline__ float rowmax(const f32x16&p0,const f32x16&p1){
  float a=max3f(p0[0],p0[1],p1[0]),b=max3f(p0[2],p0[3],p1[1]);a=max3f(a,p1[2],p1[3]);
  #pragma unroll
  for(int r=4;r<16;r+=4){a=max3f(a,p0[r],p0[r+1]);b=max3f(b,p0[r+2],p0[r+3]);a=max3f(a,p1[r],p1[r+1]);b=max3f(b,p1[r+2],p1[r+3]);}
  const float m=max2f(a,b);
  auto rr=__builtin_amdgcn_permlane32_swap(__float_as_uint(m),__float_as_uint(m),false,false);
  return max2f(__uint_as_float(rr[0]),__uint_as_float(rr[1]));
}
__device__ __forceinline__ void pv(f32x16*o,int vb,bf16x8 pa0,bf16x8 pa1,bf16x8 pa2,bf16x8 pa3){
  #pragma unroll
  for(int d0=0;d0<2;++d0){s16x4 lo[4],hi[4];
    #pragma unroll
    for(int ks=0;ks<4;++ks){
      asm volatile("ds_read_b64_tr_b16 %0,%1 offset:%c2":"=&v"(lo[ks]):"v"(vb),"i"(d0*4096+ks*1024):"memory");
      asm volatile("ds_read_b64_tr_b16 %0,%1 offset:%c2":"=&v"(hi[ks]):"v"(vb),"i"(d0*4096+ks*1024+512):"memory");}
    asm volatile("s_waitcnt lgkmcnt(0)":::"memory");SBAR();
    #define PK(k) (bf16x8){lo[k][0],lo[k][1],lo[k][2],lo[k][3],hi[k][0],hi[k][1],hi[k][2],hi[k][3]}
    o[d0]=__builtin_amdgcn_mfma_f32_32x32x16_bf16(pa0,PK(0),o[d0],0,0,0);
    o[d0]=__builtin_amdgcn_mfma_f32_32x32x16_bf16(pa1,PK(1),o[d0],0,0,0);
    o[d0]=__builtin_amdgcn_mfma_f32_32x32x16_bf16(pa2,PK(2),o[d0],0,0,0);
    o[d0]=__builtin_amdgcn_mfma_f32_32x32x16_bf16(pa3,PK(3),o[d0],0,0,0);
    #undef PK
  }
}

#ifndef ATTN_STORE16
#define ATTN_STORE16(p,v) (*(u32x4*)(p)=(v))
#endif
template<int THRL> __device__ __forceinline__ void attn_unit(int b,int h,int qb,const bf16*Q,const bf16*__restrict__ K,const bf16*__restrict__ V,bf16*O,const float*gfox,char*shm,int tid_,int ts_){
  asm volatile("":"+v"(tid_)); const int tid=tid_,lane=tid&63,r32=lane&31,hi=lane>>5; const int wid=__builtin_amdgcn_readfirstlane(tid>>6);
  const long rowbase=(long)b*SEQ; const int q0=qb*QB;
  const bf16*Qw=Q+(rowbase+q0+wid*QBLK)*DM+h*D;
  const bf16*Kh=K+(rowbase+(long)ts_*KVBLK)*DM+h*D,*Vh=V+(rowbase+(long)ts_*KVBLK)*DM+h*D;
  const unsigned lds0=(unsigned)(uintptr_t)shm;
  float*wsf=(float*)(shm+LDS_WS)+wid*64;
  const bf16*ksrc=Kh+(long)lane*DM+wid*8;
  const bf16*vsrc=Vh+(long)(16*(wid&3)+(lane>>2))*DM+(wid>>2)*32+(lane&3)*8;
  const unsigned kdst=lds0+LDS_K+wid*1024, vdst=lds0+LDS_V+wid*1024;
  #define DMA_K(t,slot) glds16(ksrc+(long)(t)*KVBLK*DM,(unsigned)__builtin_amdgcn_readfirstlane(kdst+(slot)))
  #define DMA_V(t,slot) glds16(vsrc+(long)(t)*KVBLK*DM,(unsigned)__builtin_amdgcn_readfirstlane(vdst+(slot)))
  const int vb0=(int)(lds0+LDS_V)+((lane>>4)&1)*32+(lane&3)*8+(4*hi+((lane&15)>>2))*64;
  const char*Kbase=shm+LDS_K; bf16x8 kf[8];
  const lds_cptr shm3=(lds_cptr)shm; const lds_cptr kp0=shm3+LDS_K+hi*1024+r32*16; const lds_cptr vp0=shm3+LDS_V+((lane>>4)&1)*32+(lane&3)*8+(4*hi+((lane&15)>>2))*64;
  const int NT=(q0+QB)/KVBLK-ts_;
  DMA_K(0,0);DMA_V(0,0);DMA_K(1,SLOTB);
  bf16x8 qr[4];
  #pragma unroll
  for(int d0=0;d0<4;++d0)qr[d0]=*reinterpret_cast<const bf16x8*>(&Qw[(long)r32*DM+d0*16+hi*8]);
  float mhat=0.f,l_reg=0.f;f32x16 o[2]; float zz_=0.f; asm volatile("":"+v"(zz_));
  #pragma unroll
  for(int r=0;r<16;++r){o[0][r]=zz_;o[1][r]=zz_;}
  f32x16 negm;
  #pragma unroll
  for(int r=0;r<16;++r)negm[r]=zz_;
  asm volatile("":"+v"(negm));
  const int qrel=wid*QBLK+r32;
  const __attribute__((address_space(3))) f32x4v* cbq=(const __attribute__((address_space(3))) f32x4v*)((lds_cptr)shm+LDS_CB)+hi+ts_*16;
  #define CINIT(C0,C1,t) do{ const __attribute__((address_space(3))) f32x4v* cb_=cbq+(t)*16; const float nm_=-mhat; \
    _Pragma("unroll") for(int j_=0;j_<4;++j_){ const f32x4v a_=cb_[2*j_], b_=cb_[8+2*j_]; \
      C0[4*j_]=nm_-a_[0]; C0[4*j_+1]=nm_-a_[1]; C0[4*j_+2]=nm_-a_[2]; C0[4*j_+3]=nm_-a_[3]; \
      C1[4*j_]=nm_-b_[0]; C1[4*j_+1]=nm_-b_[1]; C1[4*j_+2]=nm_-b_[2]; C1[4*j_+3]=nm_-b_[3]; } }while(0)
  #define FBIAS(P0,P1,t) do{ const __attribute__((address_space(3))) f32x4v* cb_=cbq+(t)*16; \
    _Pragma("unroll") for(int j_=0;j_<4;++j_){ const f32x4v a_=cb_[2*j_], b_=cb_[8+2*j_]; \
      P0[4*j_]-=a_[0]; P0[4*j_+1]-=a_[1]; P0[4*j_+2]-=a_[2]; P0[4*j_+3]-=a_[3]; \
      P1[4*j_]-=b_[0]; P1[4*j_+1]-=b_[1]; P1[4*j_+2]-=b_[2]; P1[4*j_+3]-=b_[3]; } }while(0)
  #define CMASK(P0,P1,t) do{int jb_=(t)-(NT-4); if(jb_>=0)cmask(P0,P1,jb_,qrel,hi);}while(0)
  bool resc=false;
  #define START(P0,P1) do{ const float rm=rowmax(P0,P1); resc=false; \
    { const float dl=rm; mhat=fadd_s(mhat,dl); \
      _Pragma("unroll") for(int r=0;r<16;++r){P0[r]=fsub_s(P0[r],dl);P1[r]=fsub_s(P1[r],dl);} \
      } \
    _Pragma("unroll") for(int r=0;r<16;++r)P0[r]=__builtin_amdgcn_exp2f(P0[r]); }while(0)
  #define RESC() do{ if(resc){ asm volatile("s_waitcnt lgkmcnt(0)":::"memory"); \
      _Pragma("unroll") for(int d_=0;d_<2;++d_) _Pragma("unroll") for(int r=0;r<16;++r)o[d_][r]*=wsf[crow(r,hi)]; } }while(0)
  f32x16 pA0,pA1,pB0,pB1;
  int sl_prev=0,sl_cur=0,sl_next=SLOTB;
  #define ROT() do{sl_prev=sl_cur;sl_cur=sl_next;sl_next=(sl_next==(NSLOT-1)*SLOTB)?0:sl_next+SLOTB;}while(0)
  DMA_K(2,2*SLOTB);
  WAIT_BAR(3);
  qkt(pA0,pA1,Kbase,qr,negm,r32,hi);asm volatile("s_nop 15\n\ts_nop 7":"+v"(pA0),"+v"(pA1));FBIAS(pA0,pA1,0);CMASK(pA0,pA1,0);
  START(pA0,pA1);
  _Pragma("unroll") for(int r=0;r<16;++r)pA1[r]=__builtin_amdgcn_exp2f(pA1[r]);
  WAIT_BAR(0);
  DMA_K(3,0);DMA_V(1,SLOTB);
  ROT();
  kload8(kf,kp0+sl_cur);
  WAIT_BAR(2);
  s16x4 vlo[8],vhi[8]; u32x4 pw0,pw1,pw2,pw3;
  #define PKW(P,B) cvtpk_s(P[B],P[B+1])
  #define PAF(k) __builtin_bit_cast(bf16x8,pw##k)
  #define VFR(i) (bf16x8){vlo[i][0],vlo[i][1],vlo[i][2],vlo[i][3],vhi[i][0],vhi[i][1],vhi[i][2],vhi[i][3]}
  #define PIN(x) asm volatile("":"+v"(x))
  #define MX3(a,b,c) __builtin_fmaxf(__builtin_fmaxf((a),(b)),(c))
  #define GAPA(MF,A0,A1,A2,A3,W0,W1,PW) do{ MF; sacc+=A0; sacc+=A1; sacc+=A2; sacc+=A3; PIN(sacc); W0; W1; PIN(PW); SBAR(); }while(0)
  #define EX(v) __builtin_amdgcn_exp2f(v)
  #define GAPB(MF,X,B) do{ MF; X[B]=EX(X[B]); X[B+1]=EX(X[B+1]); X[B+2]=EX(X[B+2]); X[B+3]=EX(X[B+3]); PIN(X); SBAR(); }while(0)
  #define VRD(i) do{ vlo[i]=vtr(vp_+(((i)>>2)*4096+((i)&3)*1024)); vhi[i]=vtr(vp_+(((i)>>2)*4096+((i)&3)*1024+512)); }while(0)
  #define KRD(G,j) do{ if(G){ kload2(kf,kp0+sl_next,j); SBAR(); } }while(0)
  #define STEP(C0,C1,P0,P1,t,GK,GV,GL) do{ SBAR(); \
    const lds_cptr vp_=vp0+sl_prev; CINIT(C0,C1,t); SBAR(); \
    VRD(0); SBAR(); float sacc=(P0[0]+P0[1]); \
    GAPA(C0=__builtin_amdgcn_mfma_f32_32x32x16_bf16(kf[0],qr[0],C0,0,0,0), P0[2],P0[3],P0[4],P0[5],     pw0[0]=PKW(P0,0), pw0[1]=PKW(P0,2), pw0); \
    VRD(4); SBAR(); GAPA(C1=__builtin_amdgcn_mfma_f32_32x32x16_bf16(kf[1],qr[0],C1,0,0,0), P0[6],P0[7],P0[8],P0[9],     pw0[2]=PKW(P0,4), pw0[3]=PKW(P0,6), pw0); \
    VRD(1); SBAR(); GAPA(C0=__builtin_amdgcn_mfma_f32_32x32x16_bf16(kf[2],qr[1],C0,0,0,0),   P0[10],P0[11],P0[12],P0[13], pw1[0]=PKW(P0,8), pw1[1]=PKW(P0,10), pw1); \
    VRD(5); SBAR(); GAPA(C1=__builtin_amdgcn_mfma_f32_32x32x16_bf16(kf[3],qr[1],C1,0,0,0),   P0[14],P0[15],P1[0],P1[1],   pw1[2]=PKW(P0,12),pw1[3]=PKW(P0,14), pw1); \
    VRD(2); SBAR(); GAPA(C0=__builtin_amdgcn_mfma_f32_32x32x16_bf16(kf[4],qr[2],C0,0,0,0),   P1[2],P1[3],P1[4],P1[5],     pw2[0]=PKW(P1,0), pw2[1]=PKW(P1,2), pw2); \
    VRD(6); SBAR(); GAPA(C1=__builtin_amdgcn_mfma_f32_32x32x16_bf16(kf[5],qr[2],C1,0,0,0),   P1[6],P1[7],P1[8],P1[9],     pw2[2]=PKW(P1,4), pw2[3]=PKW(P1,6), pw2); \
    VRD(3); SBAR(); GAPA(C0=__builtin_amdgcn_mfma_f32_32x32x16_bf16(kf[6],qr[3],C0,0,0,0),   P1[10],P1[11],P1[12],P1[13], pw3[0]=PKW(P1,8), pw3[1]=PKW(P1,10), pw3); \
    VRD(7); SBAR(); GAPA(C1=__builtin_amdgcn_mfma_f32_32x32x16_bf16(kf[7],qr[3],C1,0,0,0),   P1[14],P1[15],0.f,0.f,       pw3[2]=PKW(P1,12),pw3[3]=PKW(P1,14), pw3); \
    l_reg+=sacc; \
    if(GK){DMA_K((t)+3,sl_cur);} if(GV){DMA_V((t)+1,sl_next);} \
    CMASK(C0,C1,t); \
    { float a=MX3(C0[0],C0[1],C1[0]),b=MX3(C0[2],C0[3],C1[1]); a=MX3(a,C1[2],C1[3]); \
      _Pragma("unroll") for(int r=4;r<16;r+=4){a=MX3(a,C0[r],C0[r+1]);b=MX3(b,C0[r+2],C0[r+3]);a=MX3(a,C1[r],C1[r+1]);b=MX3(b,C1[r+2],C1[r+3]);} \
      float rm=__builtin_fmaxf(a,b); { auto rr=__builtin_amdgcn_permlane32_swap(__float_as_uint(rm),__float_as_uint(rm),false,false); rm=__builtin_fmaxf(__uint_as_float(rr[0]),__uint_as_float(rr[1])); } \
      resc=false; \
      if(__builtin_expect(__any(rm>(float)THRL),0)){ const float dl=__builtin_fmaxf(rm,0.f); mhat+=dl; \
        _Pragma("unroll") for(int r=0;r<16;++r){C0[r]-=dl;C1[r]-=dl;} \
        const float f=__builtin_amdgcn_exp2f(-dl); l_reg*=f; if(hi==0)wsf[r32]=f; resc=true; } } \
    SBAR(); \
    GAPB(o[0]=__builtin_amdgcn_mfma_f32_32x32x16_bf16(PAF(0),VFR(0),o[0],0,0,0), C0,0); \
    GAPB(o[1]=__builtin_amdgcn_mfma_f32_32x32x16_bf16(PAF(0),VFR(4),o[1],0,0,0), C0,4); \
    KRD(GL,0); GAPB(o[0]=__builtin_amdgcn_mfma_f32_32x32x16_bf16(PAF(1),VFR(1),o[0],0,0,0), C0,8); \
    KRD(GL,1); GAPB(o[1]=__builtin_amdgcn_mfma_f32_32x32x16_bf16(PAF(1),VFR(5),o[1],0,0,0), C0,12); \
    KRD(GL,2); GAPB(o[0]=__builtin_amdgcn_mfma_f32_32x32x16_bf16(PAF(2),VFR(2),o[0],0,0,0), C1,0); \
    KRD(GL,3); GAPB(o[1]=__builtin_amdgcn_mfma_f32_32x32x16_bf16(PAF(2),VFR(6),o[1],0,0,0), C1,4); \
    GAPB(o[0]=__builtin_amdgcn_mfma_f32_32x32x16_bf16(PAF(3),VFR(3),o[0],0,0,0), C1,8); \
    GAPB(o[1]=__builtin_amdgcn_mfma_f32_32x32x16_bf16(PAF(3),VFR(7),o[1],0,0,0), C1,12); \
    }while(0)
  int t=1;
  #undef CMASK
  #define CMASK(P0,P1,t) do{}while(0)
  for(;t+5<NT;t+=2){
    STEP(pB0,pB1,pA0,pA1,t,true,true,true);     WAIT_BAR(2); RESC(); ROT();
    STEP(pA0,pA1,pB0,pB1,t+1,true,true,true);   WAIT_BAR(2); RESC(); ROT();
  }
  #undef CMASK
  #define CMASK(P0,P1,t) do{int jb_=(t)-(NT-4); if(jb_>=0)cmask(P0,P1,jb_,qrel,hi);}while(0)
  #define ENDW(tt) do{ if((tt)+3<NT){WAIT_BAR(2);} else if((tt)+2<NT){WAIT_BAR(1);} else {WAIT_BAR(0);} }while(0)
  for(;t+1<NT;t+=2){
    STEP(pB0,pB1,pA0,pA1,t,(t+3<NT),(t+1<NT),(t+1<NT));       ENDW(t);   RESC(); ROT();
    STEP(pA0,pA1,pB0,pB1,t+1,(t+4<NT),(t+2<NT),(t+2<NT));     ENDW(t+1); RESC(); ROT();
  }
  STEP(pB0,pB1,pA0,pA1,NT-1,false,false,false); RESC();
  { float sacc=pB0[0]+pB0[1]; _Pragma("unroll") for(int r=2;r<16;++r)sacc+=pB0[r]; _Pragma("unroll") for(int r=0;r<16;++r)sacc+=pB1[r]; l_reg+=sacc;
    pw0=(u32x4){PKW(pB0,0),PKW(pB0,2),PKW(pB0,4),PKW(pB0,6)};pw1=(u32x4){PKW(pB0,8),PKW(pB0,10),PKW(pB0,12),PKW(pB0,14)};pw2=(u32x4){PKW(pB1,0),PKW(pB1,2),PKW(pB1,4),PKW(pB1,6)};pw3=(u32x4){PKW(pB1,8),PKW(pB1,10),PKW(pB1,12),PKW(pB1,14)};
    SBAR(); pv(o,vb0+sl_cur,PAF(0),PAF(1),PAF(2),PAF(3)); }
  #undef PKW
  #undef PAF
  #undef VFR
  #undef PIN
  #undef MX3
  #undef GAPA
  #undef GAPB
  #undef EX
  #undef VRD
  #undef KRD
  #undef STEP
  #undef ENDW
  {auto rr=__builtin_amdgcn_permlane32_swap(__float_as_uint(l_reg),__float_as_uint(l_reg),false,false);l_reg=__uint_as_float(rr[0])+__uint_as_float(rr[1]);}
  if(hi==0)wsf[32+r32]=l_reg;asm volatile("s_waitcnt lgkmcnt(0)":::"memory");
  float rli[16];
  #pragma unroll
  for(int r=0;r<16;++r)rli[r]=__builtin_amdgcn_rcpf(wsf[32+crow(r,hi)]);
  bf16*Ow=O+(rowbase+q0+wid*QBLK)*OPITCH+h*D;
  { bf16*stg=(bf16*)(shm+LDS_OST)+wid*2048;
    #pragma unroll
    for(int r=0;r<16;++r){const int orow=crow(r,hi);
      #pragma unroll
      for(int d0=0;d0<2;++d0)stg[orow*64+d0*32+r32]=__float2bfloat16(o[d0][r]*rli[r]);}
    asm volatile("s_waitcnt lgkmcnt(0)":::"memory");
    #pragma unroll
    for(int i=0;i<4;++i){const int row=i*8+(lane>>3),ch=lane&7; const u32x4 v=*(const u32x4*)(stg+row*64+ch*8);
      float f[8]; f[0]=__uint_as_float(v.x<<16);f[1]=__uint_as_float(v.x&0xffff0000u);f[2]=__uint_as_float(v.y<<16);f[3]=__uint_as_float(v.y&0xffff0000u);
      f[4]=__uint_as_float(v.z<<16);f[5]=__uint_as_float(v.z&0xffff0000u);f[6]=__uint_as_float(v.w<<16);f[7]=__uint_as_float(v.w&0xffff0000u);
      float ss=0.f;
      #pragma unroll
      for(int j=0;j<8;++j)ss+=f[j]*f[j];
      ss+=__int_as_float(__builtin_amdgcn_ds_bpermute((lane^1)<<2,__float_as_int(ss)));ss+=__int_as_float(__builtin_amdgcn_ds_bpermute((lane^2)<<2,__float_as_int(ss)));ss+=__int_as_float(__builtin_amdgcn_ds_bpermute((lane^4)<<2,__float_as_int(ss)));
      const float rs=1.0f/sqrtf(ss*(1.0f/64.0f)+1e-6f);
      const f32x4v g0=*(const f32x4v*)(gfox+h*D+ch*8),g1=*(const f32x4v*)(gfox+h*D+ch*8+4);
      u32x4 w; w.x=cvtpk_s(f[0]*rs*g0[0],f[1]*rs*g0[1]); w.y=cvtpk_s(f[2]*rs*g0[2],f[3]*rs*g0[3]); w.z=cvtpk_s(f[4]*rs*g1[0],f[5]*rs*g1[1]); w.w=cvtpk_s(f[6]*rs*g1[2],f[7]*rs*g1[3]);
      ATTN_STORE16(Ow+(long)row*OPITCH+ch*8,w);} }
  asm volatile("s_waitcnt lgkmcnt(0)\n\ts_barrier":::"memory");
  #undef DMA_K
  #undef DMA_V
  #undef CMASK
  #undef FBIAS
  #undef CINIT
  #undef START
  #undef RESC
  #undef ROT
}
constexpr int ATTN_LDS_BYTES=LDS_BYTES;
#undef SBAR
#undef WAIT_BAR
}
#include <hip/hip_cooperative_groups.h>
namespace cg = cooperative_groups;
constexpr int NWAVES = 8, NTHR = 512;
constexpr int BATCH = 16, SEQ = 4096, DM = 1024, FF = 4096, M = BATCH * SEQ, PLE = 256, NZ = 3840, WIN_LD = 3600;
constexpr float EPS = 1e-6f;
constexpr size_t MiB = 1u << 20;
constexpr size_t WS_CTL = 0, CTL_BYTES = 65536;
constexpr size_t WS_WIN = 2 * MiB, WS_WOUT = 10 * MiB, WS_WUP = 12 * MiB, WS_WDN = 20 * MiB, WS_WPG = 28 * MiB, WS_WPLE = 30 * MiB;
constexpr size_t WS_XN = 32 * MiB;
constexpr size_t WS_Z = 160 * MiB;
constexpr size_t WS_QC = 544 * MiB, WS_KC = 608 * MiB;
constexpr size_t WS_H = 160 * MiB;
constexpr size_t WS_MO = 672 * MiB, WS_MIX = 736 * MiB, WS_G = 864 * MiB, WS_PB = 868 * MiB, WS_RSTD = 900 * MiB, WS_RSI = 900 * MiB + 512 * 1024, WS_SSP = 901 * MiB, WS_CBG = 906 * MiB, WS_QKB = 908 * MiB, WS_SSP2 = 909 * MiB, WS_SSP3 = 913 * MiB, WS_END = 917 * MiB;
constexpr int RING_BYTES = 131072, LDS_TOTAL = 147456;
#define LAS __attribute__((address_space(3)))
typedef unsigned short bf16;
typedef unsigned v4u __attribute__((ext_vector_type(4)));
typedef unsigned v2u __attribute__((ext_vector_type(2)));
typedef float f32x4 __attribute__((ext_vector_type(4)));
typedef float f32x2 __attribute__((ext_vector_type(2)));
typedef float f32x2_c __attribute__((ext_vector_type(2))); typedef __bf16 bf16x2_c __attribute__((ext_vector_type(2)));
__device__ __forceinline__ unsigned pk2(float lo, float hi) { const f32x2_c v = {lo, hi}; return __builtin_bit_cast(unsigned, __builtin_convertvector(v, bf16x2_c)); }
__device__ __forceinline__ unsigned f2bf(float f) { return pk2(f, 0.f) & 0xffffu; }
__device__ __forceinline__ float bflo(unsigned w) { return __uint_as_float(w << 16); }
__device__ __forceinline__ float bfhi(unsigned w) { return __uint_as_float(w & 0xffff0000u); }
__device__ __forceinline__ float xsig(float x, float y) { return x * __builtin_amdgcn_rcpf(1.f + __expf(-y)); }
__device__ __forceinline__ float shx(float v, int o, int lane) { return __int_as_float(__builtin_amdgcn_ds_bpermute((lane ^ o) << 2, __float_as_int(v))); }
__device__ __forceinline__ float shu(float v, int o, int lane) { return __int_as_float(__builtin_amdgcn_ds_bpermute((lane - o) << 2, __float_as_int(v))); }
__device__ __forceinline__ float shl(float v, int src) { return __int_as_float(__builtin_amdgcn_ds_bpermute(src << 2, __float_as_int(v))); }
__device__ __forceinline__ float wave_sum(float v, int lane) {
#pragma unroll
    for (int o = 1; o < 64; o <<= 1) v += shx(v, o, lane);
    return v;
}
__device__ __forceinline__ void block_seam() {
    asm volatile("s_waitcnt vmcnt(0) lgkmcnt(0)" ::: "memory");
    __syncthreads();
    __builtin_amdgcn_fence(__ATOMIC_ACQUIRE, "agent");
    asm volatile("s_waitcnt vmcnt(0)" ::: "memory");
}
__device__ __forceinline__ void p0_transpose_item(const float* W, int ldw, int ncols, int K, bf16* WT, int row_off, const float* gain, LAS float* scr, int item, int lane) {
    const int nblk = ncols / 32, kb = item / nblk, nb = item % nblk, k0 = 64 * kb, n0 = 32 * nb;
#pragma unroll 16
    for (int i = 0; i < 32; ++i) { const int kk = 2 * i + (lane >> 5); float v = W[(size_t)(k0 + kk) * ldw + n0 + (lane & 31)]; if (gain) v *= gain[k0 + kk]; scr[kk * 33 + (lane & 31)] = v; }
    asm volatile("s_waitcnt lgkmcnt(0)" ::: "memory");
    const int c = lane & 7;
#pragma unroll
    for (int j = 0; j < 4; ++j) { const int n = (lane >> 3) + 8 * j; const LAS float* s = scr + (8 * c) * 33 + n;
        v4u o; o.x = pk2(s[0 * 33], s[1 * 33]); o.y = pk2(s[2 * 33], s[3 * 33]); o.z = pk2(s[4 * 33], s[5 * 33]); o.w = pk2(s[6 * 33], s[7 * 33]);
        *(v4u*)(WT + (size_t)(row_off + n0 + n) * K + k0 + 8 * c) = o; }
    asm volatile("s_waitcnt lgkmcnt(0)" ::: "memory");
}
__device__ __forceinline__ int gate_src_col(int j) { return j < 8 ? 1536 + j : (j < 12 ? 3080 + (j - 8) : 3084 + (j - 12)); }

template <class T> __device__ __forceinline__ T* opq(T* p) { asm volatile("" : "+s"(p)); return p; }
typedef __attribute__((address_space(1))) unsigned gu32;
#define RLX_AGENT __ATOMIC_RELAXED, __HIP_MEMORY_SCOPE_AGENT
#define XB_TMO      128
#define XB_XCNT(j)  (256  + 64 * (j))
#define XB_XSUB(j)  (1280 + 64 * (j))
#define XB_XGEN(j)  (2304 + 64 * (j))
#define XB_TOP      3328
#define XB_TOPGEN   3392
#define XCD_BAR_WORDS 3456
#define XB_SPIN_CAP (1u << 18)

__device__ __forceinline__ unsigned xb_ld(unsigned* p)              { return __hip_atomic_load(p, __ATOMIC_RELAXED, __HIP_MEMORY_SCOPE_AGENT); }
__device__ __forceinline__ unsigned xb_add(unsigned* p, unsigned v) { return __hip_atomic_fetch_add(p, v, __ATOMIC_RELAXED, __HIP_MEMORY_SCOPE_AGENT); }
__device__ __forceinline__ unsigned xb_xcc_id() { return (unsigned)__builtin_amdgcn_s_getreg((3 << 11) | 20) & 0xFu; }
#define XB_SPIN(cond, bar) do { unsigned _sp = 0; while (cond) { __builtin_amdgcn_s_sleep(1); \
    if ((++_sp & 255u) == 0u) { if (xb_ld(&(bar)[XB_TMO])) break; if (_sp > XB_SPIN_CAP) { atomicAdd(&(bar)[XB_TMO], 1u); break; } } } } while (0)

struct XcdBarrier {
    unsigned* bar; unsigned x;
    volatile LAS unsigned* st;
};

__device__ __forceinline__ XcdBarrier xcd_barrier_make(unsigned* bar, volatile LAS unsigned* st) { XcdBarrier b; b.bar = bar; b.x = xb_xcc_id(); b.st = st; return b; }
__device__ __forceinline__ void xcd_barrier_post(const XcdBarrier& b, bool t0) { if (t0) (void)xb_add(&b.bar[XB_XCNT(b.x)], 1u); }
__device__ __forceinline__ void xcd_barrier_complete(unsigned* bar, unsigned x, unsigned& nloc, unsigned& nx) {
    const unsigned G = gridDim.x * gridDim.y * gridDim.z;
    unsigned sum, cnt, mine, sp = 0u;
    for (;;) {
        sum = 0u; cnt = 0u; mine = 0u;
#pragma unroll
        for (unsigned j = 0; j < 16; ++j) { const unsigned c = xb_ld(&bar[XB_XCNT(j)]); sum += c; cnt += (c > 0u) ? 1u : 0u; mine = (j == x) ? c : mine; }
        if (sum == G) break;
        __builtin_amdgcn_s_sleep(1);
        if ((++sp & 255u) == 0u) { if (xb_ld(&bar[XB_TMO])) break; if (sp > XB_SPIN_CAP) { atomicAdd(&bar[XB_TMO], 1u); break; } }
    }
    nloc = mine > 0u ? mine : 1u; nx = cnt > 0u ? cnt : 1u;
}

__device__ __forceinline__ void xcd_barrier(const XcdBarrier& b, bool t0) {
    asm volatile("s_waitcnt vmcnt(0)" ::: "memory");
    __syncthreads();
    if (t0) {
        unsigned* bar = b.bar;
        __builtin_amdgcn_s_waitcnt(0);
        unsigned nloc = b.st[0], nx = b.st[1];
        if (nloc == 0u) { xcd_barrier_complete(bar, b.x, nloc, nx); b.st[0] = nloc; b.st[1] = nx; }
        const unsigned old = xb_add(&bar[XB_XSUB(b.x)], 1u);
        const unsigned gen = old / nloc;
        if (old + 1u == (gen + 1u) * nloc) {
            __builtin_amdgcn_fence(__ATOMIC_RELEASE, "agent");
            asm volatile("s_waitcnt vmcnt(0)" ::: "memory");
            const unsigned og = xb_add(&bar[XB_TOP], 1u);
            const unsigned tg = og / nx;
            if (og + 1u == (tg + 1u) * nx) xb_add(&bar[XB_TOPGEN], 1u);
            else XB_SPIN(xb_ld(&bar[XB_TOPGEN]) == tg, bar);
            __builtin_amdgcn_fence(__ATOMIC_ACQUIRE, "agent");
            xb_add(&bar[XB_XGEN(b.x)], 1u);
            asm volatile("s_waitcnt vmcnt(0)" ::: "memory");
        } else {
            XB_SPIN(xb_ld(&bar[XB_XGEN(b.x)]) == gen, bar);
            __builtin_amdgcn_fence(__ATOMIC_ACQUIRE, "agent");
            asm volatile("s_waitcnt vmcnt(0)" ::: "memory");
        }
    }
    __syncthreads();
}
struct Args { const float* in[18]; float* out; unsigned char* ws; };

__device__ __forceinline__ void p0_prologue(const Args& A, unsigned char* ws, LAS unsigned char* lds, int tid, int lane, int wave, int bx, int G) {
    LAS float* scr = (LAS float*)(lds + wave * 16384);
    const int gw = bx * NWAVES + wave, NGW = G * NWAVES;
    const float* w_in = A.in[2];
    bf16* WinT = (bf16*)(ws + WS_WIN); bf16* WoutT = (bf16*)(ws + WS_WOUT); bf16* WupT = (bf16*)(ws + WS_WUP); bf16* WdnT = (bf16*)(ws + WS_WDN); bf16* WpgT = (bf16*)(ws + WS_WPG); bf16* WpleT = (bf16*)(ws + WS_WPLE);
    constexpr int I_SEG = 16 * 16, I_IN = 7 * I_SEG, I_OUT = 16 * 32, I_UP = 16 * 128, I_DN = 64 * 32, I_PG = 16 * 32, I_PLE = 4 * 32;
    constexpr int NITEMS = I_IN + I_OUT + I_UP + I_DN + I_PG + I_PLE;
    for (int it = gw; it < NITEMS; it += NGW) {
        int r = it;
        if (r < I_IN) { const int s = r / I_SEG; const int srcc = (s == 0) ? 0 : (s == 1) ? 512 : (s == 2) ? 1024 : (s == 3) ? 1544 : (s == 4) ? 2056 : (s == 5) ? 2568 : 3088;
            p0_transpose_item(w_in + srcc, WIN_LD, 512, DM, WinT, 512 * s, A.in[7]  , scr, r % I_SEG, lane); continue; } r -= I_IN;
        if (r < I_OUT) { p0_transpose_item(A.in[10], DM, DM, DM, WoutT, 0, nullptr, scr, r, lane); continue; } r -= I_OUT;
        if (r < I_UP) { p0_transpose_item(A.in[12], FF, FF, DM, WupT, 0, A.in[11], scr, r, lane); continue; } r -= I_UP;
        if (r < I_DN) { p0_transpose_item(A.in[13], DM, DM, FF, WdnT, 0, nullptr, scr, r, lane); continue; } r -= I_DN;
        if (r < I_PG) { p0_transpose_item(A.in[16], DM, DM, DM, WpgT, 0, A.in[15], scr, r, lane); continue; } r -= I_PG;
        p0_transpose_item(A.in[14], DM, DM, PLE, WpleT, 0, nullptr, scr, r, lane);
    }
    const int gt = bx * NTHR + tid, NGT = G * NTHR;
    for (int i = gt; i < 16 * DM; i += NGT) { const int j = i >> 10, k = i & 1023; WinT[(size_t)(3584 + j) * DM + k] = (bf16)f2bf(w_in[(size_t)k * WIN_LD + gate_src_col(j)] * A.in[7][k]); }
    for (int i = gt; i < 240 * DM / 8; i += NGT) ((v4u*)(WinT + (size_t)3600 * DM))[i] = (v4u){0u, 0u, 0u, 0u};
    { const f32x4* p4 = (const f32x4*)A.in[1]; v4u* pb = (v4u*)(ws + WS_PB);
#pragma unroll 4
      for (int i = gt; i < M * PLE / 8; i += NGT) { const f32x4 a = p4[2 * i], b = p4[2 * i + 1]; pb[i] = (v4u){pk2(a[0], a[1]), pk2(a[2], a[3]), pk2(b[0], b[1]), pk2(b[2], b[3])}; } }
    { const float* x = A.in[0]; bf16* XN = (bf16*)(ws + WS_XN);
#pragma unroll 2
      for (int m = gw; m < M; m += NGW) {
          const f32x4* xr = (const f32x4*)(x + (size_t)m * DM) + lane; f32x4 v[4]; float s = 0.f;
#pragma unroll
          for (int j = 0; j < 4; ++j) { v[j] = xr[64 * j]; s += (v[j][0] * v[j][0] + v[j][1] * v[j][1]) + (v[j][2] * v[j][2] + v[j][3] * v[j][3]); }
          const float ms_ = wave_sum(s, lane) * (1.f / DM) + EPS; const float rstd = 1.0f / sqrtf(ms_);
          if (lane == 0) ((float*)(ws + WS_RSI))[m] = sqrtf(ms_);
          v2u* o8 = (v2u*)(XN + (size_t)m * DM) + lane;
#pragma unroll
          for (int j = 0; j < 4; ++j) { const f32x4 y = v[j] * rstd; o8[64 * j] = (v2u){pk2(y[0], y[1]), pk2(y[2], y[3])}; }
      } }
}

__device__ __forceinline__ void conv_silu_phase(const float* w_conv, const bf16* MQ, const bf16* MK, bf16* QC, bf16* KC, int gt, int NGT) {
    for (int it = gt; it < 2 * (M / 32) * 64; it += NGT) {
        const int cgi = it & 63, rb = (it >> 6) & (M / 32 - 1), ten = it >> 17;
        const bf16* src = (ten ? MK : MQ) + cgi * 8; bf16* dst = (ten ? KC : QC) + cgi * 8;
        const float osc = ten ? 0.08838834764831845f : 1.0f;
        float w[4][8];
#pragma unroll
        for (int j = 0; j < 4; ++j) { const f32x4 a = *(const f32x4*)(w_conv + j * 1024 + ten * 512 + cgi * 8), b = *(const f32x4*)(w_conv + j * 1024 + ten * 512 + cgi * 8 + 4);
            w[j][0] = a[0]; w[j][1] = a[1]; w[j][2] = a[2]; w[j][3] = a[3]; w[j][4] = b[0]; w[j][5] = b[1]; w[j][6] = b[2]; w[j][7] = b[3]; }
        const int t0 = rb * 32; const bool first = (t0 % SEQ) == 0;
        float h0[8], h1[8], h2[8];
#pragma unroll
        for (int i = 0; i < 8; ++i) { h0[i] = 0.f; h1[i] = 0.f; h2[i] = 0.f; }
        if (!first) {
            const v4u a = *(const v4u*)(src + (size_t)(t0 - 3) * 512), b = *(const v4u*)(src + (size_t)(t0 - 2) * 512), c = *(const v4u*)(src + (size_t)(t0 - 1) * 512);
#pragma unroll
            for (int i = 0; i < 4; ++i) { h0[2 * i] = bflo(a[i]); h0[2 * i + 1] = bfhi(a[i]); h1[2 * i] = bflo(b[i]); h1[2 * i + 1] = bfhi(b[i]); h2[2 * i] = bflo(c[i]); h2[2 * i + 1] = bfhi(c[i]); }
        }
#pragma unroll 8
        for (int r = 0; r < 32; ++r) {
            const v4u cu = *(const v4u*)(src + (size_t)(t0 + r) * 512); float c[8], o[8];
#pragma unroll
            for (int i = 0; i < 4; ++i) { c[2 * i] = bflo(cu[i]); c[2 * i + 1] = bfhi(cu[i]); }
#pragma unroll
            for (int i = 0; i < 8; ++i) { const float y = w[0][i] * h0[i] + w[1][i] * h1[i] + w[2][i] * h2[i] + w[3][i] * c[i];
                o[i] = osc * xsig(y, y); h0[i] = h1[i]; h1[i] = h2[i]; h2[i] = c[i]; }
            *(v4u*)(dst + (size_t)(t0 + r) * 512) = (v4u){pk2(o[0], o[1]), pk2(o[2], o[3]), pk2(o[4], o[5]), pk2(o[6], o[7])};
        }
    }
}

__device__ __forceinline__ void fox_cumsum(LAS float* CB, LAS float* red, const float* Gt, float bias, int b, int h, int tid, int lane, int wave) {
    float v[8]; const float* base = Gt + ((size_t)b * SEQ + tid * 8) * 16 + h;
#pragma unroll
    for (int i = 0; i < 8; ++i) { const float z = base[i * 16] + bias; v[i] = (fminf(z, 0.f) - log1pf(expf(-fabsf(z)))) * 1.4426950408889634f; }
#pragma unroll
    for (int i = 1; i < 8; ++i) v[i] += v[i - 1];
    const float tot = v[7]; float sc = tot;
#pragma unroll
    for (int o = 1; o < 64; o <<= 1) { const float n = shu(sc, o, lane); if (lane >= o) sc += n; }
    if (lane == 63) red[wave] = sc;
    __syncthreads();
    float off = sc - tot;
    for (int w = 0; w < wave; ++w) off += red[w];
#pragma unroll
    for (int i = 0; i < 8; ++i) CB[tid * 8 + i] = v[i] + off;
    __syncthreads();
}

__device__ __forceinline__ float fox_row_stats(LAS float* red, LAS float* QN, LAS float* DD, const bf16* FQ, const bf16* FK, int b, int h, int tid, int lane, int wave) {
    float mk = 0.f;
    for (int r = tid; r < SEQ; r += NTHR) { const v4u* qp = (const v4u*)(FQ + ((size_t)b * SEQ + r) * 512 + h * 64); const v4u* kp = (const v4u*)(FK + ((size_t)b * SEQ + r) * 512 + h * 64); float sq = 0.f, sk = 0.f, dd = 0.f;
#pragma unroll
        for (int j = 0; j < 8; ++j) { const v4u a = qp[j], c = kp[j];
#pragma unroll
            for (int i = 0; i < 4; ++i) { const float q0 = bflo(a[i]), q1 = bfhi(a[i]), k0 = bflo(c[i]), k1 = bfhi(c[i]); sq += q0 * q0 + q1 * q1; sk += k0 * k0 + k1 * k1; dd += q0 * k0 + q1 * k1; } }
        QN[r] = sqrtf(sq); DD[r] = dd; mk = fmaxf(mk, sk); }
#pragma unroll
    for (int o = 1; o < 64; o <<= 1) mk = fmaxf(mk, shx(mk, o, lane));
    __syncthreads();
    if (lane == 0) red[wave] = mk;
    __syncthreads();
    float c = 0.f;
    for (int w = 0; w < NWAVES; ++w) c = fmaxf(c, red[w]);
    __syncthreads();
    return sqrtf(c);
}

namespace ml {
typedef short bf16x8 __attribute__((ext_vector_type(8)));
typedef short v4i16_t __attribute__((ext_vector_type(4)));
constexpr int PK = 288, PC = 288, NEB = 9, NITEMS = BATCH * 4;
constexpr int L_K = 0, L_V = 36864, L_CT = 73728, L_U = L_CT + 144 * PC, L_MT = L_U + 512, L_BT = L_MT + 512, L_WK = L_BT + 512, L_G = L_WK + 512, L_END = L_G + 512;
static_assert(L_END <= 131072, "mLSTM LDS map");
__device__ __forceinline__ float logsig(float z) { return fminf(z, 0.f) - log1pf(__expf(-fabsf(z))); }
__device__ __forceinline__ bf16x8 cat8(v2u lo, v2u hi) { const v4u w = (v4u){lo.x, lo.y, hi.x, hi.y}; return __builtin_bit_cast(bf16x8, w); }
__device__ __forceinline__ v2u vtr(LAS unsigned char* p) { return __builtin_bit_cast(v2u, __builtin_amdgcn_ds_read_tr16_b64_v4i16((LAS v4i16_t*)p)); }
#define ML_MFMA(a, b, c) __builtin_amdgcn_mfma_f32_16x16x32_bf16((a), (b), (c), 0, 0, 0)
__device__ __forceinline__ void mlstm_item(int item, const bf16* QC, const bf16* KC, const bf16* MV, const bf16* MO, const float* Gt, const float* b_i, const float* b_f, const float* gout, bf16* MIX, LAS unsigned char* L, int tid, int lane, int wave) {
    const int hd = item & 3, b = item >> 2;
    const int hcol = hd * 128;
    const float bi = b_i[hd], bff = b_f[hd];
    const int j16 = lane & 15, kq = lane >> 4, q4 = j16 >> 2, p4 = j16 & 3;
    const int tb = (wave < 4) ? wave : 11 - wave, t = 16 * tb + j16, gmax = tb >> 1;
    unsigned rowb = (unsigned)(j16 * PK + kq * 16), trb = (unsigned)((4 * kq + q4) * PK + p4 * 8), trk = trb + 32u * (unsigned)wave, ub4 = (unsigned)(kq * 16),
             cwb = (unsigned)(4 * kq * PC + (16 * wave + j16) * 2), stb = (unsigned)((tid >> 4) * PK + (tid & 15) * 16), ulb = (unsigned)(8 * lane), tlb = (unsigned)(4 * t);
    asm volatile("" : "+v"(rowb), "+v"(trb), "+v"(trk), "+v"(ub4), "+v"(cwb), "+v"(stb), "+v"(ulb), "+v"(tlb));
    __syncthreads();
    for (int i = tid; i < 144 * PC / 4; i += NTHR) ((LAS unsigned*)(L + L_CT))[i] = 0u;
    for (int i = tid; i < 128 * 8; i += NTHR) ((LAS unsigned*)(L + L_V + (i >> 3) * PK + 256))[i & 7] = ((i & 7) == 0) ? 0x00003F80u : 0u;
    if (tid < 128) *(LAS float*)(L + L_G + 4 * tid) = gout[hcol + tid];
    f32x4 Cacc[NEB];
#pragma unroll
    for (int eb = 0; eb < NEB; ++eb) Cacc[eb] = (f32x4){0.f, 0.f, 0.f, 0.f};
    float m_prev = 0.f;
    v4u kreg[4], vreg[4]; bf16x8 qreg[4]; float gi0, gi1, gf0, gf1, hi0, hi1, hf0, hf1;
#define ML_GATES(cc, a0, a1, c0, c1) do { const float* g0_ = Gt + ((size_t)b * SEQ + (size_t)(cc) * 128 + 2 * lane) * 16; a0 = g0_[8 + hd]; a1 = g0_[24 + hd]; c0 = g0_[12 + hd]; c1 = g0_[28 + hd]; } while (0)
#define ML_LOAD(cc) do { const size_t r0_ = (size_t)b * SEQ + (size_t)(cc) * 128; \
        _Pragma("unroll") for (int j = 0; j < 4; ++j) { const int id = tid + NTHR * j, r = id >> 4, c16 = id & 15; kreg[j] = *(const v4u*)(KC + (r0_ + r) * 512 + hcol + c16 * 8); vreg[j] = *(const v4u*)(MV + (r0_ + r) * 512 + hcol + c16 * 8); } \
        _Pragma("unroll") for (int ks = 0; ks < 4; ++ks) qreg[ks] = *(const bf16x8*)(QC + (r0_ + t) * 512 + hcol + 32 * ks + 8 * kq); } while (0)
    ML_GATES(0, gi0, gi1, gf0, gf1); ML_GATES(1, hi0, hi1, hf0, hf1);
    ML_LOAD(0);
    float u0, u1, M0, M1, b0, b1, Mlast, bL;
#define ML_SCALARS(mp) do { const float i0_ = gi0 + bi, i1_ = gi1 + bi; const float f0_ = logsig(gf0 + bff), f1_ = logsig(gf1 + bff); \
        b0 = f0_; b1 = f0_ + f1_; \
        { float sc = b1; _Pragma("unroll") for (int o = 1; o < 64; o <<= 1) { const float n = shu(sc, o, lane); if (lane >= o) sc += n; } const float off = sc - b1; b0 += off; b1 += off; } \
        u0 = i0_ - b0; u1 = i1_ - b1; \
        float c0_ = u0, c1_ = fmaxf(u0, u1); \
        { float pm = c1_; _Pragma("unroll") for (int o = 1; o < 64; o <<= 1) { const float n = shu(pm, o, lane); if (lane >= o) pm = fmaxf(pm, n); } \
          float prev = shu(pm, 1, lane); if (lane == 0) prev = -INFINITY; c0_ = fmaxf(c0_, prev); c1_ = fmaxf(c1_, prev); } \
        M0 = fmaxf((mp), c0_); M1 = fmaxf((mp), c1_); Mlast = shl(M1, 63); bL = shl(b1, 63); } while (0)
    ML_SCALARS(m_prev);
    gi0 = hi0; gi1 = hi1; gf0 = hf0; gf1 = hf1;
    for (int c = 0; c < SEQ / 128; ++c) {
        const size_t row0 = (size_t)b * SEQ + (size_t)c * 128;
        if (wave == 0) { *(LAS f32x2*)(L + L_U + ulb) = (f32x2){u0, u1}; *(LAS f32x2*)(L + L_MT + ulb) = (f32x2){M0, M1}; *(LAS f32x2*)(L + L_BT + ulb) = (f32x2){b0, b1};
                         *(LAS f32x2*)(L + L_WK + ulb) = (f32x2){__expf(u0 - Mlast), __expf(u1 - Mlast)}; }
        const float Mlast_c = Mlast, m_next = bL + Mlast;
#pragma unroll
        for (int j = 0; j < 4; ++j) { *(LAS v4u*)(L + L_K + stb + 32 * j * PK) = kreg[j]; *(LAS v4u*)(L + L_V + stb + 32 * j * PK) = vreg[j]; }
        bf16x8 qf[4]; v2u mo[8];
#pragma unroll
        for (int ks = 0; ks < 4; ++ks) qf[ks] = qreg[ks];
        __syncthreads();
        if (c + 1 < SEQ / 128) ML_LOAD(c + 1);
        { const int c2 = (c + 2 < SEQ / 128) ? c + 2 : SEQ / 128 - 1; ML_GATES(c2, hi0, hi1, hf0, hf1); }
        ML_SCALARS(m_next);
        gi0 = hi0; gi1 = hi1; gf0 = hf0; gf1 = hf1;
#pragma unroll
        for (int eb = 0; eb < 8; ++eb) mo[eb] = *(const v2u*)(MO + (row0 + t) * 512 + hcol + 16 * eb + 4 * kq);
        const float Mt = *(const LAS float*)(L + L_MT + tlb), bt = *(const LAS float*)(L + L_BT + tlb);
        const float winter = __expf(m_prev - Mt), thr = __expf(-(bt + Mt));
        f32x4 acc[NEB];
#pragma unroll
        for (int eb = 0; eb < NEB; ++eb) { f32x4 a4 = (f32x4){0.f, 0.f, 0.f, 0.f};
#pragma unroll
            for (int ks = 0; ks < 4; ++ks) { const bf16x8 a = *(const LAS bf16x8*)(L + L_CT + rowb + (16 * eb * PC + 64 * ks)); a4 = ML_MFMA(a, qf[ks], a4); }
            acc[eb] = a4 * winter; }
        { const float decay = __expf(m_prev - Mlast_c);
#pragma unroll
          for (int eb = 0; eb < NEB; ++eb) Cacc[eb] = Cacc[eb] * decay; }
#pragma unroll
        for (int g = 0; g < 4; ++g) {
            bf16x8 pf; const bool live = (g <= gmax);
            if (live) {
                f32x4 s0 = (f32x4){0.f, 0.f, 0.f, 0.f}, s1 = s0;
#pragma unroll
                for (int ks = 0; ks < 4; ++ks) { const bf16x8 a0 = *(const LAS bf16x8*)(L + L_K + rowb + (32 * g * PK + 64 * ks)), a1 = *(const LAS bf16x8*)(L + L_K + rowb + ((32 * g + 16) * PK + 64 * ks));
                    s0 = ML_MFMA(a0, qf[ks], s0); s1 = ML_MFMA(a1, qf[ks], s1); }
                const f32x4 ua = *(const LAS f32x4*)(L + L_U + ub4 + 128 * g), ub = *(const LAS f32x4*)(L + L_U + ub4 + 128 * g + 64);
                float p[8];
#pragma unroll
                for (int i = 0; i < 4; ++i) { const int sa = 32 * g + 4 * kq + i;
                    p[i] = (sa <= t) ? s0[i] * __expf(ua[i] - Mt) : 0.f; p[4 + i] = (sa + 16 <= t) ? s1[i] * __expf(ub[i] - Mt) : 0.f; }
                const v4u pw = (v4u){pk2(p[0], p[1]), pk2(p[2], p[3]), pk2(p[4], p[5]), pk2(p[6], p[7])};
                pf = __builtin_bit_cast(bf16x8, pw);
            }
            bf16x8 bfr;
            { LAS unsigned char* kp = L + L_K + trk + 32 * g * PK;
              const v2u klo = vtr(kp), khi = vtr(kp + 16 * PK);
              const f32x4 wa = *(const LAS f32x4*)(L + L_WK + ub4 + 128 * g), wb = *(const LAS f32x4*)(L + L_WK + ub4 + 128 * g + 64);
              const v4u kw = (v4u){pk2(bflo(klo.x) * wa[0], bfhi(klo.x) * wa[1]), pk2(bflo(klo.y) * wa[2], bfhi(klo.y) * wa[3]), pk2(bflo(khi.x) * wb[0], bfhi(khi.x) * wb[1]), pk2(bflo(khi.y) * wb[2], bfhi(khi.y) * wb[3])};
              bfr = __builtin_bit_cast(bf16x8, kw); }
#pragma unroll
            for (int e0 = 0; e0 < NEB; e0 += 3) {
                bf16x8 af[3];
#pragma unroll
                for (int k = 0; k < 3; ++k) { LAS unsigned char* vp = L + L_V + trb + (32 * g * PK + 32 * (e0 + k)); af[k] = cat8(vtr(vp), vtr(vp + 16 * PK)); }
                if (live) {
#pragma unroll
                    for (int k = 0; k < 3; ++k) acc[e0 + k] = ML_MFMA(af[k], pf, acc[e0 + k]); }
#pragma unroll
                for (int k = 0; k < 3; ++k) Cacc[e0 + k] = ML_MFMA(af[k], bfr, Cacc[e0 + k]);
            }
        }
        { const float den = shl(acc[8][0], j16); const float inv = __builtin_amdgcn_rcpf(fmaxf(fabsf(den), thr));
          float ss = 0.f;
#pragma unroll
          for (int eb = 0; eb < 8; ++eb) { acc[eb] = acc[eb] * inv; ss += (acc[eb][0] * acc[eb][0] + acc[eb][1] * acc[eb][1]) + (acc[eb][2] * acc[eb][2] + acc[eb][3] * acc[eb][3]); }
          ss += shx(ss, 16, lane); ss += shx(ss, 32, lane);
          const float rs = __builtin_amdgcn_rsqf(ss * (1.f / 128.f) + EPS);
          bf16* op = MIX + (row0 + t) * 1024 + 512 + hcol + 4 * kq;
#pragma unroll
          for (int eb = 0; eb < 8; ++eb) { const f32x4 h = acc[eb] * rs * *(const LAS f32x4*)(L + L_G + ub4 + 64 * eb); const v2u m2 = mo[eb];
              const float o0 = xsig(h[0], bflo(m2.x)), o1 = xsig(h[1], bfhi(m2.x)), o2 = xsig(h[2], bflo(m2.y)), o3 = xsig(h[3], bfhi(m2.y));
              *(v2u*)(op + 16 * eb) = (v2u){pk2(o0, o1), pk2(o2, o3)}; } }
        __syncthreads();
#pragma unroll
        for (int eb = 0; eb < NEB; ++eb) { const unsigned w01 = pk2(Cacc[eb][0], Cacc[eb][1]), w23 = pk2(Cacc[eb][2], Cacc[eb][3]);
            *(LAS unsigned short*)(L + L_CT + cwb + (16 * eb + 0) * PC) = (unsigned short)(w01 & 0xffffu); *(LAS unsigned short*)(L + L_CT + cwb + (16 * eb + 1) * PC) = (unsigned short)(w01 >> 16);
            *(LAS unsigned short*)(L + L_CT + cwb + (16 * eb + 2) * PC) = (unsigned short)(w23 & 0xffffu); *(LAS unsigned short*)(L + L_CT + cwb + (16 * eb + 3) * PC) = (unsigned short)(w23 >> 16); }
        m_prev = m_next;
    }
}
#undef ML_MFMA
#undef ML_LOAD
#undef ML_GATES
#undef ML_SCALARS
}
__device__ __forceinline__ void panel_rstd(int row0, int nrows, const float* SSP, float* RSTD, int tid) {
    for (int rr = tid; rr < nrows; rr += NTHR) { const int row = row0 + rr; const f32x4* p = (const f32x4*)(SSP + (size_t)row * 16); const f32x4 a = p[0], b = p[1], c = p[2], d = p[3];
        const float s = (((a[0] + a[1]) + (a[2] + a[3])) + ((b[0] + b[1]) + (b[2] + b[3]))) + (((c[0] + c[1]) + (c[2] + c[3])) + ((d[0] + d[1]) + (d[2] + d[3])));
        RSTD[row] = 1.0f / sqrtf(s * (1.f / DM) + EPS); }
}
__device__ __forceinline__ void panel_final_norm(int pm, const bf16* XB, int xpitch, const float* RSTD, const float* g, float* out, int lane, int wave) {
    const f32x4* g4 = (const f32x4*)g;
#pragma unroll 4
    for (int i = wave; i < 256; i += NWAVES) { const int row = pm * 256 + i; const float rs = RSTD[row];
#pragma unroll
        for (int j = 0; j < 2; ++j) { const v4u w = *((const v4u*)(XB + (size_t)row * xpitch) + lane + 64 * j); const f32x4 ga = g4[2 * (lane + 64 * j)], gb = g4[2 * (lane + 64 * j) + 1];
            f32x4* o = (f32x4*)(out + (size_t)row * DM) + 2 * (lane + 64 * j);
            o[0] = (f32x4){bflo(w.x) * rs * ga[0], bfhi(w.x) * rs * ga[1], bflo(w.y) * rs * ga[2], bfhi(w.y) * rs * ga[3]};
            o[1] = (f32x4){bflo(w.z) * rs * gb[0], bfhi(w.z) * rs * gb[1], bflo(w.w) * rs * gb[2], bfhi(w.w) * rs * gb[3]}; } }
}

__device__ __forceinline__ void group_barrier(unsigned* cnt, unsigned want, bool t0) {
    asm volatile("s_waitcnt vmcnt(0) lgkmcnt(0)" ::: "memory");
    __syncthreads();
    if (t0) {
        __builtin_amdgcn_fence(__ATOMIC_RELEASE, "agent");
        asm volatile("s_waitcnt vmcnt(0)" ::: "memory");
        __hip_atomic_fetch_add(cnt, 1u, __ATOMIC_RELAXED, __HIP_MEMORY_SCOPE_AGENT);
        unsigned sp = 0;
        while (__hip_atomic_load(cnt, __ATOMIC_RELAXED, __HIP_MEMORY_SCOPE_AGENT) < want) { __builtin_amdgcn_s_sleep(1); if (++sp > (1u << 24)) break; }
        __builtin_amdgcn_fence(__ATOMIC_ACQUIRE, "agent");
        asm volatile("s_waitcnt vmcnt(0)" ::: "memory");
    }
    __syncthreads();
    __builtin_amdgcn_fence(__ATOMIC_ACQUIRE, "agent");
    asm volatile("s_waitcnt vmcnt(0)" ::: "memory");
}
#if defined(PROBE_DUP) && PROBE_DUP == 3
#define PROBE_ML_REP 2
#else
#define PROBE_ML_REP 1
#endif
typedef const __attribute__((address_space(4))) Args* ArgsP;
__global__ void __launch_bounds__(NTHR, 2) hymba_fwd(Args args_unused) {
    extern __shared__ __attribute__((aligned(16))) unsigned char lds[];
    cg::grid_group grid = cg::this_grid();
    LAS unsigned char* L = (LAS unsigned char*)lds;
    const int wave0 = __builtin_amdgcn_readfirstlane((int)threadIdx.x >> 6);
    const int G = gridDim.x, bx = blockIdx.x;
#define ARGP() ArgsP ap = (ArgsP)__builtin_amdgcn_kernarg_segment_ptr(); asm volatile("" : "+s"(ap)); unsigned char* ws = ap->ws; (void)ws
#define FRESH_TID() int tid_; asm volatile("v_mbcnt_lo_u32_b32 %0, -1, 0\n\tv_mbcnt_hi_u32_b32 %0, -1, %0" : "=v"(tid_)); tid_ += wave0 * 64; asm volatile("" : "+v"(tid_));     const int tid = tid_, lane = tid & 63, wave = __builtin_amdgcn_readfirstlane(tid >> 6); (void)lane; (void)wave
    constexpr size_t ZS = (size_t)M * 512;
#ifdef PROBE_A
    volatile LAS unsigned long long* TS = (volatile LAS unsigned long long*)(L + 140000);
#define STAMP(k) do { if (bx == 0 && wave0 == 0) TS[k] = __builtin_amdgcn_s_memrealtime(); } while (0)
#else
#define STAMP(k) do {} while (0)
#endif
    STAMP(0);
    volatile LAS unsigned* xst = (volatile LAS unsigned*)(L + RING_BYTES + 64);
    if (wave0 == 0) { xst[0] = 0u; xst[1] = 0u; }
    __syncthreads();
    { ARGP(); FRESH_TID(); const XcdBarrier xb0 = xcd_barrier_make((unsigned*)(ws + WS_CTL), xst); xcd_barrier_post(xb0, tid == 0); }
#define SEAM() do { ARGP(); FRESH_TID(); const XcdBarrier xb_ = xcd_barrier_make((unsigned*)(ws + WS_CTL), xst); xcd_barrier(xb_, tid == 0); } while (0)

    { ARGP(); FRESH_TID(); Args a;
#pragma unroll
      for (int i = 0; i < 18; ++i) a.in[i] = ap->in[i];
      a.out = ap->out; a.ws = ws;
      p0_prologue(a, ws, L, tid, lane, wave, bx, G);
#if defined(PROBE_DUP) && (PROBE_DUP == 4 || PROBE_DUP == 6)
      block_seam(); p0_prologue(a, ws, L, tid, lane, wave, bx, G);
#endif
    }
    grid.sync();
    STAMP(1);

    {
        ARGP(); FRESH_TID();
        pg8::Gemm g{(const bf16*)(ws + WS_XN), (const bf16*)(ws + WS_WIN), M, NZ, DM}; pg8::StaticOrder S; S.init(M, NZ, G, bx);
        pg8::EpiZ E{(bf16*)(ws + WS_Z), ZS, (bf16*)(ws + WS_MO), (float*)(ws + WS_G), attn_body::C2};
        pg8::gemm_phase<pg8::EpiZ, pg8::StaticOrder, true, true>(L, g, S, E, tid);
#if defined(PROBE_DUP) && PROBE_DUP == 1
        block_seam(); pg8::gemm_phase<pg8::EpiZ, pg8::StaticOrder, true, true>(L, g, S, E, tid);
#endif
    }
    SEAM();
    STAMP(2);

    { ARGP(); FRESH_TID(); bf16* Z = (bf16*)(ws + WS_Z); conv_silu_phase(ap->in[6], Z + 3 * ZS, Z + 4 * ZS, (bf16*)(ws + WS_QC), (bf16*)(ws + WS_KC), bx * NTHR + tid, G * NTHR);
#if defined(PROBE_DUP) && (PROBE_DUP == 5 || PROBE_DUP == 6)
      block_seam(); conv_silu_phase(ap->in[6], Z + 3 * ZS, Z + 4 * ZS, (bf16*)(ws + WS_QC), (bf16*)(ws + WS_KC), bx * NTHR + tid, G * NTHR);
#endif
    }
    STAMP(3);
    {
        const int vcu0 = (G % 8 == 0) ? (bx % 8) * (G / 8) + bx / 8 : bx;
        for (int bh = vcu0; bh < 128; bh += G) { ARGP(); FRESH_TID(); const int b = bh >> 3, h = bh & 7;
            LAS float* CBl = (LAS float*)(L + attn_body::LDS_CB); LAS float* red = (LAS float*)(L + attn_body::LDS_CB + 16384);
            __syncthreads();
            fox_cumsum(CBl, red, (const float*)(ws + WS_G), ap->in[3][h], b, h, tid, lane, wave);
            for (int i = tid; i < SEQ / 4; i += NTHR) ((f32x4*)(ws + WS_CBG) + (size_t)bh * (SEQ / 4))[i] = ((const LAS f32x4*)CBl)[i];
            LAS float* QN = (LAS float*)L; LAS float* DD = (LAS float*)(L + 16384);
            const float kmax = fox_row_stats(red, QN, DD, (const bf16*)(ws + WS_Z), (const bf16*)(ws + WS_Z) + ZS, b, h, tid, lane, wave);
#pragma unroll
            for (int k = 0; k < 2; ++k) { const int qb = wave + 8 * k, NT = 4 * qb + 4; float e = 0.f;
#pragma unroll
                for (int q = 0; q < 4; ++q) { const int i = 256 * qb + 4 * lane + q; e = fmaxf(e, 1.02f * QN[i] * kmax - DD[i]); }
#pragma unroll
                for (int o = 1; o < 64; o <<= 1) e = fmaxf(e, shx(e, o, lane));
                const float thr = 40.f + e, c0 = CBl[256 * qb];
                const bool cond = (lane < NT - 4) && (CBl[64 * lane + 63] - c0 >= thr);
                const int ts = (int)__builtin_popcountll(__ballot(cond)) & ~1;
                if (lane == 0) ((int*)(ws + WS_QKB))[bh * 16 + qb] = ts; } }
    }
    SEAM();
    {
        for (;;) { ARGP(); FRESH_TID();
            unsigned qoff = RING_BYTES + 128; asm volatile("" : "+v"(qoff));
            volatile LAS int* qslot = (volatile LAS int*)(L + qoff);
            __syncthreads();
            if (tid == 0) *qslot = (int)atomicAdd((unsigned*)(ws + WS_CTL) + 4000, 1u);
            __syncthreads();
            const int u0 = __builtin_amdgcn_readfirstlane(*qslot);
            if (u0 >= ml::NITEMS + 2048 + M / 256) break;
            if (u0 >= ml::NITEMS + 2048) {
                pg8::Gemm g{(const bf16*)(ws + WS_PB), (const bf16*)(ws + WS_WPLE), M, DM, PLE}; pg8::RowOrder S{u0 - (ml::NITEMS + 2048), 4}; pg8::EpiPlain E{(bf16*)ap->out, 2 * DM};
                pg8::gemm_phase<pg8::EpiPlain, pg8::RowOrder, true, true>(L, g, S, E, tid);
                continue; }
            if (u0 < ml::NITEMS) {
                ml::mlstm_item(u0, (const bf16*)(ws + WS_QC), (const bf16*)(ws + WS_KC), (const bf16*)(ws + WS_Z) + 5 * ZS, (const bf16*)(ws + WS_MO), (const float*)(ws + WS_G), ap->in[4], ap->in[5], ap->in[9], (bf16*)(ws + WS_MIX), L, tid, lane, wave);
                continue; }
            const int u = u0 - ml::NITEMS;
            const int qb = 15 - (u >> 7), bh = u & 127, b = bh >> 3, h = bh & 7;
            const int ts = __builtin_amdgcn_readfirstlane(((const int*)(ws + WS_QKB))[bh * 16 + qb]);
            { LAS f32x4* CB4 = (LAS f32x4*)(L + attn_body::LDS_CB); const f32x4* src = (const f32x4*)(ws + WS_CBG) + (size_t)bh * (SEQ / 4);
              for (int i = ts * 16 + tid; i < (qb + 1) * 64; i += NTHR) CB4[i] = src[i]; }
            __syncthreads();
            const bf16* Z = (const bf16*)(ws + WS_Z);
            attn_body::attn_unit<20>(b, h, qb, (const attn_body::bf16*)Z, (const attn_body::bf16*)(Z + ZS), (const attn_body::bf16*)(Z + 2 * ZS), (attn_body::bf16*)(ws + WS_MIX), ap->in[8], (char*)lds, tid, ts); }
    }
    SEAM();
    STAMP(5);

    if (G == M / 256) {
        const int vcu = (bx % 8) * (G / 8) + bx / 8, grp = vcu >> 2, mj = vcu & 3, pm0 = 4 * grp, pmine = pm0 + mj;
        unsigned gbk = 0;
#define GROUP_BAR() do { ARGP(); FRESH_TID(); gbk += 4u; group_barrier((unsigned*)(ws + WS_CTL) + 4096 + 64 * grp, gbk, tid == 0); } while (0)
        { ARGP(); FRESH_TID(); pg8::Gemm g{(const bf16*)(ws + WS_MIX), (const bf16*)(ws + WS_WOUT), M, DM, DM}; pg8::GroupOrder S{pm0, mj, 1};
          pg8::EpiResB<0> E{nullptr, (const bf16*)(ws + WS_XN), (bf16*)(ws + WS_XN), nullptr, (const float*)(ws + WS_RSI), (float*)(ws + WS_SSP)};
          pg8::gemm_phase<pg8::EpiResB<0>, pg8::GroupOrder, true, true>(L, g, S, E, tid); }
        GROUP_BAR();
        { ARGP(); FRESH_TID(); panel_rstd(pm0 * 256, 1024, (const float*)(ws + WS_SSP), (float*)(ws + WS_RSTD), tid); }
        block_seam();
        { ARGP(); FRESH_TID(); pg8::Gemm g{(const bf16*)(ws + WS_XN), (const bf16*)(ws + WS_WUP), M, FF, DM}; pg8::GroupOrder S{pm0, mj, 4}; pg8::EpiUp E{(bf16*)(ws + WS_H), (const float*)(ws + WS_RSTD)};
          pg8::gemm_phase<pg8::EpiUp, pg8::GroupOrder, true, true>(L, g, S, E, tid); }
        GROUP_BAR();
        { ARGP(); FRESH_TID(); pg8::Gemm g{(const bf16*)(ws + WS_H), (const bf16*)(ws + WS_WDN), M, DM, FF}; pg8::GroupOrder S{pm0, mj, 1};
          pg8::EpiResB<1> E{nullptr, (const bf16*)(ws + WS_XN), (bf16*)(ws + WS_XN), nullptr, nullptr, (float*)(ws + WS_SSP2)};
          pg8::gemm_phase<pg8::EpiResB<1>, pg8::GroupOrder, true, true>(L, g, S, E, tid); }
        GROUP_BAR();
        { ARGP(); FRESH_TID(); panel_rstd(pm0 * 256, 1024, (const float*)(ws + WS_SSP2), (float*)(ws + WS_RSTD), tid); }
        block_seam();
        { ARGP(); FRESH_TID();
          pg8::Gemm g{(const bf16*)(ws + WS_XN), (const bf16*)(ws + WS_WPG), M, DM, DM}; pg8::GroupOrder S{pm0, mj, 1};
          pg8::EpiResB<2> E{nullptr, (const bf16*)(ws + WS_XN), (bf16*)(ws + WS_H), (const bf16*)ap->out, (const float*)(ws + WS_RSTD), (float*)(ws + WS_SSP3)};
          pg8::gemm_phase<pg8::EpiResB<2>, pg8::GroupOrder, true, true>(L, g, S, E, tid); }
        GROUP_BAR();
        { ARGP(); FRESH_TID(); panel_rstd(pmine * 256, 256, (const float*)(ws + WS_SSP3), (float*)(ws + WS_RSTD), tid); }
        block_seam();
        { ARGP(); FRESH_TID(); panel_final_norm(pmine, (const bf16*)(ws + WS_H), FF, (const float*)(ws + WS_RSTD), ap->in[17], ap->out, lane, wave); }
#undef GROUP_BAR
    }
}

extern "C" void kernel_launch(void* const* d_in, const int* in_sizes, int n_in, void* d_out, int out_size, void* d_ws, size_t ws_size, hipStream_t stream) {
    static int grid = 0;
    if (grid == 0) {
        if (n_in != 18 || in_sizes[0] != M * DM || out_size != M * DM || ws_size < WS_END) { fprintf(stderr, "kernel_launch: unexpected shapes (n_in %d, in0 %d, out %d, ws %zu)\n", n_in, n_in > 0 ? in_sizes[0] : -1, out_size, ws_size); grid = -1; return; }
        int dev = 0, cus = 0, per_cu = 0;
        if (hipGetDevice(&dev) != hipSuccess || hipDeviceGetAttribute(&cus, hipDeviceAttributeMultiprocessorCount, dev) != hipSuccess) { grid = -1; return; }
        if (hipFuncSetAttribute((const void*)hymba_fwd, hipFuncAttributeMaxDynamicSharedMemorySize, LDS_TOTAL) != hipSuccess) { fprintf(stderr, "kernel_launch: hipFuncSetAttribute failed\n"); grid = -1; return; }
        if (hipOccupancyMaxActiveBlocksPerMultiprocessor(&per_cu, (const void*)hymba_fwd, NTHR, LDS_TOTAL) != hipSuccess || per_cu < 1) { fprintf(stderr, "kernel_launch: occupancy query says %d\n", per_cu); per_cu = 1; }
        (void)hipGetLastError();
        grid = cus * per_cu;
        if (grid > 256) grid = 256;
    }
    if (grid < 0) return;
    if (hipMemsetAsync((char*)d_ws + WS_CTL, 0, CTL_BYTES, stream) != hipSuccess) { fprintf(stderr, "kernel_launch: memset of the barrier words failed\n"); return; }
    Args a{};
    for (int i = 0; i < 18; ++i) a.in[i] = (const float*)d_in[i];
    a.out = (float*)d_out; a.ws = (unsigned char*)d_ws;
    void* params[] = {&a};
    hipError_t e = hipLaunchCooperativeKernel((const void*)hymba_fwd, dim3(grid), dim3(NTHR), params, LDS_TOTAL, stream);
    if (e != hipSuccess) fprintf(stderr, "kernel_launch: cooperative launch failed: %s (grid %d)\n", hipGetErrorString(e), grid);
}
```

```cpp
#include <hip/hip_runtime.h>
#include <cstdio>
#include <cstdint>
namespace pg8 {
#define PG8_LAS __attribute__((address_space(3)))
typedef unsigned short bf16_t;
typedef short bf16x8 __attribute__((ext_vector_type(8)));
typedef float f32x4 __attribute__((ext_vector_type(4)));
typedef unsigned u32x4 __attribute__((ext_vector_type(4)));
constexpr int BM = 256, BK = 64, HALF = 128, HTB = HALF * BK * 2  , STAGE_BYTES = 8 * HTB, NXCD = 8, WGM = 8;

__host__ __device__ __forceinline__ int lds_byte(int r, int c) { const int st = (r >> 4) * 2 + (c >> 5), rr = r & 15, cc = c & 31, ob = rr * 64 + cc * 2; return st * 1024 + (ob ^ (((ob >> 9) & 1) << 5)); }
__host__ __device__ __forceinline__ void stage_rc(int b, int& R, int& C) { const int st = b / 1024, sb = b % 1024, swz = sb ^ (((sb >> 9) & 1) << 5); R = (st >> 1) * 16 + swz / 64; C = (st & 1) * 32 + (swz % 64) / 2; }
__host__ __device__ __forceinline__ int perm32(int rho) { const int n = rho >> 4, i = rho & 15; return 8 * (i >> 2) + 4 * n + (i & 3); }

struct Unit { int pm, pn; };
struct Gemm { const bf16_t* A; const bf16_t* Bt; int M, N, K; };

struct StaticOrder {
    int nM, nN, nwg, G, c;
    __host__ __device__ void init(int M, int N, int G_, int c_) { nM = M / BM; nN = N / BM; nwg = nM * nN; G = G_; c = c_; }
    __host__ __device__ bool next(int i, Unit& u) const {
        const long L = (long)i * G + c; if (L >= nwg) return false;
        int wgid = (int)L; { const int q = nwg / NXCD, r = nwg % NXCD, xcd = wgid % NXCD, off = wgid / NXCD; wgid = (xcd < r ? xcd * (q + 1) : r * (q + 1) + (xcd - r) * q) + off; }
        const int nig = WGM * nN, gid = wgid / nig, fm = gid * WGM, gsz = (nM - fm) < WGM ? (nM - fm) : WGM;
        u.pm = fm + ((wgid % nig) % gsz); u.pn = (wgid % nig) / gsz; return true;
    }
    __device__ __forceinline__ void a_ready(const Unit&) const {}
    __device__ __forceinline__ void done(const Unit&) const {}
};

__device__ __forceinline__ unsigned cvt_pk_bf16(float lo, float hi) { unsigned r; asm volatile("v_cvt_pk_bf16_f32 %0, %1, %2" : "=v"(r) : "v"(lo), "v"(hi)); return r; }
typedef float f32x2 __attribute__((ext_vector_type(2)));
typedef unsigned u32x2 __attribute__((ext_vector_type(2)));
__device__ __forceinline__ float bf_lo(unsigned w) { return __uint_as_float(w << 16); }
__device__ __forceinline__ float bf_hi(unsigned w) { return __uint_as_float(w & 0xffff0000u); }
struct EpiZ {
    static constexpr bool PERM = true, AFTER_DRAIN = false;
    bf16_t* Z; size_t zstride; bf16_t* MO; float* G; float scale0;
    __device__ __forceinline__ void operator()(const f32x4 (&acc)[2][2][4][2], const Unit& u, int wr, int wc, int fr, int fq) const {
        asm volatile("" : "+v"(fr), "+v"(fq));
        const int row0 = u.pm * BM + wr * 64 + fr; const int t = u.pn >> 1;
        if (t < 7) {
            bf16_t* base = (t < 6) ? Z + (size_t)t * zstride : MO;
            const float sc = (t == 0) ? scale0 : 1.f;
            const int col0 = (u.pn & 1) * BM + wc * 32 + 8 * fq;
#pragma unroll
            for (int ai = 0; ai < 2; ++ai)
#pragma unroll
                for (int m = 0; m < 4; ++m) { bf16_t* rowp = base + (size_t)(row0 + ai * HALF + m * 16) * 512 + col0;
#pragma unroll
                    for (int bj = 0; bj < 2; ++bj) { const f32x4 v0 = acc[ai][bj][m][0] * sc, v1 = acc[ai][bj][m][1] * sc;
                        u32x4 w; w.x = cvt_pk_bf16(v0[0], v0[1]); w.y = cvt_pk_bf16(v0[2], v0[3]); w.z = cvt_pk_bf16(v1[0], v1[1]); w.w = cvt_pk_bf16(v1[2], v1[3]);
                        *(u32x4*)(rowp + bj * HALF) = w; } }
        } else if (wc == 0 && fq < 2) {
#pragma unroll
            for (int ai = 0; ai < 2; ++ai)
#pragma unroll
                for (int m = 0; m < 4; ++m) { float* gp = G + (size_t)(row0 + ai * HALF + m * 16) * 16 + 8 * fq;
                    *(f32x4*)gp = acc[ai][0][m][0]; *(f32x4*)(gp + 4) = acc[ai][0][m][1]; }
        }
    }
};
template <int MODE> struct EpiResB {
    static constexpr bool PERM = true, AFTER_DRAIN = false;
    const float* basef; const bf16_t* xb; bf16_t* xo; const bf16_t* pl; const float* rstd; float* ssp;
    __device__ __forceinline__ void operator()(const f32x4 (&acc)[2][2][4][2], const Unit& u, int wr, int wc, int fr, int fq) const {
        asm volatile("" : "+v"(fr), "+v"(fq));
        const int lane = fq * 16 + fr, r0 = u.pm * BM + wr * 64 + fr;
        const size_t off0 = (size_t)r0 * 1024 + u.pn * BM + wc * 32 + 8 * fq;
        u32x4 xbv[2][2], plv[2][2]; float rb[2];
#define ER_LD(slot, it) do { const int rr_ = ((it) >> 2) * HALF + ((it) & 3) * 16; const size_t o_ = off0 + (size_t)rr_ * 1024; if (MODE != 1) rb[slot] = rstd[r0 + rr_]; \
        _Pragma("unroll") for (int bj = 0; bj < 2; ++bj) { \
            xbv[slot][bj] = *(const u32x4*)(xb + o_ + bj * HALF); \
            if (MODE == 2) plv[slot][bj] = *(const u32x4*)(pl + o_ + (size_t)(r0 + rr_) * 1024 + bj * HALF); } } while (0)
        ER_LD(0, 0);
#pragma unroll
        for (int it = 0; it < 8; ++it) {
            if (it + 1 < 8) ER_LD((it + 1) & 1, it + 1);
            const int ai = it >> 2, m = it & 3, rr = ai * HALF + m * 16; const size_t off = off0 + (size_t)rr * 1024; float s = 0.f;
#pragma unroll
            for (int bj = 0; bj < 2; ++bj) { float o[8];
                const f32x4 a0 = acc[ai][bj][m][0], a1 = acc[ai][bj][m][1];
                { const u32x4 xw = xbv[it & 1][bj];
                    const float x[8] = {bf_lo(xw.x), bf_hi(xw.x), bf_lo(xw.y), bf_hi(xw.y), bf_lo(xw.z), bf_hi(xw.z), bf_lo(xw.w), bf_hi(xw.w)};
                    if (MODE == 0) { const float rsi_ = rb[it & 1];
#pragma unroll
                        for (int i = 0; i < 4; ++i) { o[i] = x[i] * rsi_ + a0[i]; o[4 + i] = x[4 + i] * rsi_ + a1[i]; } }
                    else if (MODE == 1) {
#pragma unroll
                        for (int i = 0; i < 4; ++i) { o[i] = x[i] + a0[i]; o[4 + i] = x[4 + i] + a1[i]; } }
                    else { const u32x4 pw = plv[it & 1][bj]; const float rs = rb[it & 1];
                        const float p[8] = {bf_lo(pw.x), bf_hi(pw.x), bf_lo(pw.y), bf_hi(pw.y), bf_lo(pw.z), bf_hi(pw.z), bf_lo(pw.w), bf_hi(pw.w)};
#pragma unroll
                        for (int i = 0; i < 4; ++i) { o[i] = x[i] + p[i] * __builtin_amdgcn_rcpf(1.f + __expf(-a0[i] * rs)); o[4 + i] = x[4 + i] + p[4 + i] * __builtin_amdgcn_rcpf(1.f + __expf(-a1[i] * rs)); } } }
#pragma unroll
                for (int i = 0; i < 8; ++i) s += o[i] * o[i];
                u32x4 w; w.x = cvt_pk_bf16(o[0], o[1]); w.y = cvt_pk_bf16(o[2], o[3]); w.z = cvt_pk_bf16(o[4], o[5]); w.w = cvt_pk_bf16(o[6], o[7]);
                *(u32x4*)(xo + off + (MODE == 2 ? (size_t)(r0 + rr) * 3072 : (size_t)0) + bj * HALF) = w; }
            s += __int_as_float(__builtin_amdgcn_ds_bpermute((lane ^ 16) << 2, __float_as_int(s)));
            s += __int_as_float(__builtin_amdgcn_ds_bpermute((lane ^ 32) << 2, __float_as_int(s)));
            if (fq == 0) ssp[(size_t)(r0 + rr) * 16 + u.pn * 4 + wc] = s;
            asm volatile("" ::: "memory");
        }
#undef ER_LD
    }
};
struct EpiUp {
    static constexpr bool PERM = true, AFTER_DRAIN = false;
    bf16_t* H; const float* rstd;
    __device__ __forceinline__ void operator()(const f32x4 (&acc)[2][2][4][2], const Unit& u, int wr, int wc, int fr, int fq) const {
        asm volatile("" : "+v"(fr), "+v"(fq));
        const int row0 = u.pm * BM + wr * 64 + fr, col0 = u.pn * BM + wc * 32 + 8 * fq;
        float rsv[2][4];
#pragma unroll
        for (int ai = 0; ai < 2; ++ai)
#pragma unroll
            for (int m = 0; m < 4; ++m) rsv[ai][m] = rstd[row0 + ai * HALF + m * 16];
#pragma unroll
        for (int ai = 0; ai < 2; ++ai)
#pragma unroll
            for (int m = 0; m < 4; ++m) { const int r = row0 + ai * HALF + m * 16; const float rs = rsv[ai][m]; bf16_t* rowp = H + (size_t)r * 4096 + col0;
#pragma unroll
                for (int bj = 0; bj < 2; ++bj) { f32x4 v0 = acc[ai][bj][m][0] * rs, v1 = acc[ai][bj][m][1] * rs;
#pragma unroll
                    for (int i = 0; i < 4; ++i) { const float a = fmaxf(v0[i], 0.f), b = fmaxf(v1[i], 0.f); v0[i] = a * a; v1[i] = b * b; }
                    u32x4 w; w.x = cvt_pk_bf16(v0[0], v0[1]); w.y = cvt_pk_bf16(v0[2], v0[3]); w.z = cvt_pk_bf16(v1[0], v1[1]); w.w = cvt_pk_bf16(v1[2], v1[3]);
                    *(u32x4*)(rowp + bj * HALF) = w; } }
    }
};
struct EpiPlain {
    static constexpr bool PERM = true, AFTER_DRAIN = false;
    bf16_t* O; int ldc;
    __device__ __forceinline__ void operator()(const f32x4 (&acc)[2][2][4][2], const Unit& u, int wr, int wc, int fr, int fq) const {
        asm volatile("" : "+v"(fr), "+v"(fq));
        const int row0 = u.pm * BM + wr * 64 + fr, col0 = u.pn * BM + wc * 32 + 8 * fq;
#pragma unroll
        for (int ai = 0; ai < 2; ++ai)
#pragma unroll
            for (int m = 0; m < 4; ++m) { bf16_t* rowp = O + (size_t)(row0 + ai * HALF + m * 16) * ldc + col0;
#pragma unroll
                for (int bj = 0; bj < 2; ++bj) { const f32x4 v0 = acc[ai][bj][m][0], v1 = acc[ai][bj][m][1];
                    u32x4 w; w.x = cvt_pk_bf16(v0[0], v0[1]); w.y = cvt_pk_bf16(v0[2], v0[3]); w.z = cvt_pk_bf16(v1[0], v1[1]); w.w = cvt_pk_bf16(v1[2], v1[3]);
                    *(u32x4*)(rowp + bj * HALF) = w; } }
    }
};
struct RowOrder {
    int pm, nN;
    __device__ __forceinline__ bool next(int i, Unit& u) const { if (i >= nN) return false; u.pm = pm; u.pn = i; return true; }
    __device__ __forceinline__ void a_ready(const Unit&) const {}
    __device__ __forceinline__ void done(const Unit&) const {}
};
struct GroupOrder {
    int pm0, j, ncj;
    __device__ __forceinline__ bool next(int i, Unit& u) const { if (i >= 4 * ncj) return false; u.pm = pm0 + (i & 3); u.pn = j + 4 * (i >> 2); return true; }
    __device__ __forceinline__ void a_ready(const Unit&) const {}
    __device__ __forceinline__ void done(const Unit&) const {}
};
template <class Epi, class Sched, bool ALIGN_EPI = false, bool SP2 = false>
__device__ __forceinline__ void gemm_phase(PG8_LAS unsigned char* lds, const Gemm g, const Sched& S, const Epi& E, int tid_) {
    asm volatile("" : "+v"(tid_));
    const int tid = tid_, wid = __builtin_amdgcn_readfirstlane(tid >> 6), lane = tid & 63, wr = wid >> 2, wc = wid & 3, fr = lane & 15, fq = lane >> 4;
    const int K = g.K, nt = K / BK;
    unsigned voffA[2], voffB[2];
#pragma unroll
    for (int i = 0; i < 2; ++i) { int R, C; stage_rc(tid * 16 + i * 8192, R, C); const int Rb = Epi::PERM ? ((R & ~31) + perm32(R & 31)) : R;
        voffA[i] = (unsigned)(R * K + C) * 2u; voffB[i] = (unsigned)(Rb * K + C) * 2u; }
    const size_t kstep = (size_t)(BK * 2);
    const size_t hstep = (size_t)HALF * K * 2;
    const size_t tstep = 2 * hstep;
    const unsigned ldsw = (unsigned)wid * 1024u;
    const int aoff = lds_byte(wr * 64 + fr, fq * 8), boff = lds_byte(wc * 32 + fr, fq * 8);
#define PG8_SA(b, h) (((b) * 2 + (h)) * HTB)
#define PG8_SB(b, h) ((4 + (b) * 2 + (h)) * HTB)
#define PG8_STAGE(bufoff, gbase, voff) do { _Pragma("unroll") for (int _i = 0; _i < 2; ++_i) \
        __builtin_amdgcn_global_load_lds((const unsigned*)((const char*)(gbase) + (voff)[_i]), (PG8_LAS unsigned*)(lds + (bufoff) + ldsw + _i * 8192), 16, 0, 0); } while (0)
#define PG8_LDA(dst, b, h) do { _Pragma("unroll") for (int m = 0; m < 4; ++m) _Pragma("unroll") for (int k = 0; k < 2; ++k) dst[m][k] = *(const PG8_LAS bf16x8*)(lds + PG8_SA(b, h) + aoff + m * 2048 + k * 1024); } while (0)
#define PG8_LDB(dst, b, h) do { _Pragma("unroll") for (int n = 0; n < 2; ++n) _Pragma("unroll") for (int k = 0; k < 2; ++k) dst[n][k] = *(const PG8_LAS bf16x8*)(lds + PG8_SB(b, h) + boff + n * 2048 + k * 1024); } while (0)
#define PG8_MMA(ai, bj, At, Bt) do { __builtin_amdgcn_s_setprio(1); _Pragma("unroll") for (int m = 0; m < 4; ++m) _Pragma("unroll") for (int n = 0; n < 2; ++n) _Pragma("unroll") for (int k = 0; k < 2; ++k) \
        acc[ai][bj][m][n] = __builtin_amdgcn_mfma_f32_16x16x32_bf16(Bt[n][k], At[m][k], acc[ai][bj][m][n], 0, 0, 0); __builtin_amdgcn_s_setprio(0); } while (0)
#define PG8_WAIT_V(n) asm volatile("s_waitcnt vmcnt(" #n ")" ::: "memory")
#define PG8_WAIT_L(n) asm volatile("s_waitcnt lgkmcnt(" #n ")" ::: "memory")
#define PG8_BAR __builtin_amdgcn_s_barrier()
#define PG8_SCHED __builtin_amdgcn_sched_barrier(0)
    Unit cur, nxt; int ui = 0;
    if (!S.next(0, cur)) return;
    f32x4 acc[2][2][4][2];
#pragma unroll
    for (int a = 0; a < 2; ++a)
#pragma unroll
        for (int b = 0; b < 2; ++b)
#pragma unroll
            for (int m = 0; m < 4; ++m)
#pragma unroll
                for (int n = 0; n < 2; ++n) acc[a][b][m][n] = (f32x4){0.f, 0.f, 0.f, 0.f};
    bf16x8 At[4][2], B0[2][2], B1[2][2];
    const char* cA = (const char*)g.A + (size_t)cur.pm * tstep; const char* cB = (const char*)g.Bt + (size_t)cur.pn * tstep;
    S.a_ready(cur);
    if constexpr (SP2) {
        PG8_STAGE(PG8_SB(0, 0), cB, voffB); PG8_STAGE(PG8_SB(0, 1), cB + hstep, voffB); PG8_STAGE(PG8_SA(0, 0), cA, voffA); PG8_STAGE(PG8_SA(0, 1), cA + hstep, voffA);
        if (wr == 1) PG8_BAR;
        PG8_WAIT_V(2); PG8_BAR;
        PG8_STAGE(PG8_SB(1, 0), cB + kstep, voffB); PG8_STAGE(PG8_SA(1, 0), cA + kstep, voffA); PG8_STAGE(PG8_SB(1, 1), cB + hstep + kstep, voffB);
        PG8_WAIT_V(6); PG8_BAR;
    } else {
        PG8_STAGE(PG8_SB(0, 0), cB, voffB); PG8_STAGE(PG8_SA(0, 0), cA, voffA); PG8_STAGE(PG8_SB(0, 1), cB + hstep, voffB); PG8_STAGE(PG8_SA(0, 1), cA + hstep, voffA);
        if (wr == 1) PG8_BAR;
        PG8_WAIT_V(4); PG8_BAR;
        PG8_STAGE(PG8_SB(1, 0), cB + kstep, voffB); PG8_STAGE(PG8_SA(1, 0), cA + kstep, voffA); PG8_STAGE(PG8_SB(1, 1), cB + hstep + kstep, voffB);
        PG8_WAIT_V(6); PG8_BAR;
    }
    for (;;) {
        const bool has_next = S.next(ui + 1, nxt);
        const char* nA = has_next ? (const char*)g.A + (size_t)nxt.pm * tstep : cA; const char* nB = has_next ? (const char*)g.Bt + (size_t)nxt.pn * tstep : cB;
        for (int t = 0; t < nt; t += 2) {
            const bool last = (t == nt - 2);
            const char* a1 = cA + (size_t)(t + 1) * kstep;
            const char* a2 = last ? nA : cA + (size_t)(t + 2) * kstep; const char* b2 = last ? nB : cB + (size_t)(t + 2) * kstep;
            const char* a3 = a2 + kstep; const char* b3 = b2 + kstep;
            asm volatile("" : "+s"(a1), "+s"(a2), "+s"(b2), "+s"(a3), "+s"(b3));
            if (last && has_next) S.a_ready(nxt);
            if constexpr (SP2) {
            PG8_LDB(B0, 0, 0); PG8_LDB(B1, 0, 1); PG8_SCHED; PG8_LDA(At, 0, 0); PG8_STAGE(PG8_SA(1, 1), a1 + hstep, voffA);
            PG8_WAIT_V(8); PG8_WAIT_L(0); PG8_BAR; PG8_MMA(0, 0, At, B0); PG8_MMA(0, 1, At, B1); PG8_BAR; PG8_SCHED;
            PG8_LDA(At, 0, 1); PG8_STAGE(PG8_SB(0, 0), b2, voffB); PG8_STAGE(PG8_SB(0, 1), b2 + hstep, voffB); PG8_STAGE(PG8_SA(0, 0), a2, voffA);
            PG8_WAIT_V(8); PG8_WAIT_L(0); PG8_BAR; PG8_MMA(1, 0, At, B0); PG8_MMA(1, 1, At, B1); PG8_BAR; PG8_SCHED;
            PG8_LDB(B0, 1, 0); PG8_LDB(B1, 1, 1); PG8_SCHED; PG8_LDA(At, 1, 0); PG8_STAGE(PG8_SA(0, 1), a2 + hstep, voffA);
            PG8_WAIT_V(8); PG8_WAIT_L(0); PG8_BAR; PG8_MMA(0, 0, At, B0); PG8_MMA(0, 1, At, B1); PG8_BAR; PG8_SCHED;
            PG8_LDA(At, 1, 1); PG8_STAGE(PG8_SB(1, 0), b3, voffB); PG8_STAGE(PG8_SB(1, 1), b3 + hstep, voffB); PG8_STAGE(PG8_SA(1, 0), a3, voffA);
            PG8_WAIT_V(8); PG8_WAIT_L(0); PG8_BAR; PG8_MMA(1, 0, At, B0); PG8_MMA(1, 1, At, B1); PG8_BAR; PG8_SCHED;
            } else {
            PG8_LDB(B0, 0, 0); PG8_SCHED; PG8_LDA(At, 0, 0); PG8_STAGE(PG8_SA(1, 1), a1 + hstep, voffA);
            PG8_WAIT_L(8); PG8_BAR; PG8_WAIT_L(0); PG8_MMA(0, 0, At, B0); PG8_BAR; PG8_SCHED;
            PG8_LDB(B1, 0, 1); PG8_STAGE(PG8_SB(0, 0), b2, voffB);
            PG8_BAR; PG8_WAIT_L(0); PG8_MMA(0, 1, At, B1); PG8_BAR;
            PG8_LDA(At, 0, 1); PG8_STAGE(PG8_SA(0, 0), a2, voffA);
            PG8_BAR; PG8_WAIT_L(0); PG8_MMA(1, 0, At, B0); PG8_BAR; PG8_SCHED;
            PG8_STAGE(PG8_SB(0, 1), b2 + hstep, voffB);
            PG8_WAIT_V(6); PG8_BAR; PG8_MMA(1, 1, At, B1); PG8_BAR;
            PG8_LDB(B0, 1, 0); PG8_SCHED; PG8_LDA(At, 1, 0); PG8_STAGE(PG8_SA(0, 1), a2 + hstep, voffA);
            PG8_WAIT_L(8); PG8_BAR; PG8_WAIT_L(0); PG8_MMA(0, 0, At, B0); PG8_BAR; PG8_SCHED;
            PG8_LDB(B1, 1, 1); PG8_STAGE(PG8_SB(1, 0), b3, voffB);
            PG8_BAR; PG8_WAIT_L(0); PG8_MMA(0, 1, At, B1); PG8_BAR;
            PG8_LDA(At, 1, 1); PG8_STAGE(PG8_SA(1, 0), a3, voffA);
            PG8_BAR; PG8_WAIT_L(0); PG8_MMA(1, 0, At, B0); PG8_BAR; PG8_SCHED;
            PG8_STAGE(PG8_SB(1, 1), b3 + hstep, voffB);
            PG8_WAIT_V(6); PG8_BAR; PG8_MMA(1, 1, At, B1); PG8_BAR;
            }
        }
        if constexpr (ALIGN_EPI) { if (wr == 0) PG8_BAR; }
        if constexpr (!Epi::AFTER_DRAIN) { E(acc, cur, wr, wc, fr, fq); S.done(cur); }
        if (!has_next) break;
#pragma unroll
        for (int a = 0; a < 2; ++a)
#pragma unroll
            for (int b = 0; b < 2; ++b)
#pragma unroll
                for (int m = 0; m < 4; ++m)
#pragma unroll
                    for (int n = 0; n < 2; ++n) acc[a][b][m][n] = (f32x4){0.f, 0.f, 0.f, 0.f};
        cur = nxt; cA = nA; cB = nB; ++ui;
        if constexpr (ALIGN_EPI) { if (wr == 1) PG8_BAR; }
    }
    PG8_WAIT_V(0);
    if constexpr (!ALIGN_EPI) { if (wr == 0) PG8_BAR; }
    PG8_BAR;
    if constexpr (Epi::AFTER_DRAIN) { E.fused(acc, cur, wr, wc, fr, fq, lds, wid, lane); S.done(cur); }
#undef PG8_SA
#undef PG8_SB
#undef PG8_STAGE
#undef PG8_LDA
#undef PG8_LDB
#undef PG8_MMA
#undef PG8_WAIT_V
#undef PG8_WAIT_L
#undef PG8_BAR
#undef PG8_SCHED
}
}
#include <hip/hip_bf16.h>
#include <cmath>
namespace attn_body {
using bf16=__hip_bfloat16;
using bf16x8=__attribute__((ext_vector_type(8)))short;
using s16x4=__attribute__((ext_vector_type(4)))short;
using f32x16=__attribute__((ext_vector_type(16)))float;
using u32x4=__attribute__((ext_vector_type(4)))unsigned;
using f32x4v=__attribute__((ext_vector_type(4)))float;
constexpr int BATCH=16,NHEAD=8,SEQ=4096,D=64,DM=NHEAD*D,OPITCH=1024;
constexpr int NW=8,QBLK=32,QB=QBLK*NW,KVBLK=64,NQB=SEQ/QB;
constexpr int ATTN_PITCH=DM, ATTN_UNIT_ROWS=QB;
__device__ __forceinline__ int crow(int r,int hi){return (r&3)+8*(r>>2)+4*hi;}
#define SBAR() __builtin_amdgcn_sched_barrier(0)
__device__ __forceinline__ void cmask(f32x16&p0,f32x16&p1,int jb,int qrel,int hi){
  const float NEG=-INFINITY; int kb=64*jb+4*hi;
  #pragma unroll
  for(int r=0;r<16;++r){int kv=kb+(r&3)+8*(r>>2); if(kv>qrel)p0[r]=NEG; if(kv+32>qrel)p1[r]=NEG;}
}

constexpr int NSLOT=3, SLOTB=8192;
constexpr int LDS_K=0, LDS_V=NSLOT*SLOTB, LDS_WS=2*NSLOT*SLOTB, LDS_OST=LDS_WS+NW*64*4, LDS_BYTES=LDS_OST+NW*4096;
constexpr int LDS_CB=86016;
constexpr float C2=0.125f*1.4426950408889634f;
__device__ __forceinline__ void glds16(const void*gsrc,unsigned lds_dst){unsigned keep;
  asm volatile("s_mov_b32 %0, m0\n\ts_mov_b32 m0, %2\n\ts_nop 0\n\tglobal_load_lds_dwordx4 %1, off\n\ts_mov_b32 m0, %0":"=&s"(keep):"v"(gsrc),"s"(lds_dst):"memory");}
__device__ __forceinline__ float max3f(float a,float b,float c){float r;asm("v_max3_f32 %0, %1, %2, %3":"=v"(r):"v"(a),"v"(b),"v"(c));return r;}
__device__ __forceinline__ float max2f(float a,float b){float r;asm("v_max_f32_e32 %0, %1, %2":"=v"(r):"v"(a),"v"(b));return r;}
__device__ __forceinline__ float fadd_s(float a,float b){float r;asm("v_add_f32_e32 %0, %1, %2":"=v"(r):"v"(a),"v"(b));return r;}
__device__ __forceinline__ float fsub_s(float a,float b){float r;asm("v_sub_f32_e32 %0, %1, %2":"=v"(r):"v"(a),"v"(b));return r;}
typedef float f32x2_t __attribute__((ext_vector_type(2))); typedef __bf16 bf16x2_t __attribute__((ext_vector_type(2)));
__device__ __forceinline__ unsigned cvtpk_s(float lo,float hi){f32x2_t v={lo,hi};bf16x2_t b=__builtin_convertvector(v,bf16x2_t);return __builtin_bit_cast(unsigned,b);}
#define WAIT_BAR(N) asm volatile("s_waitcnt vmcnt(" #N ") lgkmcnt(0)\n\ts_barrier":::"memory")

__device__ __forceinline__ void qkt(f32x16&p0,f32x16&p1,const char*Kslot,const bf16x8*qr,const f32x16&negm,int r32,int hi){
  const char*kb=Kslot+hi*1024+r32*16;
  #pragma unroll
  for(int d0=0;d0<4;++d0){
    const bf16x8 b0=*reinterpret_cast<const bf16x8*>(kb+d0*2048);
    const bf16x8 b1=*reinterpret_cast<const bf16x8*>(kb+d0*2048+512);
    if(d0==0){p0=__builtin_amdgcn_mfma_f32_32x32x16_bf16(b0,qr[0],negm,0,0,0);p1=__builtin_amdgcn_mfma_f32_32x32x16_bf16(b1,qr[0],negm,0,0,0);}
    else{p0=__builtin_amdgcn_mfma_f32_32x32x16_bf16(b0,qr[d0],p0,0,0,0);p1=__builtin_amdgcn_mfma_f32_32x32x16_bf16(b1,qr[d0],p1,0,0,0);}}
}
typedef __attribute__((address_space(3))) const char* lds_cptr;
typedef short v4i16_t __attribute__((ext_vector_type(4)));
__device__ __forceinline__ void kload8(bf16x8*kf,lds_cptr kp){
  kf[0]=*(const __attribute__((address_space(3))) bf16x8*)(kp);      kf[1]=*(const __attribute__((address_space(3))) bf16x8*)(kp+512);
  kf[2]=*(const __attribute__((address_space(3))) bf16x8*)(kp+2048); kf[3]=*(const __attribute__((address_space(3))) bf16x8*)(kp+2560);
  kf[4]=*(const __attribute__((address_space(3))) bf16x8*)(kp+4096); kf[5]=*(const __attribute__((address_space(3))) bf16x8*)(kp+4608);
  kf[6]=*(const __attribute__((address_space(3))) bf16x8*)(kp+6144); kf[7]=*(const __attribute__((address_space(3))) bf16x8*)(kp+6656);
}
__device__ __forceinline__ void kload2(bf16x8*kf,lds_cptr kp,int j){ kf[2*j]=*(const __attribute__((address_space(3))) bf16x8*)(kp+j*2048); kf[2*j+1]=*(const __attribute__((address_space(3))) bf16x8*)(kp+j*2048+512); }
__device__ __forceinline__ s16x4 vtr(lds_cptr p){ return __builtin_bit_cast(s16x4,__builtin_amdgcn_ds_read_tr16_b64_v4i16((__attribute__((address_space(3))) v4i16_t*)p)); }
__device__ __forceinline__ float rowmax(const f32x16&p0,const f32x16&p1){
  float a=max3f(p0[0],p0[1],p1[0]),b=max3f(p0[2],p0[3],p1[1]);a=max3f(a,p1[2],p1[3]);
  #pragma unroll
  for(int r=4;r<16;r+=4){a=max3f(a,p0[r],p0[r+1]);b=max3f(b,p0[r+2],p0[r+3]);a=max3f(a,p1[r],p1[r+1]);b=max3f(b,p1[r+2],p1[r+3]);}
  const float m=max2f(a,b);
  auto rr=__builtin_amdgcn_permlane32_swap(__float_as_uint(m),__float_as_uint(m),false,false);
  return max2f(__uint_as_float(rr[0]),__uint_as_float(rr[1]));
}
__device__ __forceinline__ void pv(f32x16*o,int vb,bf16x8 pa0,bf16x8 pa1,bf16x8 pa2,bf16x8 pa3){
  #pragma unroll
  for(int d0=0;d0<2;++d0){s16x4 lo[4],hi[4];
    #pragma unroll
    for(int ks=0;ks<4;++ks){
      asm volatile("ds_read_b64_tr_b16 %0,%1 offset:%c2":"=&v"(lo[ks]):"v"(vb),"i"(d0*4096+ks*1024):"memory");
      asm volatile("ds_read_b64_tr_b16 %0,%1 offset:%c2":"=&v"(hi[ks]):"v"(vb),"i"(d0*4096+ks*1024+512):"memory");}
    asm volatile("s_waitcnt lgkmcnt(0)":::"memory");SBAR();
    #define PK(k) (bf16x8){lo[k][0],lo[k][1],lo[k][2],lo[k][3],hi[k][0],hi[k][1],hi[k][2],hi[k][3]}
    o[d0]=__builtin_amdgcn_mfma_f32_32x32x16_bf16(pa0,PK(0),o[d0],0,0,0);
    o[d0]=__builtin_amdgcn_mfma_f32_32x32x16_bf16(pa1,PK(1),o[d0],0,0,0);
    o[d0]=__builtin_amdgcn_mfma_f32_32x32x16_bf16(pa2,PK(2),o[d0],0,0,0);
    o[d0]=__builtin_amdgcn_mfma_f32_32x32x16_bf16(pa3,PK(3),o[d0],0,0,0);
    #undef PK
  }
}

#ifndef ATTN_STORE16
#define ATTN_STORE16(p,v) (*(u32x4*)(p)=(v))
#endif
template<int THRL> __device__ __forceinline__ void attn_unit(int b,int h,int qb,const bf16*Q,const bf16*__restrict__ K,const bf16*__restrict__ V,bf16*O,const float*gfox,char*shm,int tid_,int ts_){
  asm volatile("":"+v"(tid_)); const int tid=tid_,lane=tid&63,r32=lane&31,hi=lane>>5; const int wid=__builtin_amdgcn_readfirstlane(tid>>6);
  const long rowbase=(long)b*SEQ; const int q0=qb*QB;
  const bf16*Qw=Q+(rowbase+q0+wid*QBLK)*DM+h*D;
  const bf16*Kh=K+(rowbase+(long)ts_*KVBLK)*DM+h*D,*Vh=V+(rowbase+(long)ts_*KVBLK)*DM+h*D;
  const unsigned lds0=(unsigned)(uintptr_t)shm;
  float*wsf=(float*)(shm+LDS_WS)+wid*64;
  const bf16*ksrc=Kh+(long)lane*DM+wid*8;
  const bf16*vsrc=Vh+(long)(16*(wid&3)+(lane>>2))*DM+(wid>>2)*32+(lane&3)*8;
  const unsigned kdst=lds0+LDS_K+wid*1024, vdst=lds0+LDS_V+wid*1024;
  #define DMA_K(t,slot) glds16(ksrc+(long)(t)*KVBLK*DM,(unsigned)__builtin_amdgcn_readfirstlane(kdst+(slot)))
  #define DMA_V(t,slot) glds16(vsrc+(long)(t)*KVBLK*DM,(unsigned)__builtin_amdgcn_readfirstlane(vdst+(slot)))
  const int vb0=(int)(lds0+LDS_V)+((lane>>4)&1)*32+(lane&3)*8+(4*hi+((lane&15)>>2))*64;
  const char*Kbase=shm+LDS_K; bf16x8 kf[8];
  const lds_cptr shm3=(lds_cptr)shm; const lds_cptr kp0=shm3+LDS_K+hi*1024+r32*16; const lds_cptr vp0=shm3+LDS_V+((lane>>4)&1)*32+(lane&3)*8+(4*hi+((lane&15)>>2))*64;
  const int NT=(q0+QB)/KVBLK-ts_;
  DMA_K(0,0);DMA_V(0,0);DMA_K(1,SLOTB);
  bf16x8 qr[4];
  #pragma unroll
  for(int d0=0;d0<4;++d0)qr[d0]=*reinterpret_cast<const bf16x8*>(&Qw[(long)r32*DM+d0*16+hi*8]);
  float mhat=0.f,l_reg=0.f;f32x16 o[2]; float zz_=0.f; asm volatile("":"+v"(zz_));
  #pragma unroll
  for(int r=0;r<16;++r){o[0][r]=zz_;o[1][r]=zz_;}
  f32x16 negm;
  #pragma unroll
  for(int r=0;r<16;++r)negm[r]=zz_;
  asm volatile("":"+v"(negm));
  const int qrel=wid*QBLK+r32;
  const __attribute__((address_space(3))) f32x4v* cbq=(const __attribute__((address_space(3))) f32x4v*)((lds_cptr)shm+LDS_CB)+hi+ts_*16;
  #define CINIT(C0,C1,t) do{ const __attribute__((address_space(3))) f32x4v* cb_=cbq+(t)*16; const float nm_=-mhat; \
    _Pragma("unroll") for(int j_=0;j_<4;++j_){ const f32x4v a_=cb_[2*j_], b_=cb_[8+2*j_]; \
      C0[4*j_]=nm_-a_[0]; C0[4*j_+1]=nm_-a_[1]; C0[4*j_+2]=nm_-a_[2]; C0[4*j_+3]=nm_-a_[3]; \
      C1[4*j_]=nm_-b_[0]; C1[4*j_+1]=nm_-b_[1]; C1[4*j_+2]=nm_-b_[2]; C1[4*j_+3]=nm_-b_[3]; } }while(0)
  #define FBIAS(P0,P1,t) do{ const __attribute__((address_space(3))) f32x4v* cb_=cbq+(t)*16; \
    _Pragma("unroll") for(int j_=0;j_<4;++j_){ const f32x4v a_=cb_[2*j_], b_=cb_[8+2*j_]; \
      P0[4*j_]-=a_[0]; P0[4*j_+1]-=a_[1]; P0[4*j_+2]-=a_[2]; P0[4*j_+3]-=a_[3]; \
      P1[4*j_]-=b_[0]; P1[4*j_+1]-=b_[1]; P1[4*j_+2]-=b_[2]; P1[4*j_+3]-=b_[3]; } }while(0)
  #define CMASK(P0,P1,t) do{int jb_=(t)-(NT-4); if(jb_>=0)cmask(P0,P1,jb_,qrel,hi);}while(0)
  bool resc=false;
  #define START(P0,P1) do{ const float rm=rowmax(P0,P1); resc=false; \
    { const float dl=rm; mhat=fadd_s(mhat,dl); \
      _Pragma("unroll") for(int r=0;r<16;++r){P0[r]=fsub_s(P0[r],dl);P1[r]=fsub_s(P1[r],dl);} \
      } \
    _Pragma("unroll") for(int r=0;r<16;++r)P0[r]=__builtin_amdgcn_exp2f(P0[r]); }while(0)
  #define RESC() do{ if(resc){ asm volatile("s_waitcnt lgkmcnt(0)":::"memory"); \
      _Pragma("unroll") for(int d_=0;d_<2;++d_) _Pragma("unroll") for(int r=0;r<16;++r)o[d_][r]*=wsf[crow(r,hi)]; } }while(0)
  f32x16 pA0,pA1,pB0,pB1;
  int sl_prev=0,sl_cur=0,sl_next=SLOTB;
  #define ROT() do{sl_prev=sl_cur;sl_cur=sl_next;sl_next=(sl_next==(NSLOT-1)*SLOTB)?0:sl_next+SLOTB;}while(0)
  DMA_K(2,2*SLOTB);
  WAIT_BAR(3);
  qkt(pA0,pA1,Kbase,qr,negm,r32,hi);asm volatile("s_nop 15\n\ts_nop 7":"+v"(pA0),"+v"(pA1));FBIAS(pA0,pA1,0);CMASK(pA0,pA1,0);
  START(pA0,pA1);
  _Pragma("unroll") for(int r=0;r<16;++r)pA1[r]=__builtin_amdgcn_exp2f(pA1[r]);
  WAIT_BAR(0);
  DMA_K(3,0);DMA_V(1,SLOTB);
  ROT();
  kload8(kf,kp0+sl_cur);
  WAIT_BAR(2);
  s16x4 vlo[8],vhi[8]; u32x4 pw0,pw1,pw2,pw3;
  #define PKW(P,B) cvtpk_s(P[B],P[B+1])
  #define PAF(k) __builtin_bit_cast(bf16x8,pw##k)
  #define VFR(i) (bf16x8){vlo[i][0],vlo[i][1],vlo[i][2],vlo[i][3],vhi[i][0],vhi[i][1],vhi[i][2],vhi[i][3]}
  #define PIN(x) asm volatile("":"+v"(x))
  #define MX3(a,b,c) __builtin_fmaxf(__builtin_fmaxf((a),(b)),(c))
  #define GAPA(MF,A0,A1,A2,A3,W0,W1,PW) do{ MF; sacc+=A0; sacc+=A1; sacc+=A2; sacc+=A3; PIN(sacc); W0; W1; PIN(PW); SBAR(); }while(0)
  #define EX(v) __builtin_amdgcn_exp2f(v)
  #define GAPB(MF,X,B) do{ MF; X[B]=EX(X[B]); X[B+1]=EX(X[B+1]); X[B+2]=EX(X[B+2]); X[B+3]=EX(X[B+3]); PIN(X); SBAR(); }while(0)
  #define VRD(i) do{ vlo[i]=vtr(vp_+(((i)>>2)*4096+((i)&3)*1024)); vhi[i]=vtr(vp_+(((i)>>2)*4096+((i)&3)*1024+512)); }while(0)
  #define KRD(G,j) do{ if(G){ kload2(kf,kp0+sl_next,j); SBAR(); } }while(0)
  #define STEP(C0,C1,P0,P1,t,GK,GV,GL) do{ SBAR(); \
    const lds_cptr vp_=vp0+sl_prev; CINIT(C0,C1,t); SBAR(); \
    VRD(0); SBAR(); float sacc=(P0[0]+P0[1]); \
    GAPA(C0=__builtin_amdgcn_mfma_f32_32x32x16_bf16(kf[0],qr[0],C0,0,0,0), P0[2],P0[3],P0[4],P0[5],     pw0[0]=PKW(P0,0), pw0[1]=PKW(P0,2), pw0); \
    VRD(4); SBAR(); GAPA(C1=__builtin_amdgcn_mfma_f32_32x32x16_bf16(kf[1],qr[0],C1,0,0,0), P0[6],P0[7],P0[8],P0[9],     pw0[2]=PKW(P0,4), pw0[3]=PKW(P0,6), pw0); \
    VRD(1); SBAR(); GAPA(C0=__builtin_amdgcn_mfma_f32_32x32x16_bf16(kf[2],qr[1],C0,0,0,0),   P0[10],P0[11],P0[12],P0[13], pw1[0]=PKW(P0,8), pw1[1]=PKW(P0,10), pw1); \
    VRD(5); SBAR(); GAPA(C1=__builtin_amdgcn_mfma_f32_32x32x16_bf16(kf[3],qr[1],C1,0,0,0),   P0[14],P0[15],P1[0],P1[1],   pw1[2]=PKW(P0,12),pw1[3]=PKW(P0,14), pw1); \
    VRD(2); SBAR(); GAPA(C0=__builtin_amdgcn_mfma_f32_32x32x16_bf16(kf[4],qr[2],C0,0,0,0),   P1[2],P1[3],P1[4],P1[5],     pw2[0]=PKW(P1,0), pw2[1]=PKW(P1,2), pw2); \
    VRD(6); SBAR(); GAPA(C1=__builtin_amdgcn_mfma_f32_32x32x16_bf16(kf[5],qr[2],C1,0,0,0),   P1[6],P1[7],P1[8],P1[9],     pw2[2]=PKW(P1,4), pw2[3]=PKW(P1,6), pw2); \
    VRD(3); SBAR(); GAPA(C0=__builtin_amdgcn_mfma_f32_32x32x16_bf16(kf[6],qr[3],C0,0,0,0),   P1[10],P1[11],P1[12],P1[13], pw3[0]=PKW(P1,8), pw3[1]=PKW(P1,10), pw3); \
    VRD(7); SBAR(); GAPA(C1=__builtin_amdgcn_mfma_f32_32x32x16_bf16(kf[7],qr[3],C1,0,0,0),   P1[14],P1[15],0.f,0.f,       pw3[2]=PKW(P1,12),pw3[3]=PKW(P1,14), pw3); \
    l_reg+=sacc; \
    if(GK){DMA_K((t)+3,sl_cur);} if(GV){DMA_V((t)+1,sl_next);} \
    CMASK(C0,C1,t); \
    { float a=MX3(C0[0],C0[1],C1[0]),b=MX3(C0[2],C0[3],C1[1]); a=MX3(a,C1[2],C1[3]); \
      _Pragma("unroll") for(int r=4;r<16;r+=4){a=MX3(a,C0[r],C0[r+1]);b=MX3(b,C0[r+2],C0[r+3]);a=MX3(a,C1[r],C1[r+1]);b=MX3(b,C1[r+2],C1[r+3]);} \
      float rm=__builtin_fmaxf(a,b); { auto rr=__builtin_amdgcn_permlane32_swap(__float_as_uint(rm),__float_as_uint(rm),false,false); rm=__builtin_fmaxf(__uint_as_float(rr[0]),__uint_as_float(rr[1])); } \
      resc=false; \
      if(__builtin_expect(__any(rm>(float)THRL),0)){ const float dl=__builtin_fmaxf(rm,0.f); mhat+=dl; \
        _Pragma("unroll") for(int r=0;r<16;++r){C0[r]-=dl;C1[r]-=dl;} \
        const float f=__builtin_amdgcn_exp2f(-dl); l_reg*=f; if(hi==0)wsf[r32]=f; resc=true; } } \
    SBAR(); \
    GAPB(o[0]=__builtin_amdgcn_mfma_f32_32x32x16_bf16(PAF(0),VFR(0),o[0],0,0,0), C0,0); \
    GAPB(o[1]=__builtin_amdgcn_mfma_f32_32x32x16_bf16(PAF(0),VFR(4),o[1],0,0,0), C0,4); \
    KRD(GL,0); GAPB(o[0]=__builtin_amdgcn_mfma_f32_32x32x16_bf16(PAF(1),VFR(1),o[0],0,0,0), C0,8); \
    KRD(GL,1); GAPB(o[1]=__builtin_amdgcn_mfma_f32_32x32x16_bf16(PAF(1),VFR(5),o[1],0,0,0), C0,12); \
    KRD(GL,2); GAPB(o[0]=__builtin_amdgcn_mfma_f32_32x32x16_bf16(PAF(2),VFR(2),o[0],0,0,0), C1,0); \
    KRD(GL,3); GAPB(o[1]=__builtin_amdgcn_mfma_f32_32x32x16_bf16(PAF(2),VFR(6),o[1],0,0,0), C1,4); \
    GAPB(o[0]=__builtin_amdgcn_mfma_f32_32x32x16_bf16(PAF(3),VFR(3),o[0],0,0,0), C1,8); \
    GAPB(o[1]=__builtin_amdgcn_mfma_f32_32x32x16_bf16(PAF(3),VFR(7),o[1],0,0,0), C1,12); \
    }while(0)
  int t=1;
  #undef CMASK
  #define CMASK(P0,P1,t) do{}while(0)
  for(;t+5<NT;t+=2){
    STEP(pB0,pB1,pA0,pA1,t,true,true,true);     WAIT_BAR(2); RESC(); ROT();
    STEP(pA0,pA1,pB0,pB1,t+1,true,true,true);   WAIT_BAR(2); RESC(); ROT();
  }
  #undef CMASK
  #define CMASK(P0,P1,t) do{int jb_=(t)-(NT-4); if(jb_>=0)cmask(P0,P1,jb_,qrel,hi);}while(0)
  #define ENDW(tt) do{ if((tt)+3<NT){WAIT_BAR(2);} else if((tt)+2<NT){WAIT_BAR(1);} else {WAIT_BAR(0);} }while(0)
  for(;t+1<NT;t+=2){
    STEP(pB0,pB1,pA0,pA1,t,(t+3<NT),(t+1<NT),(t+1<NT));       ENDW(t);   RESC(); ROT();
    STEP(pA0,pA1,pB0,pB1,t+1,(t+4<NT),(t+2<NT),(t+2<NT));     ENDW(t+1); RESC(); ROT();
  }
  STEP(pB0,pB1,pA0,pA1,NT-1,false,false,false); RESC();
  { float sacc=pB0[0]+pB0[1]; _Pragma("unroll") for(int r=2;r<16;++r)sacc+=pB0[r]; _Pragma("unroll") for(int r=0;r<16;++r)sacc+=pB1[r]; l_reg+=sacc;
    pw0=(u32x4){PKW(pB0,0),PKW(pB0,2),PKW(pB0,4),PKW(pB0,6)};pw1=(u32x4){PKW(pB0,8),PKW(pB0,10),PKW(pB0,12),PKW(pB0,14)};pw2=(u32x4){PKW(pB1,0),PKW(pB1,2),PKW(pB1,4),PKW(pB1,6)};pw3=(u32x4){PKW(pB1,8),PKW(pB1,10),PKW(pB1,12),PKW(pB1,14)};
    SBAR(); pv(o,vb0+sl_cur,PAF(0),PAF(1),PAF(2),PAF(3)); }
  #undef PKW
  #undef PAF
  #undef VFR
  #undef PIN
  #undef MX3
  #undef GAPA
  #undef GAPB
  #undef EX
  #undef VRD
  #undef KRD
  #undef STEP
  #undef ENDW
  {auto rr=__builtin_amdgcn_permlane32_swap(__float_as_uint(l_reg),__float_as_uint(l_reg),false,false);l_reg=__uint_as_float(rr[0])+__uint_as_float(rr[1]);}
  if(hi==0)wsf[32+r32]=l_reg;asm volatile("s_waitcnt lgkmcnt(0)":::"memory");
  float rli[16];
  #pragma unroll
  for(int r=0;r<16;++r)rli[r]=__builtin_amdgcn_rcpf(wsf[32+crow(r,hi)]);
  bf16*Ow=O+(rowbase+q0+wid*QBLK)*OPITCH+h*D;
  { bf16*stg=(bf16*)(shm+LDS_OST)+wid*2048;
    #pragma unroll
    for(int r=0;r<16;++r){const int orow=crow(r,hi);
      #pragma unroll
      for(int d0=0;d0<2;++d0)stg[orow*64+d0*32+r32]=__float2bfloat16(o[d0][r]*rli[r]);}
    asm volatile("s_waitcnt lgkmcnt(0)":::"memory");
    #pragma unroll
    for(int i=0;i<4;++i){const int row=i*8+(lane>>3),ch=lane&7; const u32x4 v=*(const u32x4*)(stg+row*64+ch*8);
      float f[8]; f[0]=__uint_as_float(v.x<<16);f[1]=__uint_as_float(v.x&0xffff0000u);f[2]=__uint_as_float(v.y<<16);f[3]=__uint_as_float(v.y&0xffff0000u);
      f[4]=__uint_as_float(v.z<<16);f[5]=__uint_as_float(v.z&0xffff0000u);f[6]=__uint_as_float(v.w<<16);f[7]=__uint_as_float(v.w&0xffff0000u);
      float ss=0.f;
      #pragma unroll
      for(int j=0;j<8;++j)ss+=f[j]*f[j];
      ss+=__int_as_float(__builtin_amdgcn_ds_bpermute((lane^1)<<2,__float_as_int(ss)));ss+=__int_as_float(__builtin_amdgcn_ds_bpermute((lane^2)<<2,__float_as_int(ss)));ss+=__int_as_float(__builtin_amdgcn_ds_bpermute((lane^4)<<2,__float_as_int(ss)));
      const float rs=1.0f/sqrtf(ss*(1.0f/64.0f)+1e-6f);
      const f32x4v g0=*(const f32x4v*)(gfox+h*D+ch*8),g1=*(const f32x4v*)(gfox+h*D+ch*8+4);
      u32x4 w; w.x=cvtpk_s(f[0]*rs*g0[0],f[1]*rs*g0[1]); w.y=cvtpk_s(f[2]*rs*g0[2],f[3]*rs*g0[3]); w.z=cvtpk_s(f[4]*rs*g1[0],f[5]*rs*g1[1]); w.w=cvtpk_s(f[6]*rs*g1[2],f[7]*rs*g1[3]);
      ATTN_STORE16(Ow+(long)row*OPITCH+ch*8,w);} }
  asm volatile("s_waitcnt lgkmcnt(0)\n\ts_barrier":::"memory");
  #undef DMA_K
  #undef DMA_V
  #undef CMASK
  #undef FBIAS
  #undef CINIT
  #undef START
  #undef RESC
  #undef ROT
}
constexpr int ATTN_LDS_BYTES=LDS_BYTES;
#undef SBAR
#undef WAIT_BAR
}
#include <hip/hip_cooperative_groups.h>
namespace cg = cooperative_groups;
constexpr int NWAVES = 8, NTHR = 512;
constexpr int BATCH = 16, SEQ = 4096, DM = 1024, FF = 4096, M = BATCH * SEQ, PLE = 256, NZ = 3840, WIN_LD = 3600;
constexpr float EPS = 1e-6f;
constexpr size_t MiB = 1u << 20;
constexpr size_t WS_CTL = 0, CTL_BYTES = 65536;
constexpr size_t WS_WIN = 2 * MiB, WS_WOUT = 10 * MiB, WS_WUP = 12 * MiB, WS_WDN = 20 * MiB, WS_WPG = 28 * MiB, WS_WPLE = 30 * MiB;
constexpr size_t WS_XN = 32 * MiB;
constexpr size_t WS_Z = 160 * MiB;
constexpr size_t WS_QC = 544 * MiB, WS_KC = 608 * MiB;
constexpr size_t WS_H = 160 * MiB;
constexpr size_t WS_MO = 672 * MiB, WS_MIX = 736 * MiB, WS_G = 864 * MiB, WS_PB = 868 * MiB, WS_RSTD = 900 * MiB, WS_RSI = 900 * MiB + 512 * 1024, WS_SSP = 901 * MiB, WS_CBG = 906 * MiB, WS_QKB = 908 * MiB, WS_SSP2 = 909 * MiB, WS_SSP3 = 913 * MiB, WS_END = 917 * MiB;
constexpr int RING_BYTES = 131072, LDS_TOTAL = 147456;
#define LAS __attribute__((address_space(3)))
typedef unsigned short bf16;
typedef unsigned v4u __attribute__((ext_vector_type(4)));
typedef unsigned v2u __attribute__((ext_vector_type(2)));
typedef float f32x4 __attribute__((ext_vector_type(4)));
typedef float f32x2 __attribute__((ext_vector_type(2)));
typedef float f32x2_c __attribute__((ext_vector_type(2))); typedef __bf16 bf16x2_c __attribute__((ext_vector_type(2)));
__device__ __forceinline__ unsigned pk2(float lo, float hi) { const f32x2_c v = {lo, hi}; return __builtin_bit_cast(unsigned, __builtin_convertvector(v, bf16x2_c)); }
__device__ __forceinline__ unsigned f2bf(float f) { return pk2(f, 0.f) & 0xffffu; }
__device__ __forceinline__ float bflo(unsigned w) { return __uint_as_float(w << 16); }
__device__ __forceinline__ float bfhi(unsigned w) { return __uint_as_float(w & 0xffff0000u); }
__device__ __forceinline__ float xsig(float x, float y) { return x * __builtin_amdgcn_rcpf(1.f + __expf(-y)); }
__device__ __forceinline__ float shx(float v, int o, int lane) { return __int_as_float(__builtin_amdgcn_ds_bpermute((lane ^ o) << 2, __float_as_int(v))); }
__device__ __forceinline__ float shu(float v, int o, int lane) { return __int_as_float(__builtin_amdgcn_ds_bpermute((lane - o) << 2, __float_as_int(v))); }
__device__ __forceinline__ float shl(float v, int src) { return __int_as_float(__builtin_amdgcn_ds_bpermute(src << 2, __float_as_int(v))); }
__device__ __forceinline__ float wave_sum(float v, int lane) {
#pragma unroll
    for (int o = 1; o < 64; o <<= 1) v += shx(v, o, lane);
    return v;
}
__device__ __forceinline__ void block_seam() {
    asm volatile("s_waitcnt vmcnt(0) lgkmcnt(0)" ::: "memory");
    __syncthreads();
    __builtin_amdgcn_fence(__ATOMIC_ACQUIRE, "agent");
    asm volatile("s_waitcnt vmcnt(0)" ::: "memory");
}
__device__ __forceinline__ void p0_transpose_item(const float* W, int ldw, int ncols, int K, bf16* WT, int row_off, const float* gain, LAS float* scr, int item, int lane) {
    const int nblk = ncols / 32, kb = item / nblk, nb = item % nblk, k0 = 64 * kb, n0 = 32 * nb;
#pragma unroll 16
    for (int i = 0; i < 32; ++i) { const int kk = 2 * i + (lane >> 5); float v = W[(size_t)(k0 + kk) * ldw + n0 + (lane & 31)]; if (gain) v *= gain[k0 + kk]; scr[kk * 33 + (lane & 31)] = v; }
    asm volatile("s_waitcnt lgkmcnt(0)" ::: "memory");
    const int c = lane & 7;
#pragma unroll
    for (int j = 0; j < 4; ++j) { const int n = (lane >> 3) + 8 * j; const LAS float* s = scr + (8 * c) * 33 + n;
        v4u o; o.x = pk2(s[0 * 33], s[1 * 33]); o.y = pk2(s[2 * 33], s[3 * 33]); o.z = pk2(s[4 * 33], s[5 * 33]); o.w = pk2(s[6 * 33], s[7 * 33]);
        *(v4u*)(WT + (size_t)(row_off + n0 + n) * K + k0 + 8 * c) = o; }
    asm volatile("s_waitcnt lgkmcnt(0)" ::: "memory");
}
__device__ __forceinline__ int gate_src_col(int j) { return j < 8 ? 1536 + j : (j < 12 ? 3080 + (j - 8) : 3084 + (j - 12)); }

template <class T> __device__ __forceinline__ T* opq(T* p) { asm volatile("" : "+s"(p)); return p; }
typedef __attribute__((address_space(1))) unsigned gu32;
#define RLX_AGENT __ATOMIC_RELAXED, __HIP_MEMORY_SCOPE_AGENT
#define XB_TMO      128
#define XB_XCNT(j)  (256  + 64 * (j))
#define XB_XSUB(j)  (1280 + 64 * (j))
#define XB_XGEN(j)  (2304 + 64 * (j))
#define XB_TOP      3328
#define XB_TOPGEN   3392
#define XCD_BAR_WORDS 3456
#define XB_SPIN_CAP (1u << 18)

__device__ __forceinline__ unsigned xb_ld(unsigned* p)              { return __hip_atomic_load(p, __ATOMIC_RELAXED, __HIP_MEMORY_SCOPE_AGENT); }
__device__ __forceinline__ unsigned xb_add(unsigned* p, unsigned v) { return __hip_atomic_fetch_add(p, v, __ATOMIC_RELAXED, __HIP_MEMORY_SCOPE_AGENT); }
__device__ __forceinline__ unsigned xb_xcc_id() { return (unsigned)__builtin_amdgcn_s_getreg((3 << 11) | 20) & 0xFu; }
#define XB_SPIN(cond, bar) do { unsigned _sp = 0; while (cond) { __builtin_amdgcn_s_sleep(1); \
    if ((++_sp & 255u) == 0u) { if (xb_ld(&(bar)[XB_TMO])) break; if (_sp > XB_SPIN_CAP) { atomicAdd(&(bar)[XB_TMO], 1u); break; } } } } while (0)

struct XcdBarrier {
    unsigned* bar; unsigned x;
    volatile LAS unsigned* st;
};

__device__ __forceinline__ XcdBarrier xcd_barrier_make(unsigned* bar, volatile LAS unsigned* st) { XcdBarrier b; b.bar = bar; b.x = xb_xcc_id(); b.st = st; return b; }
__device__ __forceinline__ void xcd_barrier_post(const XcdBarrier& b, bool t0) { if (t0) (void)xb_add(&b.bar[XB_XCNT(b.x)], 1u); }
__device__ __forceinline__ void xcd_barrier_complete(unsigned* bar, unsigned x, unsigned& nloc, unsigned& nx) {
    const unsigned G = gridDim.x * gridDim.y * gridDim.z;
    unsigned sum, cnt, mine, sp = 0u;
    for (;;) {
        sum = 0u; cnt = 0u; mine = 0u;
#pragma unroll
        for (unsigned j = 0; j < 16; ++j) { const unsigned c = xb_ld(&bar[XB_XCNT(j)]); sum += c; cnt += (c > 0u) ? 1u : 0u; mine = (j == x) ? c : mine; }
        if (sum == G) break;
        __builtin_amdgcn_s_sleep(1);
        if ((++sp & 255u) == 0u) { if (xb_ld(&bar[XB_TMO])) break; if (sp > XB_SPIN_CAP) { atomicAdd(&bar[XB_TMO], 1u); break; } }
    }
    nloc = mine > 0u ? mine : 1u; nx = cnt > 0u ? cnt : 1u;
}

__device__ __forceinline__ void xcd_barrier(const XcdBarrier& b, bool t0) {
    asm volatile("s_waitcnt vmcnt(0)" ::: "memory");
    __syncthreads();
    if (t0) {
        unsigned* bar = b.bar;
        __builtin_amdgcn_s_waitcnt(0);
        unsigned nloc = b.st[0], nx = b.st[1];
        if (nloc == 0u) { xcd_barrier_complete(bar, b.x, nloc, nx); b.st[0] = nloc; b.st[1] = nx; }
        const unsigned old = xb_add(&bar[XB_XSUB(b.x)], 1u);
        const unsigned gen = old / nloc;
        if (old + 1u == (gen + 1u) * nloc) {
            __builtin_amdgcn_fence(__ATOMIC_RELEASE, "agent");
            asm volatile("s_waitcnt vmcnt(0)" ::: "memory");
            const unsigned og = xb_add(&bar[XB_TOP], 1u);
            const unsigned tg = og / nx;
            if (og + 1u == (tg + 1u) * nx) xb_add(&bar[XB_TOPGEN], 1u);
            else XB_SPIN(xb_ld(&bar[XB_TOPGEN]) == tg, bar);
            __builtin_amdgcn_fence(__ATOMIC_ACQUIRE, "agent");
            xb_add(&bar[XB_XGEN(b.x)], 1u);
            asm volatile("s_waitcnt vmcnt(0)" ::: "memory");
        } else {
            XB_SPIN(xb_ld(&bar[XB_XGEN(b.x)]) == gen, bar);
            __builtin_amdgcn_fence(__ATOMIC_ACQUIRE, "agent");
            asm volatile("s_waitcnt vmcnt(0)" ::: "memory");
        }
    }
    __syncthreads();
}
struct Args { const float* in[18]; float* out; unsigned char* ws; };

__device__ __forceinline__ void p0_prologue(const Args& A, unsigned char* ws, LAS unsigned char* lds, int tid, int lane, int wave, int bx, int G) {
    LAS float* scr = (LAS float*)(lds + wave * 16384);
    const int gw = bx * NWAVES + wave, NGW = G * NWAVES;
    const float* w_in = A.in[2];
    bf16* WinT = (bf16*)(ws + WS_WIN); bf16* WoutT = (bf16*)(ws + WS_WOUT); bf16* WupT = (bf16*)(ws + WS_WUP); bf16* WdnT = (bf16*)(ws + WS_WDN); bf16* WpgT = (bf16*)(ws + WS_WPG); bf16* WpleT = (bf16*)(ws + WS_WPLE);
    constexpr int I_SEG = 16 * 16, I_IN = 7 * I_SEG, I_OUT = 16 * 32, I_UP = 16 * 128, I_DN = 64 * 32, I_PG = 16 * 32, I_PLE = 4 * 32;
    constexpr int NITEMS = I_IN + I_OUT + I_UP + I_DN + I_PG + I_PLE;
    for (int it = gw; it < NITEMS; it += NGW) {
        int r = it;
        if (r < I_IN) { const int s = r / I_SEG; const int srcc = (s == 0) ? 0 : (s == 1) ? 512 : (s == 2) ? 1024 : (s == 3) ? 1544 : (s == 4) ? 2056 : (s == 5) ? 2568 : 3088;
            p0_transpose_item(w_in + srcc, WIN_LD, 512, DM, WinT, 512 * s, A.in[7]  , scr, r % I_SEG, lane); continue; } r -= I_IN;
        if (r < I_OUT) { p0_transpose_item(A.in[10], DM, DM, DM, WoutT, 0, nullptr, scr, r, lane); continue; } r -= I_OUT;
        if (r < I_UP) { p0_transpose_item(A.in[12], FF, FF, DM, WupT, 0, A.in[11], scr, r, lane); continue; } r -= I_UP;
        if (r < I_DN) { p0_transpose_item(A.in[13], DM, DM, FF, WdnT, 0, nullptr, scr, r, lane); continue; } r -= I_DN;
        if (r < I_PG) { p0_transpose_item(A.in[16], DM, DM, DM, WpgT, 0, A.in[15], scr, r, lane); continue; } r -= I_PG;
        p0_transpose_item(A.in[14], DM, DM, PLE, WpleT, 0, nullptr, scr, r, lane);
    }
    const int gt = bx * NTHR + tid, NGT = G * NTHR;
    for (int i = gt; i < 16 * DM; i += NGT) { const int j = i >> 10, k = i & 1023; WinT[(size_t)(3584 + j) * DM + k] = (bf16)f2bf(w_in[(size_t)k * WIN_LD + gate_src_col(j)] * A.in[7][k]); }
    for (int i = gt; i < 240 * DM / 8; i += NGT) ((v4u*)(WinT + (size_t)3600 * DM))[i] = (v4u){0u, 0u, 0u, 0u};
    { const f32x4* p4 = (const f32x4*)A.in[1]; v4u* pb = (v4u*)(ws + WS_PB);
#pragma unroll 4
      for (int i = gt; i < M * PLE / 8; i += NGT) { const f32x4 a = p4[2 * i], b = p4[2 * i + 1]; pb[i] = (v4u){pk2(a[0], a[1]), pk2(a[2], a[3]), pk2(b[0], b[1]), pk2(b[2], b[3])}; } }
    { const float* x = A.in[0]; bf16* XN = (bf16*)(ws + WS_XN);
#pragma unroll 2
      for (int m = gw; m < M; m += NGW) {
          const f32x4* xr = (const f32x4*)(x + (size_t)m * DM) + lane; f32x4 v[4]; float s = 0.f;
#pragma unroll
          for (int j = 0; j < 4; ++j) { v[j] = xr[64 * j]; s += (v[j][0] * v[j][0] + v[j][1] * v[j][1]) + (v[j][2] * v[j][2] + v[j][3] * v[j][3]); }
          const float ms_ = wave_sum(s, lane) * (1.f / DM) + EPS; const float rstd = 1.0f / sqrtf(ms_);
          if (lane == 0) ((float*)(ws + WS_RSI))[m] = sqrtf(ms_);
          v2u* o8 = (v2u*)(XN + (size_t)m * DM) + lane;
#pragma unroll
          for (int j = 0; j < 4; ++j) { const f32x4 y = v[j] * rstd; o8[64 * j] = (v2u){pk2(y[0], y[1]), pk2(y[2], y[3])}; }
      } }
}

__device__ __forceinline__ void conv_silu_phase(const float* w_conv, const bf16* MQ, const bf16* MK, bf16* QC, bf16* KC, int it_begin, int it_end, int NGT) {
    for (int it = it_begin; it < it_end; it += NGT) {
        const int cgi = it & 63, rb = (it >> 6) & (M / 32 - 1), ten = it >> 17;
        const bf16* src = (ten ? MK : MQ) + cgi * 8; bf16* dst = (ten ? KC : QC) + cgi * 8;
        const float osc = ten ? 0.08838834764831845f : 1.0f;
        float w[4][8];
#pragma unroll
        for (int j = 0; j < 4; ++j) { const f32x4 a = *(const f32x4*)(w_conv + j * 1024 + ten * 512 + cgi * 8), b = *(const f32x4*)(w_conv + j * 1024 + ten * 512 + cgi * 8 + 4);
            w[j][0] = a[0]; w[j][1] = a[1]; w[j][2] = a[2]; w[j][3] = a[3]; w[j][4] = b[0]; w[j][5] = b[1]; w[j][6] = b[2]; w[j][7] = b[3]; }
        const int t0 = rb * 32; const bool first = (t0 % SEQ) == 0;
        float h0[8], h1[8], h2[8];
#pragma unroll
        for (int i = 0; i < 8; ++i) { h0[i] = 0.f; h1[i] = 0.f; h2[i] = 0.f; }
        if (!first) {
            const v4u a = *(const v4u*)(src + (size_t)(t0 - 3) * 512), b = *(const v4u*)(src + (size_t)(t0 - 2) * 512), c = *(const v4u*)(src + (size_t)(t0 - 1) * 512);
#pragma unroll
            for (int i = 0; i < 4; ++i) { h0[2 * i] = bflo(a[i]); h0[2 * i + 1] = bfhi(a[i]); h1[2 * i] = bflo(b[i]); h1[2 * i + 1] = bfhi(b[i]); h2[2 * i] = bflo(c[i]); h2[2 * i + 1] = bfhi(c[i]); }
        }
#pragma unroll 8
        for (int r = 0; r < 32; ++r) {
            const v4u cu = *(const v4u*)(src + (size_t)(t0 + r) * 512); float c[8], o[8];
#pragma unroll
            for (int i = 0; i < 4; ++i) { c[2 * i] = bflo(cu[i]); c[2 * i + 1] = bfhi(cu[i]); }
#pragma unroll
            for (int i = 0; i < 8; ++i) { const float y = w[0][i] * h0[i] + w[1][i] * h1[i] + w[2][i] * h2[i] + w[3][i] * c[i];
                o[i] = osc * xsig(y, y); h0[i] = h1[i]; h1[i] = h2[i]; h2[i] = c[i]; }
            *(v4u*)(dst + (size_t)(t0 + r) * 512) = (v4u){pk2(o[0], o[1]), pk2(o[2], o[3]), pk2(o[4], o[5]), pk2(o[6], o[7])};
        }
    }
}

__device__ __forceinline__ void fox_cumsum(LAS float* CB, LAS float* red, const float* Gt, float bias, int b, int h, int tid, int lane, int wave) {
    float v[8]; const float* base = Gt + ((size_t)b * SEQ + tid * 8) * 16 + h;
#pragma unroll
    for (int i = 0; i < 8; ++i) { const float z = base[i * 16] + bias; v[i] = (fminf(z, 0.f) - log1pf(expf(-fabsf(z)))) * 1.4426950408889634f; }
#pragma unroll
    for (int i = 1; i < 8; ++i) v[i] += v[i - 1];
    const float tot = v[7]; float sc = tot;
#pragma unroll
    for (int o = 1; o < 64; o <<= 1) { const float n = shu(sc, o, lane); if (lane >= o) sc += n; }
    if (lane == 63) red[wave] = sc;
    __syncthreads();
    float off = sc - tot;
    for (int w = 0; w < wave; ++w) off += red[w];
#pragma unroll
    for (int i = 0; i < 8; ++i) CB[tid * 8 + i] = v[i] + off;
    __syncthreads();
}

__device__ __forceinline__ float fox_row_stats(LAS float* red, LAS float* QN, LAS float* DD, const bf16* FQ, const bf16* FK, int b, int h, int tid, int lane, int wave) {
    float mk = 0.f;
    for (int r = tid; r < SEQ; r += NTHR) { const v4u* qp = (const v4u*)(FQ + ((size_t)b * SEQ + r) * 512 + h * 64); const v4u* kp = (const v4u*)(FK + ((size_t)b * SEQ + r) * 512 + h * 64); float sq = 0.f, sk = 0.f, dd = 0.f;
#pragma unroll
        for (int j = 0; j < 8; ++j) { const v4u a = qp[j], c = kp[j];
#pragma unroll
            for (int i = 0; i < 4; ++i) { const float q0 = bflo(a[i]), q1 = bfhi(a[i]), k0 = bflo(c[i]), k1 = bfhi(c[i]); sq += q0 * q0 + q1 * q1; sk += k0 * k0 + k1 * k1; dd += q0 * k0 + q1 * k1; } }
        QN[r] = sqrtf(sq); DD[r] = dd; mk = fmaxf(mk, sk); }
#pragma unroll
    for (int o = 1; o < 64; o <<= 1) mk = fmaxf(mk, shx(mk, o, lane));
    __syncthreads();
    if (lane == 0) red[wave] = mk;
    __syncthreads();
    float c = 0.f;
    for (int w = 0; w < NWAVES; ++w) c = fmaxf(c, red[w]);
    __syncthreads();
    return sqrtf(c);
}

namespace ml {
typedef short bf16x8 __attribute__((ext_vector_type(8)));
typedef short v4i16_t __attribute__((ext_vector_type(4)));
constexpr int PK = 288, PC = 288, NEB = 9, NITEMS = BATCH * 4;
constexpr int L_K = 0, L_V = 36864, L_CT = 73728, L_U = L_CT + 144 * PC, L_MT = L_U + 512, L_BT = L_MT + 512, L_WK = L_BT + 512, L_G = L_WK + 512, L_END = L_G + 512;
static_assert(L_END <= 131072, "mLSTM LDS map");
__device__ __forceinline__ float logsig(float z) { return fminf(z, 0.f) - log1pf(__expf(-fabsf(z))); }
__device__ __forceinline__ bf16x8 cat8(v2u lo, v2u hi) { const v4u w = (v4u){lo.x, lo.y, hi.x, hi.y}; return __builtin_bit_cast(bf16x8, w); }
__device__ __forceinline__ v2u vtr(LAS unsigned char* p) { return __builtin_bit_cast(v2u, __builtin_amdgcn_ds_read_tr16_b64_v4i16((LAS v4i16_t*)p)); }
#define ML_MFMA(a, b, c) __builtin_amdgcn_mfma_f32_16x16x32_bf16((a), (b), (c), 0, 0, 0)
__device__ __forceinline__ void mlstm_item(int item, const bf16* QC, const bf16* KC, const bf16* MV, const bf16* MO, const float* Gt, const float* b_i, const float* b_f, const float* gout, bf16* MIX, LAS unsigned char* L, int tid, int lane, int wave) {
    const int hd = item & 3, b = item >> 2;
    const int hcol = hd * 128;
    const float bi = b_i[hd], bff = b_f[hd];
    const int j16 = lane & 15, kq = lane >> 4, q4 = j16 >> 2, p4 = j16 & 3;
    const int tb = (wave < 4) ? wave : 11 - wave, t = 16 * tb + j16, gmax = tb >> 1;
    unsigned rowb = (unsigned)(j16 * PK + kq * 16), trb = (unsigned)((4 * kq + q4) * PK + p4 * 8), trk = trb + 32u * (unsigned)wave, ub4 = (unsigned)(kq * 16),
             cwb = (unsigned)(4 * kq * PC + (16 * wave + j16) * 2), stb = (unsigned)((tid >> 4) * PK + (tid & 15) * 16), ulb = (unsigned)(8 * lane), tlb = (unsigned)(4 * t);
    asm volatile("" : "+v"(rowb), "+v"(trb), "+v"(trk), "+v"(ub4), "+v"(cwb), "+v"(stb), "+v"(ulb), "+v"(tlb));
    __syncthreads();
    for (int i = tid; i < 144 * PC / 4; i += NTHR) ((LAS unsigned*)(L + L_CT))[i] = 0u;
    for (int i = tid; i < 128 * 8; i += NTHR) ((LAS unsigned*)(L + L_V + (i >> 3) * PK + 256))[i & 7] = ((i & 7) == 0) ? 0x00003F80u : 0u;
    if (tid < 128) *(LAS float*)(L + L_G + 4 * tid) = gout[hcol + tid];
    f32x4 Cacc[NEB];
#pragma unroll
    for (int eb = 0; eb < NEB; ++eb) Cacc[eb] = (f32x4){0.f, 0.f, 0.f, 0.f};
    float m_prev = 0.f;
    v4u kreg[4], vreg[4]; bf16x8 qreg[4]; float gi0, gi1, gf0, gf1, hi0, hi1, hf0, hf1;
#define ML_GATES(cc, a0, a1, c0, c1) do { const float* g0_ = Gt + ((size_t)b * SEQ + (size_t)(cc) * 128 + 2 * lane) * 16; a0 = g0_[8 + hd]; a1 = g0_[24 + hd]; c0 = g0_[12 + hd]; c1 = g0_[28 + hd]; } while (0)
#define ML_LOAD(cc) do { const size_t r0_ = (size_t)b * SEQ + (size_t)(cc) * 128; \
        _Pragma("unroll") for (int j = 0; j < 4; ++j) { const int id = tid + NTHR * j, r = id >> 4, c16 = id & 15; kreg[j] = *(const v4u*)(KC + (r0_ + r) * 512 + hcol + c16 * 8); vreg[j] = *(const v4u*)(MV + (r0_ + r) * 512 + hcol + c16 * 8); } \
        _Pragma("unroll") for (int ks = 0; ks < 4; ++ks) qreg[ks] = *(const bf16x8*)(QC + (r0_ + t) * 512 + hcol + 32 * ks + 8 * kq); } while (0)
    ML_GATES(0, gi0, gi1, gf0, gf1); ML_GATES(1, hi0, hi1, hf0, hf1);
    ML_LOAD(0);
    float u0, u1, M0, M1, b0, b1, Mlast, bL;
#define ML_SCALARS(mp) do { const float i0_ = gi0 + bi, i1_ = gi1 + bi; const float f0_ = logsig(gf0 + bff), f1_ = logsig(gf1 + bff); \
        b0 = f0_; b1 = f0_ + f1_; \
        { float sc = b1; _Pragma("unroll") for (int o = 1; o < 64; o <<= 1) { const float n = shu(sc, o, lane); if (lane >= o) sc += n; } const float off = sc - b1; b0 += off; b1 += off; } \
        u0 = i0_ - b0; u1 = i1_ - b1; \
        float c0_ = u0, c1_ = fmaxf(u0, u1); \
        { float pm = c1_; _Pragma("unroll") for (int o = 1; o < 64; o <<= 1) { const float n = shu(pm, o, lane); if (lane >= o) pm = fmaxf(pm, n); } \
          float prev = shu(pm, 1, lane); if (lane == 0) prev = -INFINITY; c0_ = fmaxf(c0_, prev); c1_ = fmaxf(c1_, prev); } \
        M0 = fmaxf((mp), c0_); M1 = fmaxf((mp), c1_); Mlast = shl(M1, 63); bL = shl(b1, 63); } while (0)
    ML_SCALARS(m_prev);
    gi0 = hi0; gi1 = hi1; gf0 = hf0; gf1 = hf1;
    for (int c = 0; c < SEQ / 128; ++c) {
        const size_t row0 = (size_t)b * SEQ + (size_t)c * 128;
        if (wave == 0) { *(LAS f32x2*)(L + L_U + ulb) = (f32x2){u0, u1}; *(LAS f32x2*)(L + L_MT + ulb) = (f32x2){M0, M1}; *(LAS f32x2*)(L + L_BT + ulb) = (f32x2){b0, b1};
                         *(LAS f32x2*)(L + L_WK + ulb) = (f32x2){__expf(u0 - Mlast), __expf(u1 - Mlast)}; }
        const float Mlast_c = Mlast, m_next = bL + Mlast;
#pragma unroll
        for (int j = 0; j < 4; ++j) { *(LAS v4u*)(L + L_K + stb + 32 * j * PK) = kreg[j]; *(LAS v4u*)(L + L_V + stb + 32 * j * PK) = vreg[j]; }
        bf16x8 qf[4]; v2u mo[8];
#pragma unroll
        for (int ks = 0; ks < 4; ++ks) qf[ks] = qreg[ks];
        __syncthreads();
        if (c + 1 < SEQ / 128) ML_LOAD(c + 1);
        { const int c2 = (c + 2 < SEQ / 128) ? c + 2 : SEQ / 128 - 1; ML_GATES(c2, hi0, hi1, hf0, hf1); }
        ML_SCALARS(m_next);
        gi0 = hi0; gi1 = hi1; gf0 = hf0; gf1 = hf1;
#pragma unroll
        for (int eb = 0; eb < 8; ++eb) mo[eb] = *(const v2u*)(MO + (row0 + t) * 512 + hcol + 16 * eb + 4 * kq);
        const float Mt = *(const LAS float*)(L + L_MT + tlb), bt = *(const LAS float*)(L + L_BT + tlb);
        const float winter = __expf(m_prev - Mt), thr = __expf(-(bt + Mt));
        f32x4 acc[NEB];
#pragma unroll
        for (int eb = 0; eb < NEB; ++eb) { f32x4 a4 = (f32x4){0.f, 0.f, 0.f, 0.f};
#pragma unroll
            for (int ks = 0; ks < 4; ++ks) { const bf16x8 a = *(const LAS bf16x8*)(L + L_CT + rowb + (16 * eb * PC + 64 * ks)); a4 = ML_MFMA(a, qf[ks], a4); }
            acc[eb] = a4 * winter; }
        { const float decay = __expf(m_prev - Mlast_c);
#pragma unroll
          for (int eb = 0; eb < NEB; ++eb) Cacc[eb] = Cacc[eb] * decay; }
#pragma unroll
        for (int g = 0; g < 4; ++g) {
            bf16x8 pf; const bool live = (g <= gmax);
            if (live) {
                f32x4 s0 = (f32x4){0.f, 0.f, 0.f, 0.f}, s1 = s0;
#pragma unroll
                for (int ks = 0; ks < 4; ++ks) { const bf16x8 a0 = *(const LAS bf16x8*)(L + L_K + rowb + (32 * g * PK + 64 * ks)), a1 = *(const LAS bf16x8*)(L + L_K + rowb + ((32 * g + 16) * PK + 64 * ks));
                    s0 = ML_MFMA(a0, qf[ks], s0); s1 = ML_MFMA(a1, qf[ks], s1); }
                const f32x4 ua = *(const LAS f32x4*)(L + L_U + ub4 + 128 * g), ub = *(const LAS f32x4*)(L + L_U + ub4 + 128 * g + 64);
                float p[8];
#pragma unroll
                for (int i = 0; i < 4; ++i) { const int sa = 32 * g + 4 * kq + i;
                    p[i] = (sa <= t) ? s0[i] * __expf(ua[i] - Mt) : 0.f; p[4 + i] = (sa + 16 <= t) ? s1[i] * __expf(ub[i] - Mt) : 0.f; }
                const v4u pw = (v4u){pk2(p[0], p[1]), pk2(p[2], p[3]), pk2(p[4], p[5]), pk2(p[6], p[7])};
                pf = __builtin_bit_cast(bf16x8, pw);
            }
            bf16x8 bfr;
            { LAS unsigned char* kp = L + L_K + trk + 32 * g * PK;
              const v2u klo = vtr(kp), khi = vtr(kp + 16 * PK);
              const f32x4 wa = *(const LAS f32x4*)(L + L_WK + ub4 + 128 * g), wb = *(const LAS f32x4*)(L + L_WK + ub4 + 128 * g + 64);
              const v4u kw = (v4u){pk2(bflo(klo.x) * wa[0], bfhi(klo.x) * wa[1]), pk2(bflo(klo.y) * wa[2], bfhi(klo.y) * wa[3]), pk2(bflo(khi.x) * wb[0], bfhi(khi.x) * wb[1]), pk2(bflo(khi.y) * wb[2], bfhi(khi.y) * wb[3])};
              bfr = __builtin_bit_cast(bf16x8, kw); }
#pragma unroll
            for (int e0 = 0; e0 < NEB; e0 += 3) {
                bf16x8 af[3];
#pragma unroll
                for (int k = 0; k < 3; ++k) { LAS unsigned char* vp = L + L_V + trb + (32 * g * PK + 32 * (e0 + k)); af[k] = cat8(vtr(vp), vtr(vp + 16 * PK)); }
                if (live) {
#pragma unroll
                    for (int k = 0; k < 3; ++k) acc[e0 + k] = ML_MFMA(af[k], pf, acc[e0 + k]); }
#pragma unroll
                for (int k = 0; k < 3; ++k) Cacc[e0 + k] = ML_MFMA(af[k], bfr, Cacc[e0 + k]);
            }
        }
        { const float den = shl(acc[8][0], j16); const float inv = __builtin_amdgcn_rcpf(fmaxf(fabsf(den), thr));
          float ss = 0.f;
#pragma unroll
          for (int eb = 0; eb < 8; ++eb) { acc[eb] = acc[eb] * inv; ss += (acc[eb][0] * acc[eb][0] + acc[eb][1] * acc[eb][1]) + (acc[eb][2] * acc[eb][2] + acc[eb][3] * acc[eb][3]); }
          ss += shx(ss, 16, lane); ss += shx(ss, 32, lane);
          const float rs = __builtin_amdgcn_rsqf(ss * (1.f / 128.f) + EPS);
          bf16* op = MIX + (row0 + t) * 1024 + 512 + hcol + 4 * kq;
#pragma unroll
          for (int eb = 0; eb < 8; ++eb) { const f32x4 h = acc[eb] * rs * *(const LAS f32x4*)(L + L_G + ub4 + 64 * eb); const v2u m2 = mo[eb];
              const float o0 = xsig(h[0], bflo(m2.x)), o1 = xsig(h[1], bfhi(m2.x)), o2 = xsig(h[2], bflo(m2.y)), o3 = xsig(h[3], bfhi(m2.y));
              *(v2u*)(op + 16 * eb) = (v2u){pk2(o0, o1), pk2(o2, o3)}; } }
        __syncthreads();
#pragma unroll
        for (int eb = 0; eb < NEB; ++eb) { const unsigned w01 = pk2(Cacc[eb][0], Cacc[eb][1]), w23 = pk2(Cacc[eb][2], Cacc[eb][3]);
            *(LAS unsigned short*)(L + L_CT + cwb + (16 * eb + 0) * PC) = (unsigned short)(w01 & 0xffffu); *(LAS unsigned short*)(L + L_CT + cwb + (16 * eb + 1) * PC) = (unsigned short)(w01 >> 16);
            *(LAS unsigned short*)(L + L_CT + cwb + (16 * eb + 2) * PC) = (unsigned short)(w23 & 0xffffu); *(LAS unsigned short*)(L + L_CT + cwb + (16 * eb + 3) * PC) = (unsigned short)(w23 >> 16); }
        m_prev = m_next;
    }
}
#undef ML_MFMA
#undef ML_LOAD
#undef ML_GATES
#undef ML_SCALARS
}
__device__ __forceinline__ void panel_rstd(int row0, int nrows, const float* SSP, float* RSTD, int tid) {
    for (int rr = tid; rr < nrows; rr += NTHR) { const int row = row0 + rr; const f32x4* p = (const f32x4*)(SSP + (size_t)row * 16); const f32x4 a = p[0], b = p[1], c = p[2], d = p[3];
        const float s = (((a[0] + a[1]) + (a[2] + a[3])) + ((b[0] + b[1]) + (b[2] + b[3]))) + (((c[0] + c[1]) + (c[2] + c[3])) + ((d[0] + d[1]) + (d[2] + d[3])));
        RSTD[row] = 1.0f / sqrtf(s * (1.f / DM) + EPS); }
}
__device__ __forceinline__ void panel_final_norm(int pm, const bf16* XB, int xpitch, const float* RSTD, const float* g, float* out, int lane, int wave) {
    const f32x4* g4 = (const f32x4*)g;
#pragma unroll 4
    for (int i = wave; i < 256; i += NWAVES) { const int row = pm * 256 + i; const float rs = RSTD[row];
#pragma unroll
        for (int j = 0; j < 2; ++j) { const v4u w = *((const v4u*)(XB + (size_t)row * xpitch) + lane + 64 * j); const f32x4 ga = g4[2 * (lane + 64 * j)], gb = g4[2 * (lane + 64 * j) + 1];
            f32x4* o = (f32x4*)(out + (size_t)row * DM) + 2 * (lane + 64 * j);
            o[0] = (f32x4){bflo(w.x) * rs * ga[0], bfhi(w.x) * rs * ga[1], bflo(w.y) * rs * ga[2], bfhi(w.y) * rs * ga[3]};
            o[1] = (f32x4){bflo(w.z) * rs * gb[0], bfhi(w.z) * rs * gb[1], bflo(w.w) * rs * gb[2], bfhi(w.w) * rs * gb[3]}; } }
}

__device__ __forceinline__ void group_barrier(unsigned* cnt, unsigned want, bool t0) {
    asm volatile("s_waitcnt vmcnt(0) lgkmcnt(0)" ::: "memory");
    __syncthreads();
    if (t0) {
        __builtin_amdgcn_fence(__ATOMIC_RELEASE, "agent");
        asm volatile("s_waitcnt vmcnt(0)" ::: "memory");
        __hip_atomic_fetch_add(cnt, 1u, __ATOMIC_RELAXED, __HIP_MEMORY_SCOPE_AGENT);
        unsigned sp = 0;
        while (__hip_atomic_load(cnt, __ATOMIC_RELAXED, __HIP_MEMORY_SCOPE_AGENT) < want) { __builtin_amdgcn_s_sleep(1); if (++sp > (1u << 24)) break; }
        __builtin_amdgcn_fence(__ATOMIC_ACQUIRE, "agent");
        asm volatile("s_waitcnt vmcnt(0)" ::: "memory");
    }
    __syncthreads();
    __builtin_amdgcn_fence(__ATOMIC_ACQUIRE, "agent");
    asm volatile("s_waitcnt vmcnt(0)" ::: "memory");
}
#if defined(PROBE_DUP) && PROBE_DUP == 3
#define PROBE_ML_REP 2
#else
#define PROBE_ML_REP 1
#endif
typedef const __attribute__((address_space(4))) Args* ArgsP;
__global__ void __launch_bounds__(NTHR, 2) hymba_fwd(Args args_unused) {
    extern __shared__ __attribute__((aligned(16))) unsigned char lds[];
    cg::grid_group grid = cg::this_grid();
    LAS unsigned char* L = (LAS unsigned char*)lds;
    const int wave0 = __builtin_amdgcn_readfirstlane((int)threadIdx.x >> 6);
    const int G = gridDim.x, bx = blockIdx.x;
#define ARGP() ArgsP ap = (ArgsP)__builtin_amdgcn_kernarg_segment_ptr(); asm volatile("" : "+s"(ap)); unsigned char* ws = ap->ws; (void)ws
#define FRESH_TID() int tid_; asm volatile("v_mbcnt_lo_u32_b32 %0, -1, 0\n\tv_mbcnt_hi_u32_b32 %0, -1, %0" : "=v"(tid_)); tid_ += wave0 * 64; asm volatile("" : "+v"(tid_));     const int tid = tid_, lane = tid & 63, wave = __builtin_amdgcn_readfirstlane(tid >> 6); (void)lane; (void)wave
    constexpr size_t ZS = (size_t)M * 512;
#ifdef PROBE_A
    volatile LAS unsigned long long* TS = (volatile LAS unsigned long long*)(L + 140000);
#define STAMP(k) do { if (bx == 0 && wave0 == 0) TS[k] = __builtin_amdgcn_s_memrealtime(); } while (0)
#else
#define STAMP(k) do {} while (0)
#endif
    STAMP(0);
    volatile LAS unsigned* xst = (volatile LAS unsigned*)(L + RING_BYTES + 64);
    if (wave0 == 0) { xst[0] = 0u; xst[1] = 0u; }
    __syncthreads();
    { ARGP(); FRESH_TID(); const XcdBarrier xb0 = xcd_barrier_make((unsigned*)(ws + WS_CTL), xst); xcd_barrier_post(xb0, tid == 0); }
#define SEAM() do { ARGP(); FRESH_TID(); const XcdBarrier xb_ = xcd_barrier_make((unsigned*)(ws + WS_CTL), xst); xcd_barrier(xb_, tid == 0); } while (0)

    { ARGP(); FRESH_TID(); Args a;
#pragma unroll
      for (int i = 0; i < 18; ++i) a.in[i] = ap->in[i];
      a.out = ap->out; a.ws = ws;
      p0_prologue(a, ws, L, tid, lane, wave, bx, G);
#if defined(PROBE_DUP) && (PROBE_DUP == 4 || PROBE_DUP == 6)
      block_seam(); p0_prologue(a, ws, L, tid, lane, wave, bx, G);
#endif
    }
    grid.sync();
    STAMP(1);

    {
        ARGP(); FRESH_TID();
        pg8::Gemm g{(const bf16*)(ws + WS_XN), (const bf16*)(ws + WS_WIN), M, NZ, DM}; pg8::StaticOrder S; S.init(M, NZ, G, bx);
        pg8::EpiZ E{(bf16*)(ws + WS_Z), ZS, (bf16*)(ws + WS_MO), (float*)(ws + WS_G), attn_body::C2};
        pg8::gemm_phase<pg8::EpiZ, pg8::StaticOrder, true, true>(L, g, S, E, tid);
#if defined(PROBE_DUP) && PROBE_DUP == 1
        block_seam(); pg8::gemm_phase<pg8::EpiZ, pg8::StaticOrder, true, true>(L, g, S, E, tid);
#endif
    }
    SEAM();
    STAMP(2);

    { ARGP(); FRESH_TID(); bf16* Z = (bf16*)(ws + WS_Z);
      constexpr int NCONV = 2 * (M / 32) * 64, NC_A = (NCONV / 8) * 5;
      const int vc = (G % 8 == 0) ? (bx % 8) * (G / 8) + bx / 8 : bx;
      int cb_ = bx * NTHR + tid, ce_ = NCONV, cs_ = G * NTHR;
      if (G == 256) { if (vc >= 128) { cb_ = (vc - 128) * NTHR + tid; ce_ = NC_A; } else { cb_ = NC_A + vc * NTHR + tid; ce_ = NCONV; } cs_ = 128 * NTHR; }
      conv_silu_phase(ap->in[6], Z + 3 * ZS, Z + 4 * ZS, (bf16*)(ws + WS_QC), (bf16*)(ws + WS_KC), cb_, ce_, cs_); }
    STAMP(3);
    {
        const int vcu0 = (G % 8 == 0) ? (bx % 8) * (G / 8) + bx / 8 : bx;
        for (int bh = vcu0; bh < 128; bh += G) { ARGP(); FRESH_TID(); const int b = bh >> 3, h = bh & 7;
            LAS float* CBl = (LAS float*)(L + attn_body::LDS_CB); LAS float* red = (LAS float*)(L + attn_body::LDS_CB + 16384);
            __syncthreads();
            fox_cumsum(CBl, red, (const float*)(ws + WS_G), ap->in[3][h], b, h, tid, lane, wave);
            for (int i = tid; i < SEQ / 4; i += NTHR) ((f32x4*)(ws + WS_CBG) + (size_t)bh * (SEQ / 4))[i] = ((const LAS f32x4*)CBl)[i];
            LAS float* QN = (LAS float*)L; LAS float* DD = (LAS float*)(L + 16384);
            const float kmax = fox_row_stats(red, QN, DD, (const bf16*)(ws + WS_Z), (const bf16*)(ws + WS_Z) + ZS, b, h, tid, lane, wave);
#pragma unroll
            for (int k = 0; k < 2; ++k) { const int qb = wave + 8 * k, NT = 4 * qb + 4; float e = 0.f;
#pragma unroll
                for (int q = 0; q < 4; ++q) { const int i = 256 * qb + 4 * lane + q; e = fmaxf(e, 1.02f * QN[i] * kmax - DD[i]); }
#pragma unroll
                for (int o = 1; o < 64; o <<= 1) e = fmaxf(e, shx(e, o, lane));
                const float thr = 40.f + e, c0 = CBl[256 * qb];
                const bool cond = (lane < NT - 4) && (CBl[64 * lane + 63] - c0 >= thr);
                const int ts = (int)__builtin_popcountll(__ballot(cond)) & ~1;
                if (lane == 0) ((int*)(ws + WS_QKB))[bh * 16 + qb] = ts; } }
    }
    SEAM();
    {
        for (;;) { ARGP(); FRESH_TID();
            unsigned qoff = RING_BYTES + 128; asm volatile("" : "+v"(qoff));
            volatile LAS int* qslot = (volatile LAS int*)(L + qoff);
            __syncthreads();
            if (tid == 0) *qslot = (int)atomicAdd((unsigned*)(ws + WS_CTL) + 4000, 1u);
            __syncthreads();
            const int u0 = __builtin_amdgcn_readfirstlane(*qslot);
            if (u0 >= ml::NITEMS + 2048 + M / 256) break;
            if (u0 >= ml::NITEMS + 2048) {
                pg8::Gemm g{(const bf16*)(ws + WS_PB), (const bf16*)(ws + WS_WPLE), M, DM, PLE}; pg8::RowOrder S{u0 - (ml::NITEMS + 2048), 4}; pg8::EpiPlain E{(bf16*)ap->out, 2 * DM};
                pg8::gemm_phase<pg8::EpiPlain, pg8::RowOrder, true, true>(L, g, S, E, tid);
                continue; }
            if (u0 < ml::NITEMS) {
                ml::mlstm_item(u0, (const bf16*)(ws + WS_QC), (const bf16*)(ws + WS_KC), (const bf16*)(ws + WS_Z) + 5 * ZS, (const bf16*)(ws + WS_MO), (const float*)(ws + WS_G), ap->in[4], ap->in[5], ap->in[9], (bf16*)(ws + WS_MIX), L, tid, lane, wave);
                continue; }
            const int u = u0 - ml::NITEMS;
            const int qb = 15 - (u >> 7), bh = u & 127, b = bh >> 3, h = bh & 7;
            const int ts = __builtin_amdgcn_readfirstlane(((const int*)(ws + WS_QKB))[bh * 16 + qb]);
            { LAS f32x4* CB4 = (LAS f32x4*)(L + attn_body::LDS_CB); const f32x4* src = (const f32x4*)(ws + WS_CBG) + (size_t)bh * (SEQ / 4);
              for (int i = ts * 16 + tid; i < (qb + 1) * 64; i += NTHR) CB4[i] = src[i]; }
            __syncthreads();
            const bf16* Z = (const bf16*)(ws + WS_Z);
            attn_body::attn_unit<20>(b, h, qb, (const attn_body::bf16*)Z, (const attn_body::bf16*)(Z + ZS), (const attn_body::bf16*)(Z + 2 * ZS), (attn_body::bf16*)(ws + WS_MIX), ap->in[8], (char*)lds, tid, ts); }
    }
    SEAM();
    STAMP(5);

    if (G == M / 256) {
        const int vcu = (bx % 8) * (G / 8) + bx / 8, grp = vcu >> 2, mj = vcu & 3, pm0 = 4 * grp, pmine = pm0 + mj;
        unsigned gbk = 0;
#define GROUP_BAR() do { ARGP(); FRESH_TID(); gbk += 4u; group_barrier((unsigned*)(ws + WS_CTL) + 4096 + 64 * grp, gbk, tid == 0); } while (0)
        { ARGP(); FRESH_TID(); pg8::Gemm g{(const bf16*)(ws + WS_MIX), (const bf16*)(ws + WS_WOUT), M, DM, DM}; pg8::GroupOrder S{pm0, mj, 1};
          pg8::EpiResB<0> E{nullptr, (const bf16*)(ws + WS_XN), (bf16*)(ws + WS_XN), nullptr, (const float*)(ws + WS_RSI), (float*)(ws + WS_SSP)};
          pg8::gemm_phase<pg8::EpiResB<0>, pg8::GroupOrder, true, true>(L, g, S, E, tid); }
        GROUP_BAR();
        { ARGP(); FRESH_TID(); panel_rstd(pm0 * 256, 1024, (const float*)(ws + WS_SSP), (float*)(ws + WS_RSTD), tid); }
        block_seam();
        { ARGP(); FRESH_TID(); pg8::Gemm g{(const bf16*)(ws + WS_XN), (const bf16*)(ws + WS_WUP), M, FF, DM}; pg8::GroupOrder S{pm0, mj, 4}; pg8::EpiUp E{(bf16*)(ws + WS_H), (const float*)(ws + WS_RSTD)};
          pg8::gemm_phase<pg8::EpiUp, pg8::GroupOrder, true, true>(L, g, S, E, tid); }
        GROUP_BAR();
        { ARGP(); FRESH_TID(); pg8::Gemm g{(const bf16*)(ws + WS_H), (const bf16*)(ws + WS_WDN), M, DM, FF}; pg8::GroupOrder S{pm0, mj, 1};
          pg8::EpiResB<1> E{nullptr, (const bf16*)(ws + WS_XN), (bf16*)(ws + WS_XN), nullptr, nullptr, (float*)(ws + WS_SSP2)};
          pg8::gemm_phase<pg8::EpiResB<1>, pg8::GroupOrder, true, true>(L, g, S, E, tid); }
        GROUP_BAR();
        { ARGP(); FRESH_TID(); panel_rstd(pm0 * 256, 1024, (const float*)(ws + WS_SSP2), (float*)(ws + WS_RSTD), tid); }
        block_seam();
        { ARGP(); FRESH_TID();
          pg8::Gemm g{(const bf16*)(ws + WS_XN), (const bf16*)(ws + WS_WPG), M, DM, DM}; pg8::GroupOrder S{pm0, mj, 1};
          pg8::EpiResB<2> E{nullptr, (const bf16*)(ws + WS_XN), (bf16*)(ws + WS_H), (const bf16*)ap->out, (const float*)(ws + WS_RSTD), (float*)(ws + WS_SSP3)};
          pg8::gemm_phase<pg8::EpiResB<2>, pg8::GroupOrder, true, true>(L, g, S, E, tid); }
        GROUP_BAR();
        { ARGP(); FRESH_TID(); panel_rstd(pmine * 256, 256, (const float*)(ws + WS_SSP3), (float*)(ws + WS_RSTD), tid); }
        block_seam();
        { ARGP(); FRESH_TID(); panel_final_norm(pmine, (const bf16*)(ws + WS_H), FF, (const float*)(ws + WS_RSTD), ap->in[17], ap->out, lane, wave); }
#undef GROUP_BAR
    }
}

extern "C" void kernel_launch(void* const* d_in, const int* in_sizes, int n_in, void* d_out, int out_size, void* d_ws, size_t ws_size, hipStream_t stream) {
    static int grid = 0;
    if (grid == 0) {
        if (n_in != 18 || in_sizes[0] != M * DM || out_size != M * DM || ws_size < WS_END) { fprintf(stderr, "kernel_launch: unexpected shapes (n_in %d, in0 %d, out %d, ws %zu)\n", n_in, n_in > 0 ? in_sizes[0] : -1, out_size, ws_size); grid = -1; return; }
        int dev = 0, cus = 0, per_cu = 0;
        if (hipGetDevice(&dev) != hipSuccess || hipDeviceGetAttribute(&cus, hipDeviceAttributeMultiprocessorCount, dev) != hipSuccess) { grid = -1; return; }
        if (hipFuncSetAttribute((const void*)hymba_fwd, hipFuncAttributeMaxDynamicSharedMemorySize, LDS_TOTAL) != hipSuccess) { fprintf(stderr, "kernel_launch: hipFuncSetAttribute failed\n"); grid = -1; return; }
        if (hipOccupancyMaxActiveBlocksPerMultiprocessor(&per_cu, (const void*)hymba_fwd, NTHR, LDS_TOTAL) != hipSuccess || per_cu < 1) { fprintf(stderr, "kernel_launch: occupancy query says %d\n", per_cu); per_cu = 1; }
        (void)hipGetLastError();
        grid = cus * per_cu;
        if (grid > 256) grid = 256;
    }
    if (grid < 0) return;
    if (hipMemsetAsync((char*)d_ws + WS_CTL, 0, CTL_BYTES, stream) != hipSuccess) { fprintf(stderr, "kernel_launch: memset of the barrier words failed\n"); return; }
    Args a{};
    for (int i = 0; i < 18; ++i) a.in[i] = (const float*)d_in[i];
    a.out = (float*)d_out; a.ws = (unsigned char*)d_ws;
    void* params[] = {&a};
    hipError_t e = hipLaunchCooperativeKernel((const void*)hymba_fwd, dim3(grid), dim3(NTHR), params, LDS_TOTAL, stream);
    if (e != hipSuccess) fprintf(stderr, "kernel_launch: cooperative launch failed: %s (grid %d)\n", hipGetErrorString(e), grid);
}
```
